# Optimizing an MI355X kernel written in HIP

```python
import math
import jax
import jax.numpy as jnp
from jax import lax
import numpy as np

D_MODEL = 1024
BATCH = 16
SEQ = 2048
DEPTH = 1

ATT_PATTERNS = ((128, 1), (512, 4), (2048, 16))
N_ATT_GROUPS = 3
HEADS_PER_GROUP = 4
ATT_HEADS = N_ATT_GROUPS * HEADS_PER_GROUP
HEAD_DIM = 64
ATT_WIDTH = ATT_HEADS * HEAD_DIM
ATT_OUT_WIDTH = HEADS_PER_GROUP * HEAD_DIM
REL_BUCKETS = 32
REL_MAX_DIST = 2048
RWKV_HEADS = 8
RWKV_HEAD_DIM = 64
RWKV_WIDTH = RWKV_HEADS * RWKV_HEAD_DIM
DECAY_LORA = 64
ICLR_LORA = 64
GATE_LORA = 160
RWKV_SHIFT_WIDTH = 3 * RWKV_WIDTH + DECAY_LORA + ICLR_LORA + GATE_LORA
GN_EPS = 64e-5
N_BRANCHES = 2
IN_WIDTH = 3 * ATT_WIDTH + RWKV_SHIFT_WIDTH + N_BRANCHES * D_MODEL
N_EXPERT_GROUPS = 4
EXPERTS_PER_GROUP = 8
N_EXPERTS = N_EXPERT_GROUPS * EXPERTS_PER_GROUP
TOP_K = 2
D_EXPERT = 512
ROW_BLOCK = 256
NORM_EPS = 1e-6
NEG_INF = -1e30

kernel_name = 'hybrid_dilated_rwkv7_hmoe_block'


def rms_norm(x, gain, eps=NORM_EPS):
    xf = x.astype(jnp.float32)
    y = xf * lax.rsqrt(jnp.mean(xf * xf, axis=-1, keepdims=True) + eps)
    return (y * gain.astype(jnp.float32)).astype(x.dtype)


def t5_causal_bucket(dist):
    max_exact = REL_BUCKETS // 2
    d = jnp.maximum(dist.astype(jnp.float32), 1.0)
    large = max_exact + (jnp.log(d / max_exact) / math.log(REL_MAX_DIST / max_exact)
                         * (REL_BUCKETS - max_exact)).astype(jnp.int32)
    large = jnp.minimum(large, REL_BUCKETS - 1)
    return jnp.where(dist < max_exact, dist, large)


def dilated_window_attention(q, k, v, bias_table, window, dilation):
    B, S, H, E = q.shape
    L = S // dilation
    W = window // dilation
    n_blk = -(-L // W)
    Lp = n_blk * W

    def to_sub(t):
        return t.reshape(B, L, dilation, H, E).transpose(0, 2, 3, 1, 4)

    qb = jnp.pad(to_sub(q), ((0, 0),) * 3 + ((0, Lp - L), (0, 0))).reshape(B, dilation, H, n_blk, W, E)
    kv_pad = ((0, 0),) * 3 + ((W, Lp - L), (0, 0))

    def band(t):
        t = jnp.pad(to_sub(t), kv_pad)
        prev = t[:, :, :, :Lp].reshape(B, dilation, H, n_blk, W, E)
        cur = t[:, :, :, W:].reshape(B, dilation, H, n_blk, W, E)
        return jnp.concatenate([prev, cur], axis=4)

    kb, vb = band(k), band(v)
    qi = jnp.arange(W)[:, None]
    kj = jnp.arange(2 * W)[None, :]
    rel = qi + W - kj
    key_pos = (jnp.arange(n_blk) * W - W)[:, None, None] + kj[None]
    valid = (rel >= 0)[None] & (rel <= W)[None] & (key_pos >= 0)
    bias = bias_table[t5_causal_bucket(jnp.clip(rel, 0, W) * dilation)]
    bias = jnp.transpose(bias, (2, 0, 1)).astype(jnp.float32)[:, None]
    s = jnp.einsum('bdhnqe,bdhnke->bdhnqk', qb, kb).astype(jnp.float32) * (E ** -0.5) + bias
    s = jnp.where(valid, s, NEG_INF)
    lse = jax.nn.logsumexp(s, axis=-1)
    p = jnp.exp(s - lse[..., None])
    o = jnp.einsum('bdhnqk,bdhnke->bdhnqe', p.astype(v.dtype), vb)

    def from_sub(t):
        t = t.reshape((B, dilation, H, Lp) + t.shape[5:])[:, :, :, :L]
        t = jnp.moveaxis(t, 3, 1)
        return t.reshape((B, S, H) + t.shape[4:])

    return from_sub(o), from_sub(lse)


def wkv7_scan(r, decay, k, v, kk, a):
    B, S, H, N = r.shape

    def step(state, inp):
        r_t, w_t, k_t, v_t, kk_t, b_t = inp
        sa = jnp.einsum('bhvk,bhk->bhv', state, -kk_t)
        state = (state * w_t[:, :, None, :] + sa[..., None] * b_t[:, :, None, :]
                 + v_t[..., None] * k_t[:, :, None, :])
        return state, jnp.einsum('bhvk,bhk->bhv', state, r_t)

    xs = tuple(jnp.moveaxis(t, 1, 0) for t in (r, decay, k, v, kk, kk * a))
    _, out = lax.scan(step, jnp.zeros((B, H, N, N), jnp.float32), xs)
    return jnp.moveaxis(out, 0, 1)


def rwkv7_time_mix(p, shift_mu, w0, w_up, a0, a_up, g_up, k_k, k_a, r_k, ln_w, ln_b, w_rwkv_out):
    B, S, _ = p.shape
    H, N, C = RWKV_HEADS, RWKV_HEAD_DIM, RWKV_WIDTH
    pf = p.astype(jnp.float32)
    prev = jnp.pad(pf, ((0, 0), (1, 0), (0, 0)))[:, :-1]
    pm = pf + (prev - pf) * shift_mu
    r, k, v, xw, xa, xg = jnp.split(pm, [C, 2 * C, 3 * C, 3 * C + DECAY_LORA,
                                          3 * C + DECAY_LORA + ICLR_LORA], axis=-1)
    w_log = -jax.nn.softplus(-(w0 + jnp.tanh(xw) @ w_up)) - 0.5
    decay = jnp.exp(-jnp.exp(w_log))
    a = jax.nn.sigmoid(a0 + xa @ a_up)
    g = jax.nn.sigmoid(xg) @ g_up
    hd = lambda t: t.reshape(B, S, H, N)
    kk = hd(k * k_k)
    kk = kk / jnp.maximum(jnp.sqrt(jnp.sum(kk * kk, axis=-1, keepdims=True)), 1e-12)
    k = k * (1.0 + (a - 1.0) * k_a)
    o = wkv7_scan(hd(r), hd(decay), hd(k), hd(v), kk, hd(a))
    mu = jnp.mean(o, axis=-1, keepdims=True)
    var = jnp.mean(jnp.square(o - mu), axis=-1, keepdims=True)
    o = ((o - mu) * lax.rsqrt(var + GN_EPS)).reshape(B, S, C) * ln_w + ln_b
    bonus = jnp.sum(hd(r) * hd(k) * r_k, axis=-1, keepdims=True) * hd(v)
    o = (o + bonus.reshape(B, S, C)) * g
    return o.astype(p.dtype) @ w_rwkv_out


def hierarchical_moe(h, w_group_router, b_group_router, w_expert_router, b_expert_router,
                     w_expert_gate, w_expert_up, w_expert_down):
    B, S, D = h.shape
    T = B * S
    hf = h.reshape(T, D)
    grp_prob = jax.nn.softmax((hf @ w_group_router).astype(jnp.float32) + b_group_router, axis=-1)
    grp_p, grp_idx = lax.top_k(grp_prob, 1)
    exp_logits = ((hf @ w_expert_router).astype(jnp.float32) + b_expert_router).reshape(
        T, N_EXPERT_GROUPS, EXPERTS_PER_GROUP)
    sel_logits = jnp.take_along_axis(exp_logits, grp_idx[:, :, None], axis=1)[:, 0]
    top_p, top_i = lax.top_k(jax.nn.softmax(sel_logits, axis=-1), TOP_K)
    gates = grp_p * top_p / jnp.sum(top_p, axis=-1, keepdims=True)
    expert_id = grp_idx * EXPERTS_PER_GROUP + top_i

    A = T * TOP_K
    eid = expert_id.reshape(A).astype(jnp.int32)
    tok = jnp.arange(A, dtype=jnp.int32) // TOP_K
    gate = gates.reshape(A)
    order = jnp.argsort(eid)
    se = eid[order]
    counts = jnp.bincount(eid, length=N_EXPERTS)
    starts = jnp.cumsum(counts) - counts
    pcounts = (counts + ROW_BLOCK - 1) // ROW_BLOCK * ROW_BLOCK
    pends = jnp.cumsum(pcounts)
    pstarts = pends - pcounts
    dest = pstarts[se] + jnp.arange(A, dtype=jnp.int32) - starts[se]
    n_blocks = -(-A // ROW_BLOCK) + N_EXPERTS
    n_rows = n_blocks * ROW_BLOCK
    row_tok = jnp.full((n_rows,), T, jnp.int32).at[dest].set(tok[order])
    row_gate = jnp.zeros((n_rows,), jnp.float32).at[dest].set(gate[order])
    blk_expert = jnp.minimum(jnp.searchsorted(pends, jnp.arange(n_blocks) * ROW_BLOCK, side='right'),
                             N_EXPERTS - 1)
    h_pad = jnp.concatenate([hf, jnp.zeros((1, D), hf.dtype)], axis=0)
    xin = h_pad[row_tok].reshape(n_blocks, ROW_BLOCK, D)

    def expert_block(args):
        xb, e = args
        hid = jax.nn.silu(xb @ w_expert_gate[e]) * (xb @ w_expert_up[e])
        return hid @ w_expert_down[e]

    yb = lax.map(expert_block, (xin, blk_expert)).reshape(n_rows, D)
    y = jax.ops.segment_sum(yb.astype(jnp.float32) * row_gate[:, None], row_tok, num_segments=T + 1)[:T]
    return y.reshape(B, S, D).astype(h.dtype)


def hybrid_layer(x, norm1_gain, w_in, q_norm_gain, k_norm_gain, rel_bias_table, w_att_out,
                 shift_mu, w0, w_up, a0, a_up, g_up, k_k, k_a, r_k, ln_w, ln_b, w_rwkv_out,
                 w_out, norm2_gain, w_group_router, b_group_router, w_expert_router,
                 b_expert_router, w_expert_gate, w_expert_up, w_expert_down):
    B, S, D = x.shape
    h = rms_norm(x, norm1_gain)
    p = h @ w_in
    q, k, v, p_rwkv, p_gate = jnp.split(
        p, [ATT_WIDTH, 2 * ATT_WIDTH, 3 * ATT_WIDTH, 3 * ATT_WIDTH + RWKV_SHIFT_WIDTH], axis=-1)

    heads = lambda t: t.reshape(B, S, N_ATT_GROUPS, HEADS_PER_GROUP, HEAD_DIM)
    q = rms_norm(heads(q), q_norm_gain[:, None, :])
    k = rms_norm(heads(k), k_norm_gain[:, None, :])
    v = heads(v)
    outs, lses = [], []
    for g, (win, dil) in enumerate(ATT_PATTERNS):
        o_g, l_g = dilated_window_attention(
            q[:, :, g], k[:, :, g], v[:, :, g],
            rel_bias_table[:, g * HEADS_PER_GROUP:(g + 1) * HEADS_PER_GROUP], win, dil)
        outs.append(o_g)
        lses.append(l_g)
    wts = jax.nn.softmax(jnp.stack(lses, axis=0), axis=0)
    att = jnp.einsum('gbsh,gbshe->bshe', wts, jnp.stack(outs, axis=0).astype(jnp.float32))
    y_att = att.reshape(B, S, ATT_OUT_WIDTH).astype(x.dtype) @ w_att_out

    y_rwkv = rwkv7_time_mix(p_rwkv, shift_mu, w0, w_up, a0, a_up, g_up, k_k, k_a, r_k,
                            ln_w, ln_b, w_rwkv_out)

    gates = jax.nn.sigmoid(p_gate.astype(jnp.float32)).astype(x.dtype)
    mixed = gates[..., :D] * y_att + gates[..., D:] * y_rwkv
    x = x + mixed @ w_out

    x = x + hierarchical_moe(rms_norm(x, norm2_gain), w_group_router, b_group_router,
                             w_expert_router, b_expert_router, w_expert_gate, w_expert_up,
                             w_expert_down)
    return x


def setup_inputs(seed: int = 0) -> dict:
    key = jax.random.key(seed)
    ks = jax.random.split(key, 28)
    f32 = jnp.float32
    L, D = DEPTH, D_MODEL
    nrm = lambda k, shape, scale: scale * jax.random.normal(k, shape, f32)
    return {
        'x': nrm(ks[0], (BATCH, SEQ, D), 1.0),
        'norm1_gain': 1.0 + nrm(ks[1], (L, D), 0.05),
        'w_in': nrm(ks[2], (L, D, IN_WIDTH), D ** -0.5),
        'q_norm_gain': 1.0 + nrm(ks[3], (L, N_ATT_GROUPS, HEAD_DIM), 0.05),
        'k_norm_gain': 1.0 + nrm(ks[4], (L, N_ATT_GROUPS, HEAD_DIM), 0.05),
        'rel_bias_table': nrm(ks[5], (REL_BUCKETS, ATT_HEADS), 0.5),
        'w_att_out': nrm(ks[6], (L, ATT_OUT_WIDTH, D), ATT_OUT_WIDTH ** -0.5),
        'rwkv_shift_mu': jax.random.uniform(ks[7], (L, RWKV_SHIFT_WIDTH), f32),
        'rwkv_w0': jax.random.uniform(ks[8], (L, RWKV_WIDTH), f32, -6.0, 1.0),
        'rwkv_w_up': nrm(ks[9], (L, DECAY_LORA, RWKV_WIDTH), 0.5 * DECAY_LORA ** -0.5),
        'rwkv_a0': nrm(ks[10], (L, RWKV_WIDTH), 0.1),
        'rwkv_a_up': nrm(ks[11], (L, ICLR_LORA, RWKV_WIDTH), ICLR_LORA ** -0.5),
        'rwkv_g_up': nrm(ks[12], (L, GATE_LORA, RWKV_WIDTH), GATE_LORA ** -0.5),
        'rwkv_k_k': 0.85 + nrm(ks[13], (L, RWKV_WIDTH), 0.05),
        'rwkv_k_a': 1.0 + nrm(ks[14], (L, RWKV_WIDTH), 0.05),
        'rwkv_r_k': nrm(ks[15], (L, RWKV_HEADS, RWKV_HEAD_DIM), 0.1),
        'rwkv_ln_w': 1.0 + nrm(ks[16], (L, RWKV_WIDTH), 0.05),
        'rwkv_ln_b': nrm(ks[17], (L, RWKV_WIDTH), 0.01),
        'w_rwkv_out': nrm(ks[18], (L, RWKV_WIDTH, D), RWKV_WIDTH ** -0.5),
        'w_out': nrm(ks[19], (L, D, D), D ** -0.5),
        'norm2_gain': 1.0 + nrm(ks[20], (L, D), 0.05),
        'w_group_router': nrm(ks[21], (L, D, N_EXPERT_GROUPS), D ** -0.5),
        'b_group_router': nrm(ks[22], (L, N_EXPERT_GROUPS), 0.01),
        'w_expert_router': nrm(ks[23], (L, D, N_EXPERTS), D ** -0.5),
        'b_expert_router': nrm(ks[24], (L, N_EXPERTS), 0.01),
        'w_expert_gate': nrm(ks[25], (L, N_EXPERTS, D, D_EXPERT), D ** -0.5),
        'w_expert_up': nrm(ks[26], (L, N_EXPERTS, D, D_EXPERT), D ** -0.5),
        'w_expert_down': nrm(ks[27], (L, N_EXPERTS, D_EXPERT, D), D_EXPERT ** -0.5),
    }


def reference(x, norm1_gain, w_in, q_norm_gain, k_norm_gain, rel_bias_table, w_att_out,
              rwkv_shift_mu, rwkv_w0, rwkv_w_up, rwkv_a0, rwkv_a_up, rwkv_g_up, rwkv_k_k,
              rwkv_k_a, rwkv_r_k, rwkv_ln_w, rwkv_ln_b, w_rwkv_out, w_out, norm2_gain,
              w_group_router, b_group_router, w_expert_router, b_expert_router,
              w_expert_gate, w_expert_up, w_expert_down):
    for l in range(DEPTH):
        x = hybrid_layer(x, norm1_gain[l], w_in[l], q_norm_gain[l], k_norm_gain[l], rel_bias_table,
                         w_att_out[l], rwkv_shift_mu[l], rwkv_w0[l], rwkv_w_up[l], rwkv_a0[l],
                         rwkv_a_up[l], rwkv_g_up[l], rwkv_k_k[l], rwkv_k_a[l], rwkv_r_k[l],
                         rwkv_ln_w[l], rwkv_ln_b[l], w_rwkv_out[l], w_out[l], norm2_gain[l],
                         w_group_router[l], b_group_router[l], w_expert_router[l],
                         b_expert_router[l], w_expert_gate[l], w_expert_up[l], w_expert_down[l])
    return x
```

```cpp
#include <hip/hip_runtime.h>
#include <cstdio>
#include <cstdint>

#ifndef MK_N_LAUNCHES
#define MK_N_LAUNCHES 12
#endif
#ifndef NAIVE_GEMM_MASK
#define NAIVE_GEMM_MASK 0
#endif

#define LAS __attribute__((address_space(3)))
#define GAS __attribute__((address_space(1)))
typedef unsigned short bf16_t;
typedef short bf16x8 __attribute__((ext_vector_type(8)));
typedef short bf16x4 __attribute__((ext_vector_type(4)));
typedef float f32x4 __attribute__((ext_vector_type(4)));
typedef float f32x2 __attribute__((ext_vector_type(2)));
typedef unsigned u32x4 __attribute__((ext_vector_type(4)));
typedef unsigned u32x2 __attribute__((ext_vector_type(2)));

constexpr int D = 1024, BATCH = 16, SEQ = 2048, T = BATCH * SEQ;
constexpr int AW = 768;
constexpr int RW = 1824;
constexpr int NIN = 6400;
constexpr int CR = 512;
constexpr int LK = 384;
constexpr int NEXP = 32, DE = 512;
constexpr int NLIST = 64;
constexpr int NPH = 12;

constexpr size_t MiB = 1u << 20;
constexpr size_t WS_CTL = 0, CTL_ZERO_BYTES = 1 * MiB;
constexpr size_t WS_LIST = 1 * MiB;
constexpr size_t WS_TOKG = 9 * MiB;
constexpr size_t WS_WIN = 10 * MiB;
constexpr size_t WS_WATT = 23 * MiB;
constexpr size_t WS_WRWKV = 24 * MiB;
constexpr size_t WS_WOUT = 25 * MiB;
constexpr size_t WS_WLORA = 27 * MiB;
constexpr size_t WS_H = 30 * MiB;
constexpr size_t WS_OG = WS_H;
constexpr size_t WS_LSE = WS_H + 48 * MiB;
constexpr size_t WS_QKV = 94 * MiB;
constexpr size_t WS_WGU = WS_QKV;
constexpr size_t WS_WD = WS_QKV + 64 * MiB;
constexpr size_t WS_PR = 238 * MiB;
constexpr size_t WS_HID = WS_PR;
constexpr size_t WS_LAG = 352 * MiB;
constexpr size_t WS_ATT = 448 * MiB;
constexpr size_t WS_ORW = 464 * MiB;
constexpr size_t WS_END = 496 * MiB;

constexpr int CW_TMO = 0;
constexpr int CW_BAR = 4096;
constexpr int CW_CNT = 16384;

constexpr int LDS_BYTES = 147456;
constexpr int LDS_TAB = 131072;
constexpr int LDS_MISC = 147456 - 64;

#define RLX_AGENT __ATOMIC_RELAXED, __HIP_MEMORY_SCOPE_AGENT
#define LDS_WAIT() asm volatile("s_waitcnt lgkmcnt(0)" ::: "memory")
#define VM_WAIT() asm volatile("s_waitcnt vmcnt(0)" ::: "memory")

__device__ __forceinline__ unsigned cvt_pk_bf16(float lo, float hi) { unsigned r; asm volatile("v_cvt_pk_bf16_f32 %0, %1, %2" : "=v"(r) : "v"(lo), "v"(hi)); return r; }
__device__ __forceinline__ float bf_lo(unsigned u) { return __uint_as_float(u << 16); }
__device__ __forceinline__ float bf_hi(unsigned u) { return __uint_as_float(u & 0xffff0000u); }
__device__ __forceinline__ u32x4 pack8(const float (&v)[8]) { u32x4 w; w.x = cvt_pk_bf16(v[0], v[1]); w.y = cvt_pk_bf16(v[2], v[3]); w.z = cvt_pk_bf16(v[4], v[5]); w.w = cvt_pk_bf16(v[6], v[7]); return w; }
__device__ __forceinline__ void unpack8(u32x4 w, float (&v)[8]) { v[0] = bf_lo(w.x); v[1] = bf_hi(w.x); v[2] = bf_lo(w.y); v[3] = bf_hi(w.y); v[4] = bf_lo(w.z); v[5] = bf_hi(w.z); v[6] = bf_lo(w.w); v[7] = bf_hi(w.w); }
__device__ __forceinline__ void unpack4(u32x2 w, float (&v)[4]) { v[0] = bf_lo(w.x); v[1] = bf_hi(w.x); v[2] = bf_lo(w.y); v[3] = bf_hi(w.y); }
__device__ __forceinline__ float sigmoidf_(float x) { return 1.f / (1.f + __expf(-x)); }
__device__ __forceinline__ float wave_sum(float v) {
#pragma unroll
    for (int o = 1; o < 64; o <<= 1) v += __shfl_xor(v, o);
    return v;
}
template <int CTRL> __device__ __forceinline__ float dpp_f(float x) { return __builtin_bit_cast(float, __builtin_amdgcn_mov_dpp(__builtin_bit_cast(int, x), CTRL, 0xf, 0xf, true)); }
__device__ __forceinline__ float red16(float x) { x += dpp_f<0xB1>(x); x += dpp_f<0x4E>(x); x += dpp_f<0x141>(x); x += dpp_f<0x128>(x); return x; }

#define XB_TMO      128
#define XB_XCNT(j)  (256  + 64 * (j))
#define XB_XSUB(j)  (1280 + 64 * (j))
#define XB_XGEN(j)  (2304 + 64 * (j))
#define XB_TOP      3328
#define XB_TOPGEN   3392
#define XCD_BAR_WORDS 3456
#define XB_SPIN_CAP (1u << 18)
__device__ __forceinline__ unsigned xb_ld(unsigned* p)              { return __hip_atomic_load(p, __ATOMIC_RELAXED, __HIP_MEMORY_SCOPE_AGENT); }
__device__ __forceinline__ unsigned xb_add(unsigned* p, unsigned v) { return __hip_atomic_fetch_add(p, v, __ATOMIC_RELAXED, __HIP_MEMORY_SCOPE_AGENT); }
__device__ __forceinline__ unsigned xb_xcc_id() { return (unsigned)__builtin_amdgcn_s_getreg((3 << 11) | 20) & 0xFu; }
#define XB_SPIN(cond, bar) do { unsigned _sp = 0; while (cond) { __builtin_amdgcn_s_sleep(1); \
    if ((++_sp & 255u) == 0u) { if (xb_ld(&(bar)[XB_TMO])) break; if (_sp > XB_SPIN_CAP) { atomicAdd(&(bar)[XB_TMO], 1u); break; } } } } while (0)
struct XcdBarrier { unsigned* bar; unsigned x; volatile LAS unsigned* st; };
__device__ __forceinline__ XcdBarrier xcd_barrier_post(unsigned* bar, volatile LAS unsigned* st) {
    XcdBarrier b; b.bar = bar; b.x = xb_xcc_id(); b.st = st;
    if (threadIdx.x == 0) (void)xb_add(&bar[XB_XCNT(b.x)], 1u);
    return b;
}
__device__ __forceinline__ void xcd_barrier_complete(unsigned* bar, unsigned x, unsigned& nloc, unsigned& nx) {
    const unsigned G = gridDim.x * gridDim.y * gridDim.z;
    unsigned sum, cnt, mine, sp = 0u;
    for (;;) {
        sum = 0u; cnt = 0u; mine = 0u;
#pragma unroll
        for (unsigned j = 0; j < 16; ++j) { const unsigned c = xb_ld(&bar[XB_XCNT(j)]); sum += c; cnt += (c > 0u) ? 1u : 0u; mine = (j == x) ? c : mine; }
        if (sum == G) break;
        __builtin_amdgcn_s_sleep(1);
        if ((++sp & 255u) == 0u) { if (xb_ld(&bar[XB_TMO])) break; if (sp > XB_SPIN_CAP) { atomicAdd(&bar[XB_TMO], 1u); break; } }
    }
    nloc = mine > 0u ? mine : 1u; nx = cnt > 0u ? cnt : 1u;
}
__device__ __forceinline__ void xcd_barrier(const XcdBarrier& b) {
    asm volatile("s_waitcnt vmcnt(0)" ::: "memory");
    __syncthreads();
    if (threadIdx.x == 0) {
        unsigned* bar = b.bar;
        __builtin_amdgcn_s_waitcnt(0);
        unsigned nloc = b.st[0], nx = b.st[1];
        if (nloc == 0u) { xcd_barrier_complete(bar, b.x, nloc, nx); b.st[0] = nloc; b.st[1] = nx; }
        const unsigned old = xb_add(&bar[XB_XSUB(b.x)], 1u);
        const unsigned gen = old / nloc;
        if (old + 1u == (gen + 1u) * nloc) {
            __builtin_amdgcn_fence(__ATOMIC_RELEASE, "agent");
            asm volatile("s_waitcnt vmcnt(0)" ::: "memory");
            const unsigned og = xb_add(&bar[XB_TOP], 1u);
            const unsigned tg = og / nx;
            if (og + 1u == (tg + 1u) * nx) xb_add(&bar[XB_TOPGEN], 1u);
            else XB_SPIN(xb_ld(&bar[XB_TOPGEN]) == tg, bar);
            __builtin_amdgcn_fence(__ATOMIC_ACQUIRE, "agent");
            xb_add(&bar[XB_XGEN(b.x)], 1u);
            asm volatile("s_waitcnt vmcnt(0)" ::: "memory");
        } else {
            XB_SPIN(xb_ld(&bar[XB_XGEN(b.x)]) == gen, bar);
            __builtin_amdgcn_fence(__ATOMIC_ACQUIRE, "agent");
            asm volatile("s_waitcnt vmcnt(0)" ::: "memory");
        }
    }
    __syncthreads();
}

namespace pg8 {
constexpr int BM = 256, BK = 64, HALF = 128, HTB = HALF * BK * 2, NXCD = 8, WGM = 8;
__host__ __device__ __forceinline__ int lds_byte(int r, int c) { const int st = (r >> 4) * 2 + (c >> 5), rr = r & 15, cc = c & 31, ob = rr * 64 + cc * 2; return st * 1024 + (ob ^ (((ob >> 9) & 1) << 5)); }
__host__ __device__ __forceinline__ void stage_rc(int b, int& R, int& C) { const int st = b / 1024, sb = b % 1024, swz = sb ^ (((sb >> 9) & 1) << 5); R = (st >> 1) * 16 + swz / 64; C = (st & 1) * 32 + (swz % 64) / 2; }
__host__ __device__ __forceinline__ int perm32(int rho) { const int n = rho >> 4, i = rho & 15; return 8 * (i >> 2) + 4 * n + (i & 3); }

struct Unit { int pm, pn; const char* A; const char* B; int ui, aux; };

struct StaticOrder {
    static constexpr bool GATHER = false;
    int nM, nN, nwg, G, c; const char* A; const char* Bt; size_t tstep;
    __device__ void init(const void* A_, const void* Bt_, int M, int N, int K, int G_, int c_) { A = (const char*)A_; Bt = (const char*)Bt_; nM = M / BM; nN = N / BM; nwg = nM * nN; G = G_; c = c_; tstep = (size_t)BM * K * 2; }
    __device__ bool next(int i, Unit& u) const {
        const long L = (long)i * G + c; if (L >= nwg) return false;
        int wgid = (int)L; { const int q = nwg / NXCD, r = nwg % NXCD, xcd = wgid % NXCD, off = wgid / NXCD; wgid = (xcd < r ? xcd * (q + 1) : r * (q + 1) + (xcd - r) * q) + off; }
        const int nig = WGM * nN, gid = wgid / nig, fm = gid * WGM, gsz = (nM - fm) < WGM ? (nM - fm) : WGM;
        u.pm = fm + ((wgid % nig) % gsz); u.pn = (wgid % nig) / gsz; u.A = A + (size_t)u.pm * tstep; u.B = Bt + (size_t)u.pn * tstep; u.ui = i; u.aux = 0; return true;
    }
    __device__ __forceinline__ unsigned row_off(const Unit&, int) const { return 0u; }
};

template <class F> struct EpiRow8 {
    F f;
    __device__ __forceinline__ void operator()(const f32x4 (&acc)[2][2][4][2], const Unit& u, int wr, int wc, int fr, int fq) const {
        asm volatile("" : "+v"(fr), "+v"(fq));
#pragma unroll
        for (int ai = 0; ai < 2; ++ai)
#pragma unroll
            for (int m = 0; m < 4; ++m) { const int r = ai * HALF + wr * 64 + m * 16 + fr;
#pragma unroll
                for (int bj = 0; bj < 2; ++bj) { const f32x4 a = acc[ai][bj][m][0], b = acc[ai][bj][m][1]; const float v[8] = {a[0], a[1], a[2], a[3], b[0], b[1], b[2], b[3]};
                    f(u, r, bj * HALF + wc * 32 + 8 * fq, v); }
                asm volatile("" ::: "memory"); }
    }
};
template <class F> struct EpiPair8 {
    F f;
    __device__ __forceinline__ void operator()(const f32x4 (&acc)[2][2][4][2], const Unit& u, int wr, int wc, int fr, int fq) const {
        asm volatile("" : "+v"(fr), "+v"(fq));
#pragma unroll
        for (int ai = 0; ai < 2; ++ai)
#pragma unroll
            for (int m = 0; m < 4; ++m) { const int r = ai * HALF + wr * 64 + m * 16 + fr;
                const f32x4 a = acc[ai][0][m][0], b = acc[ai][0][m][1], c = acc[ai][1][m][0], d = acc[ai][1][m][1];
                const float g[8] = {a[0], a[1], a[2], a[3], b[0], b[1], b[2], b[3]}, up[8] = {c[0], c[1], c[2], c[3], d[0], d[1], d[2], d[3]};
                f(u, r, wc * 32 + 8 * fq, g, up); asm volatile("" ::: "memory"); }
    }
};

template <class Epi, class Sched>
__device__ __forceinline__ void gemm_phase(LAS unsigned char* lds, const int K, const Sched& S, const Epi& E) {
    const int tid = threadIdx.x, wid = __builtin_amdgcn_readfirstlane(tid >> 6), lane = tid & 63, wr = wid >> 2, wc = wid & 3, fr = lane & 15, fq = lane >> 4;
    const int nt = K / BK;
    unsigned voffA[2], voffB[2]; int Rr[2], Cb[2];
#pragma unroll
    for (int i = 0; i < 2; ++i) { int R, C; stage_rc(tid * 16 + i * 8192, R, C); const int Rb = (R & ~31) + perm32(R & 31);
        voffA[i] = (unsigned)(R * K + C) * 2u; voffB[i] = (unsigned)(Rb * K + C) * 2u; Rr[i] = R; Cb[i] = C * 2; }
    const size_t kstep = (size_t)(BK * 2);
    const size_t hstep = (size_t)HALF * K * 2;
    const unsigned ldsw = (unsigned)wid * 1024u;
    const int aoff = lds_byte(wr * 64 + fr, fq * 8), boff = lds_byte(wc * 32 + fr, fq * 8);
#define PG8_SA(b, h) (((b) * 2 + (h)) * HTB)
#define PG8_SB(b, h) ((4 + (b) * 2 + (h)) * HTB)
#define PG8_STAGE_B(bufoff, gbase) do { _Pragma("unroll") for (int _i = 0; _i < 2; ++_i) \
        __builtin_amdgcn_global_load_lds((const unsigned*)((const char*)(gbase) + voffB[_i]), (LAS unsigned*)(lds + (bufoff) + ldsw + _i * 8192), 16, 0, 0); } while (0)
#define PG8_STAGE_A(bufoff, gbase, h) do { _Pragma("unroll") for (int _i = 0; _i < 2; ++_i) { \
        const char* _p; if constexpr (Sched::GATHER) _p = (const char*)(gbase) + ao[h][_i]; else _p = (const char*)(gbase) + (h) * hstep + voffA[_i]; \
        __builtin_amdgcn_global_load_lds((const unsigned*)_p, (LAS unsigned*)(lds + (bufoff) + ldsw + _i * 8192), 16, 0, 0); } } while (0)
#define PG8_LDA(dst, b, h) do { _Pragma("unroll") for (int m = 0; m < 4; ++m) _Pragma("unroll") for (int k = 0; k < 2; ++k) dst[m][k] = *(const LAS bf16x8*)(lds + PG8_SA(b, h) + aoff + m * 2048 + k * 1024); } while (0)
#define PG8_LDB(dst, b, h) do { _Pragma("unroll") for (int n = 0; n < 2; ++n) _Pragma("unroll") for (int k = 0; k < 2; ++k) dst[n][k] = *(const LAS bf16x8*)(lds + PG8_SB(b, h) + boff + n * 2048 + k * 1024); } while (0)
#define PG8_MMA(ai, bj, At, Bt) do { __builtin_amdgcn_s_setprio(1); _Pragma("unroll") for (int m = 0; m < 4; ++m) _Pragma("unroll") for (int n = 0; n < 2; ++n) _Pragma("unroll") for (int k = 0; k < 2; ++k) \
        acc[ai][bj][m][n] = __builtin_amdgcn_mfma_f32_16x16x32_bf16(Bt[n][k], At[m][k], acc[ai][bj][m][n], 0, 0, 0); __builtin_amdgcn_s_setprio(0); } while (0)
#define PG8_WAIT_V(n) asm volatile("s_waitcnt vmcnt(" #n ")" ::: "memory")
#define PG8_WAIT_L(n) asm volatile("s_waitcnt lgkmcnt(" #n ")" ::: "memory")
#define PG8_BAR __builtin_amdgcn_s_barrier()
#define PG8_SCHED __builtin_amdgcn_sched_barrier(0)
    Unit cur, nxt; int ui = 0;
    if (!S.next(0, cur)) return;
    f32x4 acc[2][2][4][2];
#pragma unroll
    for (int a = 0; a < 2; ++a)
#pragma unroll
        for (int b = 0; b < 2; ++b)
#pragma unroll
            for (int m = 0; m < 4; ++m)
#pragma unroll
                for (int n = 0; n < 2; ++n) acc[a][b][m][n] = (f32x4){0.f, 0.f, 0.f, 0.f};
    bf16x8 At[4][2], B0[2][2], B1[2][2];
    const char* cA = cur.A; const char* cB = cur.B;
    unsigned ao[2][2] = {{0u, 0u}, {0u, 0u}};
    if constexpr (Sched::GATHER) {
#pragma unroll
        for (int h = 0; h < 2; ++h)
#pragma unroll
            for (int i = 0; i < 2; ++i) ao[h][i] = S.row_off(cur, h * HALF + Rr[i]) + (unsigned)Cb[i];
    }
    PG8_STAGE_B(PG8_SB(0, 0), cB); PG8_STAGE_B(PG8_SB(0, 1), cB + hstep); PG8_STAGE_A(PG8_SA(0, 0), cA, 0); PG8_STAGE_A(PG8_SA(0, 1), cA, 1);
    if (wr == 1) PG8_BAR;
    PG8_WAIT_V(2); PG8_BAR;
    PG8_STAGE_B(PG8_SB(1, 0), cB + kstep); PG8_STAGE_A(PG8_SA(1, 0), cA + kstep, 0); PG8_STAGE_B(PG8_SB(1, 1), cB + hstep + kstep);
    PG8_WAIT_V(6); PG8_BAR;
    for (;;) {
        const bool has_next = S.next(ui + 1, nxt);
        const char* nA = has_next ? nxt.A : cA; const char* nB = has_next ? nxt.B : cB;
#pragma unroll 1
        for (int t = 0; t < nt; t += 2) {
            const bool last = (t == nt - 2);
            const char* a1 = cA + (size_t)(t + 1) * kstep;
            const char* a2 = last ? nA : cA + (size_t)(t + 2) * kstep; const char* b2 = last ? nB : cB + (size_t)(t + 2) * kstep;
            const char* a3 = a2 + kstep; const char* b3 = b2 + kstep;
            PG8_LDB(B0, 0, 0); PG8_LDB(B1, 0, 1); PG8_SCHED; PG8_LDA(At, 0, 0); PG8_STAGE_A(PG8_SA(1, 1), a1, 1);
            if constexpr (Sched::GATHER) { if (last && has_next) {
#pragma unroll
                for (int h = 0; h < 2; ++h)
#pragma unroll
                    for (int i = 0; i < 2; ++i) ao[h][i] = S.row_off(nxt, h * HALF + Rr[i]) + (unsigned)Cb[i]; } }
            PG8_WAIT_V(8); PG8_WAIT_L(0); PG8_BAR; PG8_MMA(0, 0, At, B0); PG8_MMA(0, 1, At, B1); PG8_BAR; PG8_SCHED;
            PG8_LDA(At, 0, 1); PG8_STAGE_B(PG8_SB(0, 0), b2); PG8_STAGE_B(PG8_SB(0, 1), b2 + hstep); PG8_STAGE_A(PG8_SA(0, 0), a2, 0);
            PG8_WAIT_V(8); PG8_WAIT_L(0); PG8_BAR; PG8_MMA(1, 0, At, B0); PG8_MMA(1, 1, At, B1); PG8_BAR; PG8_SCHED;
            PG8_LDB(B0, 1, 0); PG8_LDB(B1, 1, 1); PG8_SCHED; PG8_LDA(At, 1, 0); PG8_STAGE_A(PG8_SA(0, 1), a2, 1);
            PG8_WAIT_V(8); PG8_WAIT_L(0); PG8_BAR; PG8_MMA(0, 0, At, B0); PG8_MMA(0, 1, At, B1); PG8_BAR; PG8_SCHED;
            PG8_LDA(At, 1, 1); PG8_STAGE_B(PG8_SB(1, 0), b3); PG8_STAGE_B(PG8_SB(1, 1), b3 + hstep); PG8_STAGE_A(PG8_SA(1, 0), a3, 0);
            PG8_WAIT_V(8); PG8_WAIT_L(0); PG8_BAR; PG8_MMA(1, 0, At, B0); PG8_MMA(1, 1, At, B1); PG8_BAR; PG8_SCHED;
        }
        if (wr == 0) PG8_BAR;
        E(acc, cur, wr, wc, fr, fq);
        if (!has_next) break;
#pragma unroll
        for (int a = 0; a < 2; ++a)
#pragma unroll
            for (int b = 0; b < 2; ++b)
#pragma unroll
                for (int m = 0; m < 4; ++m)
#pragma unroll
                    for (int n = 0; n < 2; ++n) acc[a][b][m][n] = (f32x4){0.f, 0.f, 0.f, 0.f};
        cur = nxt; cA = nA; cB = nB; ++ui;
        if (wr == 1) PG8_BAR;
    }
    PG8_WAIT_V(0);
    PG8_BAR;
#undef PG8_SA
#undef PG8_SB
#undef PG8_STAGE_A
#undef PG8_STAGE_B
#undef PG8_LDA
#undef PG8_LDB
#undef PG8_MMA
#undef PG8_WAIT_V
#undef PG8_WAIT_L
#undef PG8_BAR
#undef PG8_SCHED
}

template <bool PAIR, class F, class Sched>
__device__ __forceinline__ void gemm_naive(const int K, const Sched& S, const F& f) {
    Unit u;
    for (int i = 0; S.next(i, u); ++i) {
        const int ncg = PAIR ? 16 : 32;
        for (int it = threadIdx.x; it < 256 * ncg; it += 512) {
            const int r = it & 255, c = (it >> 8) * 8;
            const char* ap = u.A + (Sched::GATHER ? (size_t)S.row_off(u, r) : (size_t)r * K * 2);
            float s0[8], s1[8];
#pragma unroll
            for (int j = 0; j < 8; ++j) { s0[j] = 0.f; s1[j] = 0.f; }
            for (int k = 0; k < K; k += 8) {
                float a[8]; unpack8(*(const u32x4*)(ap + (size_t)k * 2), a);
#pragma unroll
                for (int j = 0; j < 8; ++j) { float b[8]; unpack8(*(const u32x4*)(u.B + ((size_t)(c + j) * K + k) * 2), b);
#pragma unroll
                    for (int e = 0; e < 8; ++e) s0[j] += a[e] * b[e];
                    if constexpr (PAIR) { unpack8(*(const u32x4*)(u.B + ((size_t)(c + 128 + j) * K + k) * 2), b);
#pragma unroll
                        for (int e = 0; e < 8; ++e) s1[j] += a[e] * b[e]; } }
            }
            if constexpr (PAIR) f(u, r, c, s0, s1); else f(u, r, c, s0);
        }
    }
}
}

struct Args { const float* in[28]; float* out; unsigned char* ws; int ph_lo, ph_hi; };
enum { I_X = 0, I_N1G, I_WIN, I_QNG, I_KNG, I_RELB, I_WATT, I_MU, I_W0, I_WUP, I_A0, I_AUP, I_GUP, I_KK, I_KA, I_RK, I_LNW, I_LNB, I_WRWKV, I_WOUT, I_N2G, I_WGR, I_BGR, I_WER, I_BER, I_WEG, I_WEU, I_WED };

__device__ __forceinline__ void tr_item(bf16_t* WT, int Kd, int n0, int k0, const float* src, int ld, int ks0, int cs0, int kvalid, LAS float* scr, int lane) {
#pragma unroll 8
    for (int i = 0; i < 32; ++i) { const int kk = 2 * i + (lane >> 5); float v = 0.f; if (src != nullptr && kk < kvalid) v = src[(size_t)(ks0 + kk) * ld + cs0 + (lane & 31)]; scr[kk * 33 + (lane & 31)] = v; }
    LDS_WAIT();
    const int c = lane & 7;
#pragma unroll
    for (int j = 0; j < 4; ++j) { const int n = (lane >> 3) + 8 * j; const LAS float* s = scr + (8 * c) * 33 + n;
        u32x4 o; o.x = cvt_pk_bf16(s[0 * 33], s[1 * 33]); o.y = cvt_pk_bf16(s[2 * 33], s[3 * 33]); o.z = cvt_pk_bf16(s[4 * 33], s[5 * 33]); o.w = cvt_pk_bf16(s[6 * 33], s[7 * 33]);
        *(u32x4*)(WT + (size_t)(n0 + n) * Kd + k0 + 8 * c) = o; }
    LDS_WAIT();
}

__device__ __forceinline__ void p0_prologue(const Args& a, LAS unsigned char* lds, int wg, int G) {
    const int tid = threadIdx.x, lane = tid & 63, wave = tid >> 6;
    LAS float* scr = (LAS float*)(lds + wave * 16384);
    const int gw = wg * 8 + wave, NGW = G * 8;
    unsigned char* ws = a.ws;
    constexpr int I_IN = 200 * 16, I_ATT = 32 * 4, I_RWK = 32 * 8, I_OUT = 32 * 16, I_LORA = 48 * 6;
    for (int it = gw; it < I_IN + I_ATT + I_RWK + I_OUT + I_LORA; it += NGW) {
        int r = it;
        if (r < I_IN) { const int nb = r / 16, kb = r % 16, n0 = nb * 32; const float* src = a.in[I_WIN]; int cs0 = n0;
            if (n0 >= 4128 && n0 < 4352) src = nullptr; else if (n0 >= 4352) cs0 = 4128 + (n0 - 4352);
            tr_item((bf16_t*)(ws + WS_WIN), D, n0, kb * 64, src, 6176, kb * 64, cs0, 64, scr, lane); continue; } r -= I_IN;
        if (r < I_ATT) { const int nb = r / 4, kb = r % 4; tr_item((bf16_t*)(ws + WS_WATT), 256, nb * 32, kb * 64, a.in[I_WATT], D, kb * 64, nb * 32, 64, scr, lane); continue; } r -= I_ATT;
        if (r < I_RWK) { const int nb = r / 8, kb = r % 8; tr_item((bf16_t*)(ws + WS_WRWKV), 512, nb * 32, kb * 64, a.in[I_WRWKV], D, kb * 64, nb * 32, 64, scr, lane); continue; } r -= I_RWK;
        if (r < I_OUT) { const int nb = r / 16, kb = r % 16; tr_item((bf16_t*)(ws + WS_WOUT), D, nb * 32, kb * 64, a.in[I_WOUT], D, kb * 64, nb * 32, 64, scr, lane); continue; } r -= I_OUT;
        { const int nb = r / 6, kb = r % 6, n0 = nb * 32; const float* src = nullptr; int ks0 = 0, cs0 = 0, kv = 64;
            if (nb < 16) { if (kb == 0) { src = a.in[I_WUP]; cs0 = n0; } }
            else if (nb < 32) { if (kb == 1) { src = a.in[I_AUP]; cs0 = n0 - 512; } }
            else { if (kb >= 2 && kb <= 4) { src = a.in[I_GUP]; cs0 = n0 - 1024; ks0 = (kb - 2) * 64; kv = (kb == 4) ? 32 : 64; } }
            tr_item((bf16_t*)(ws + WS_WLORA), LK, n0, kb * 64, src, CR, ks0, cs0, kv, scr, lane); }
    }
    const float* x = a.in[I_X]; const float* gn = a.in[I_N1G]; bf16_t* H = (bf16_t*)(ws + WS_H);
    f32x4 g4[4];
#pragma unroll
    for (int j = 0; j < 4; ++j) g4[j] = *(const f32x4*)(gn + 4 * lane + 256 * j);
    for (int m = gw; m < T; m += NGW) {
        const f32x4* xr = (const f32x4*)(x + (size_t)m * D) + lane; f32x4 v[4]; float s = 0.f;
#pragma unroll
        for (int j = 0; j < 4; ++j) { v[j] = xr[64 * j]; s += (v[j].x * v[j].x + v[j].y * v[j].y) + (v[j].z * v[j].z + v[j].w * v[j].w); }
        const float rstd = rsqrtf(wave_sum(s) * (1.f / D) + 1e-6f);
        u32x2* o8 = (u32x2*)(H + (size_t)m * D) + lane;
#pragma unroll
        for (int j = 0; j < 4; ++j) { u32x2 o; o.x = cvt_pk_bf16(v[j].x * rstd * g4[j].x, v[j].y * rstd * g4[j].y); o.y = cvt_pk_bf16(v[j].z * rstd * g4[j].z, v[j].w * rstd * g4[j].w); o8[64 * j] = o; }
    }
}

struct FIn {
    bf16_t *Q, *PR, *GATE;
    __device__ __forceinline__ void operator()(const pg8::Unit& u, int r, int c, const float (&v)[8]) const {
        const size_t row = (size_t)u.pm * 256 + r; const int pn = u.pn;
        if (pn < 9) { bf16_t* base = Q + (size_t)(pn / 3) * ((size_t)T * AW); *(u32x4*)(base + row * AW + (pn % 3) * 256 + c) = pack8(v); }
        else if (pn < 17) { const int j = (pn - 9) * 256 + c; if (j < RW) *(u32x4*)(PR + row * RW + j) = pack8(v); }
        else { const int j = (pn - 17) * 256 + c; float s[8];
#pragma unroll
            for (int e = 0; e < 8; ++e) s[e] = sigmoidf_(v[e]);
            *(u32x4*)(GATE + row * 2048 + j) = pack8(s); }
    }
};
struct FLora {
    bf16_t* LAG; const float* w0; const float* a0;
    __device__ __forceinline__ void operator()(const pg8::Unit& u, int r, int c, const float (&v)[8]) const {
        const size_t row = (size_t)u.pm * 256 + r; const int col = u.pn * 256 + c, which = u.pn >> 1, cc = col & 511; float o[8];
        const float* bias = which == 0 ? w0 : a0;
        const f32x4 b0 = *(const f32x4*)(bias + cc), b1 = *(const f32x4*)(bias + cc + 4);
        const float bv[8] = {b0[0], b0[1], b0[2], b0[3], b1[0], b1[1], b1[2], b1[3]};
#pragma unroll
        for (int e = 0; e < 8; ++e) {
            const float z = bv[e] + v[e];
            const float sg = 1.f / (1.f + __expf(-z));
            const float sp = fmaxf(-z, 0.f) + __logf(1.f + __expf(-fabsf(z)));
            const float ld = -__expf(-sp - 0.5f);
            o[e] = which == 0 ? ld : (which == 1 ? sg : v[e]);
        }
        *(u32x4*)(LAG + row * 1536 + col) = pack8(o);
    }
};
struct FMix1 {
    bf16_t* MIXED; const bf16_t* GATE;
    __device__ __forceinline__ void operator()(const pg8::Unit& u, int r, int c, const float (&v)[8]) const {
        const size_t row = (size_t)u.pm * 256 + r; const int col = u.pn * 256 + c; float g[8], o[8]; unpack8(*(const u32x4*)(GATE + row * 2048 + col), g);
#pragma unroll
        for (int e = 0; e < 8; ++e) o[e] = g[e] * v[e];
        *(u32x4*)(MIXED + row * D + col) = pack8(o);
    }
};
struct FMix2 {
    bf16_t* MIXED; const bf16_t* GATE;
    __device__ __forceinline__ void operator()(const pg8::Unit& u, int r, int c, const float (&v)[8]) const {
        const size_t row = (size_t)u.pm * 256 + r; const int col = u.pn * 256 + c; float g[8], m[8], o[8]; unpack8(*(const u32x4*)(GATE + row * 2048 + 1024 + col), g);
        unpack8(*(const u32x4*)(MIXED + row * D + col), m);
#pragma unroll
        for (int e = 0; e < 8; ++e) o[e] = m[e] + g[e] * v[e];
        *(u32x4*)(MIXED + row * D + col) = pack8(o);
    }
};
struct FOut {
    const float* x; float* out;
    __device__ __forceinline__ void operator()(const pg8::Unit& u, int r, int c, const float (&v)[8]) const {
        const size_t off = ((size_t)u.pm * 256 + r) * D + u.pn * 256 + c; const f32x4 x0 = *(const f32x4*)(x + off), x1 = *(const f32x4*)(x + off + 4);
        *(f32x4*)(out + off) = (f32x4){x0[0] + v[0], x0[1] + v[1], x0[2] + v[2], x0[3] + v[3]}; *(f32x4*)(out + off + 4) = (f32x4){x1[0] + v[4], x1[1] + v[5], x1[2] + v[6], x1[3] + v[7]};
    }
};

struct MoeOrder {
    static constexpr bool GATHER = true;
    LAS int* tab; int K; const char* Abase; const char* Wbase; size_t wexp; int gatherA;
    __device__ bool next(int i, pg8::Unit& u) const {
        if (i >= 8) return false; const LAS int* d = tab + 160 + 4 * i; if (d[3] == 0) return false;
        const int l = d[0], rt = d[1], pn = d[2]; u.pm = rt; u.pn = pn; u.ui = i; u.aux = l;
        u.A = gatherA ? Abase : Abase + (size_t)(tab[l] + rt) * 256 * (size_t)K * 2;
        u.B = Wbase + (size_t)(l & 31) * wexp + (size_t)pn * 256 * (size_t)K * 2; return true;
    }
    __device__ __forceinline__ unsigned row_off(const pg8::Unit& u, int r) const {
        if (gatherA) { int tok = tab[256 + u.ui * 256 + r]; tok = tok < 0 ? 0 : tok; return (unsigned)tok * (unsigned)(K * 2); }
        return (unsigned)r * (unsigned)(K * 2);
    }
};
__device__ __forceinline__ void moe_tables(LAS int* tab, const unsigned* cnt, const int* lists, int l_lo, int l_hi, int wg, int G) {
    const int tid = threadIdx.x;
    __syncthreads();
    if (tid < 64) tab[80 + tid] = (int)cnt[tid];
    __syncthreads();
    if (tid == 0) { int s = 0; for (int l = 0; l < 64; ++l) { tab[l] = s; s += (tab[80 + l] + 255) >> 8; } tab[64] = s; }
    __syncthreads();
    const int t_lo = tab[l_lo], t_hi = tab[l_hi];
    if (tid < 8) { const int L = tid * G + wg, tile = t_lo + (L >> 2); LAS int* d = tab + 160 + 4 * tid;
        if (tile < t_hi) { int l = l_lo; while (tab[l + 1] <= tile) ++l; d[0] = l; d[1] = tile - tab[l]; d[2] = L & 3; d[3] = 1; } else { d[0] = 0; d[1] = 0; d[2] = 0; d[3] = 0; } }
    __syncthreads();
    for (int i = 0; i < 8; ++i) { const LAS int* d = tab + 160 + 4 * i; if (d[3] == 0) break; const int l = d[0], rt = d[1];
        if (tid < 256) { const int pos = rt * 256 + tid; tab[256 + i * 256 + tid] = pos < tab[80 + l] ? lists[(size_t)l * T + pos] : -1; } }
    __syncthreads();
}
struct FGU {
    bf16_t* HID; const LAS int* tab;
    __device__ __forceinline__ void operator()(const pg8::Unit& u, int r, int c, const float (&g)[8], const float (&up)[8]) const {
        const size_t hrow = (size_t)(tab[u.aux] + u.pm) * 256 + r; float o[8];
#pragma unroll
        for (int e = 0; e < 8; ++e) o[e] = g[e] * sigmoidf_(g[e]) * up[e];
        *(u32x4*)(HID + hrow * DE + u.pn * 128 + c) = pack8(o);
    }
};
struct FDown {
    float* out; const float* tokg; const LAS int* tab; int k;
    __device__ __forceinline__ void operator()(const pg8::Unit& u, int r, int c, const float (&v)[8]) const {
        const int tok = tab[256 + u.ui * 256 + r]; if (tok < 0) return;
        const float g = tokg[tok * 2 + k]; float* p = out + (size_t)tok * D + u.pn * 256 + c; const f32x4 x0 = *(const f32x4*)p, x1 = *(const f32x4*)(p + 4);
        *(f32x4*)p = (f32x4){x0[0] + g * v[0], x0[1] + g * v[1], x0[2] + g * v[2], x0[3] + g * v[3]}; *(f32x4*)(p + 4) = (f32x4){x1[0] + g * v[4], x1[1] + g * v[5], x1[2] + g * v[6], x1[3] + g * v[7]};
    }
};

__device__ __forceinline__ void p2_lora_in(const Args& a, int wg, int G) {
    const bf16_t* PR = (const bf16_t*)(a.ws + WS_PR); bf16_t* AP = (bf16_t*)(a.ws + WS_H); const float* mu = a.in[I_MU];
    for (int it = wg * 512 + threadIdx.x; it < T * 48; it += G * 512) {
        const int t = it / 48, j = (it % 48) * 8; float o[8];
        if (j < 288) { float p[8], q[8]; unpack8(*(const u32x4*)(PR + (size_t)t * RW + 1536 + j), p);
            if ((t & (SEQ - 1)) != 0) unpack8(*(const u32x4*)(PR + (size_t)(t - 1) * RW + 1536 + j), q); else {
#pragma unroll
                for (int e = 0; e < 8; ++e) q[e] = 0.f; }
#pragma unroll
            for (int e = 0; e < 8; ++e) { const float pm = p[e] + (q[e] - p[e]) * mu[1536 + j + e]; o[e] = j < 64 ? tanhf(pm) : (j < 128 ? pm : sigmoidf_(pm)); }
        } else {
#pragma unroll
            for (int e = 0; e < 8; ++e) o[e] = 0.f; }
        *(u32x4*)(AP + (size_t)t * LK + j) = pack8(o);
    }
}

__device__ __forceinline__ void scan_unit(const Args& a, LAS unsigned char* lds, int b, int hd) {
    constexpr int TC = 32;
    LAS float* buf = (LAS float*)lds;
    LAS float* obuf = buf + 2 * TC * 7 * 64;
    LAS float* bon = obuf + TC * 64;
    const int tid = threadIdx.x, w = tid >> 6, lane = tid & 63, c = lane & 15, rp = lane >> 4;
    const int row0 = 8 * w + rp, row1 = row0 + 4;
    const int tt = tid >> 4, d4 = (tid & 15) * 4, ch0 = hd * 64 + d4;
    const bf16_t* PR = (const bf16_t*)(a.ws + WS_PR); const bf16_t* LAG = (const bf16_t*)(a.ws + WS_LAG); bf16_t* ORW = (bf16_t*)(a.ws + WS_ORW);
    const f32x4 mu_r = *(const f32x4*)(a.in[I_MU] + ch0), mu_k = *(const f32x4*)(a.in[I_MU] + 512 + ch0), mu_v = *(const f32x4*)(a.in[I_MU] + 1024 + ch0);
    const f32x4 kkp = *(const f32x4*)(a.in[I_KK] + ch0), kap = *(const f32x4*)(a.in[I_KA] + ch0), rkp = *(const f32x4*)(a.in[I_RK] + ch0);
    const f32x4 lnw = *(const f32x4*)(a.in[I_LNW] + ch0), lnb = *(const f32x4*)(a.in[I_LNB] + ch0);
    float S0[4] = {0.f, 0.f, 0.f, 0.f}, S1[4] = {0.f, 0.f, 0.f, 0.f};
    u32x2 pr_r, pr_k, pr_v, pp_r, pp_k, pp_v, p_ld, p_a, p_g;
    auto prefetch = [&](int ch) {
        const int s = ch * TC + tt; const size_t t = (size_t)b * SEQ + s;
        pr_r = *(const u32x2*)(PR + t * RW + ch0); pr_k = *(const u32x2*)(PR + t * RW + 512 + ch0); pr_v = *(const u32x2*)(PR + t * RW + 1024 + ch0);
        if (s > 0) { pp_r = *(const u32x2*)(PR + (t - 1) * RW + ch0); pp_k = *(const u32x2*)(PR + (t - 1) * RW + 512 + ch0); pp_v = *(const u32x2*)(PR + (t - 1) * RW + 1024 + ch0); }
        else { pp_r = (u32x2){0u, 0u}; pp_k = pp_r; pp_v = pp_r; }
        p_ld = *(const u32x2*)(LAG + t * 1536 + ch0); p_a = *(const u32x2*)(LAG + t * 1536 + 512 + ch0); p_g = *(const u32x2*)(LAG + t * 1536 + 1024 + ch0);
    };
    prefetch(0);
    for (int ch = 0; ch < SEQ / TC; ++ch) {
        const int bi = ch & 1; LAS float* B = buf + bi * (TC * 7 * 64) + tt * (7 * 64);
        {
            float r[4], k[4], v[4], pr[4], pk[4], pv[4], ld[4], aa[4], g[4];
            unpack4(pr_r, r); unpack4(pr_k, k); unpack4(pr_v, v); unpack4(pp_r, pr); unpack4(pp_k, pk); unpack4(pp_v, pv); unpack4(p_ld, ld); unpack4(p_a, aa); unpack4(p_g, g);
            float kk[4], kp[4], bb[4], wv[4]; float ssq = 0.f, bsum = 0.f;
#pragma unroll
            for (int e = 0; e < 4; ++e) { r[e] = r[e] + (pr[e] - r[e]) * mu_r[e]; k[e] = k[e] + (pk[e] - k[e]) * mu_k[e]; v[e] = v[e] + (pv[e] - v[e]) * mu_v[e];
                wv[e] = __expf(ld[e]); kk[e] = k[e] * kkp[e]; ssq += kk[e] * kk[e]; kp[e] = k[e] * (1.f + (aa[e] - 1.f) * kap[e]); bsum += r[e] * kp[e] * rkp[e]; }
            ssq = red16(ssq); bsum = red16(bsum);
            const float inv = 1.f / fmaxf(sqrtf(ssq), 1e-12f);
#pragma unroll
            for (int e = 0; e < 4; ++e) { kk[e] *= inv; bb[e] = kk[e] * aa[e]; }
            *(LAS f32x4*)(B + 0 * 64 + d4) = (f32x4){kk[0], kk[1], kk[2], kk[3]};
            *(LAS f32x4*)(B + 1 * 64 + d4) = (f32x4){wv[0], wv[1], wv[2], wv[3]};
            *(LAS f32x4*)(B + 2 * 64 + d4) = (f32x4){bb[0], bb[1], bb[2], bb[3]};
            *(LAS f32x4*)(B + 3 * 64 + d4) = (f32x4){kp[0], kp[1], kp[2], kp[3]};
            *(LAS f32x4*)(B + 4 * 64 + d4) = (f32x4){r[0], r[1], r[2], r[3]};
            *(LAS f32x4*)(B + 5 * 64 + d4) = (f32x4){v[0], v[1], v[2], v[3]};
            *(LAS f32x4*)(B + 6 * 64 + d4) = (f32x4){g[0], g[1], g[2], g[3]};
            if ((tid & 15) == 0) bon[bi * TC + tt] = bsum;
        }
        if (ch + 1 < SEQ / TC) prefetch(ch + 1);
        __syncthreads();
        {
            const LAS float* Bc = buf + bi * (TC * 7 * 64);
#pragma unroll 2
            for (int s = 0; s < TC; ++s) {
                const LAS float* Bs = Bc + s * (7 * 64);
                const f32x4 kk4 = *(const LAS f32x4*)(Bs + 0 * 64 + 4 * c), w4 = *(const LAS f32x4*)(Bs + 1 * 64 + 4 * c), b4 = *(const LAS f32x4*)(Bs + 2 * 64 + 4 * c);
                const f32x4 k4 = *(const LAS f32x4*)(Bs + 3 * 64 + 4 * c), r4 = *(const LAS f32x4*)(Bs + 4 * 64 + 4 * c);
                const float v0 = Bs[5 * 64 + row0], v1 = Bs[5 * 64 + row1];
                float p0 = S0[0] * kk4[0] + S0[1] * kk4[1] + S0[2] * kk4[2] + S0[3] * kk4[3];
                float p1 = S1[0] * kk4[0] + S1[1] * kk4[1] + S1[2] * kk4[2] + S1[3] * kk4[3];
                p0 = red16(p0); p1 = red16(p1);
                float q0 = 0.f, q1 = 0.f;
#pragma unroll
                for (int e = 0; e < 4; ++e) { S0[e] = S0[e] * w4[e] + (v0 * k4[e] - p0 * b4[e]); S1[e] = S1[e] * w4[e] + (v1 * k4[e] - p1 * b4[e]); q0 += S0[e] * r4[e]; q1 += S1[e] * r4[e]; }
                q0 = red16(q0); q1 = red16(q1);
                if (c == 0) { obuf[s * 64 + row0] = q0; obuf[s * 64 + row1] = q1; }
            }
        }
        __syncthreads();
        {
            const f32x4 o4 = *(const LAS f32x4*)(obuf + tt * 64 + d4); const f32x4 v4 = *(const LAS f32x4*)(B + 5 * 64 + d4), g4 = *(const LAS f32x4*)(B + 6 * 64 + d4);
            const float mean = red16((o4[0] + o4[1]) + (o4[2] + o4[3])) * (1.f / 64.f);
            float dv[4], q = 0.f;
#pragma unroll
            for (int e = 0; e < 4; ++e) { dv[e] = o4[e] - mean; q += dv[e] * dv[e]; }
            const float rs = rsqrtf(red16(q) * (1.f / 64.f) + 64e-5f), bs = bon[bi * TC + tt];
            float y[4];
#pragma unroll
            for (int e = 0; e < 4; ++e) y[e] = (dv[e] * rs * lnw[e] + lnb[e] + bs * v4[e]) * g4[e];
            const size_t t = (size_t)b * SEQ + ch * TC + tt;
            u32x2 o; o.x = cvt_pk_bf16(y[0], y[1]); o.y = cvt_pk_bf16(y[2], y[3]);
            *(u32x2*)(ORW + t * CR + ch0) = o;
        }
    }
    __syncthreads();
}

__device__ __forceinline__ int t5_bucket(int dist) {
    if (dist < 16) return dist;
    const float d = (float)dist; int large = 16 + (int)(logf(d / 16.f) / 4.852030263919617f * 16.f); return large < 31 ? large : 31;
}
__device__ __forceinline__ void attn_unit(const Args& a, LAS unsigned char* lds, int unit) {
    const int g = unit >> 10, rem = unit & 1023; int dil, b, r, hd, n;
    b = rem >> 6;
    if (g == 0) { dil = 1; r = 0; hd = (rem >> 4) & 3; n = rem & 15; }
    else if (g == 1) { dil = 4; r = (rem >> 4) & 3; hd = (rem >> 2) & 3; n = rem & 3; }
    else { dil = 16; r = (rem >> 2) & 15; hd = rem & 3; n = 0; }
    const int head = 4 * g + hd, colq = head * 64;
    const bf16_t* Q = (const bf16_t*)(a.ws + WS_QKV); const bf16_t* Kb = Q + (size_t)T * AW; const bf16_t* Vb = Kb + (size_t)T * AW;
    LAS bf16_t* Ks = (LAS bf16_t*)lds;
    LAS bf16_t* VT = (LAS bf16_t*)(lds + 36864);
    LAS float* bias = (LAS float*)(lds + 36864 + 33792);
    const int tid = threadIdx.x, lane = tid & 63, w = tid >> 6;
    __syncthreads();
    {
        const int key = tid >> 1, half = tid & 1, lk = 128 * (n - 1) + key;
        float kv[32], vv[32];
        if (lk >= 0) { const size_t tok = (size_t)b * SEQ + (size_t)lk * dil + r; const u32x4* kp = (const u32x4*)(Kb + tok * AW + colq + 32 * half); const u32x4* vp = (const u32x4*)(Vb + tok * AW + colq + 32 * half);
#pragma unroll
            for (int j = 0; j < 4; ++j) { float t8[8]; unpack8(kp[j], t8);
#pragma unroll
                for (int e = 0; e < 8; ++e) kv[8 * j + e] = t8[e];
                unpack8(vp[j], t8);
#pragma unroll
                for (int e = 0; e < 8; ++e) vv[8 * j + e] = t8[e]; }
        } else {
#pragma unroll
            for (int e = 0; e < 32; ++e) { kv[e] = 0.f; vv[e] = 0.f; } }
        float ssq = 0.f;
#pragma unroll
        for (int e = 0; e < 32; ++e) ssq += kv[e] * kv[e];
        ssq += __shfl_xor(ssq, 1);
        const float rstd = rsqrtf(ssq * (1.f / 64.f) + 1e-6f); const float* kg = a.in[I_KNG] + g * 64 + 32 * half;
#pragma unroll
        for (int j = 0; j < 4; ++j) { float t8[8];
#pragma unroll
            for (int e = 0; e < 8; ++e) t8[e] = kv[8 * j + e] * rstd * kg[8 * j + e];
            *(LAS u32x4*)(Ks + key * 72 + 32 * half + 8 * j) = pack8(t8); }
#pragma unroll
        for (int e = 0; e < 32; e += 2) { const unsigned pk = cvt_pk_bf16(vv[e], vv[e + 1]); VT[(32 * half + e) * 264 + key] = (bf16_t)(pk & 0xffffu); VT[(32 * half + e + 1) * 264 + key] = (bf16_t)(pk >> 16); }
        if (tid < 129) bias[tid] = a.in[I_RELB][t5_bucket(tid * dil) * 12 + head];
    }
    __syncthreads();
    const int iq = lane & 15, rg = lane >> 4, qi = 16 * w + iq;
    const size_t tq = (size_t)b * SEQ + (size_t)(128 * n + qi) * dil + r;
    bf16x8 qf[2];
    {
        float q0[8], q1[8]; unpack8(*(const u32x4*)(Q + tq * AW + colq + 8 * rg), q0); unpack8(*(const u32x4*)(Q + tq * AW + colq + 32 + 8 * rg), q1);
        float ssq = 0.f;
#pragma unroll
        for (int e = 0; e < 8; ++e) ssq += q0[e] * q0[e] + q1[e] * q1[e];
        ssq += __shfl_xor(ssq, 16); ssq += __shfl_xor(ssq, 32);
        const float rstd = rsqrtf(ssq * (1.f / 64.f) + 1e-6f) * 0.125f; const float* qg = a.in[I_QNG] + g * 64;
#pragma unroll
        for (int e = 0; e < 8; ++e) { q0[e] *= rstd * qg[8 * rg + e]; q1[e] *= rstd * qg[32 + 8 * rg + e]; }
        qf[0] = __builtin_bit_cast(bf16x8, pack8(q0)); qf[1] = __builtin_bit_cast(bf16x8, pack8(q1));
    }
    const int u0 = w >> 1;
    f32x4 s[10];
#pragma unroll
    for (int j = 0; j < 10; ++j) { const int kt = 2 * u0 + j;
        const bf16x8 k0 = *(const LAS bf16x8*)(Ks + (16 * kt + iq) * 72 + 8 * rg), k1 = *(const LAS bf16x8*)(Ks + (16 * kt + iq) * 72 + 32 + 8 * rg);
        f32x4 z = (f32x4){0.f, 0.f, 0.f, 0.f};
        z = __builtin_amdgcn_mfma_f32_16x16x32_bf16(k0, qf[0], z, 0, 0, 0); s[j] = __builtin_amdgcn_mfma_f32_16x16x32_bf16(k1, qf[1], z, 0, 0, 0); }
    float mx = -1e30f;
#pragma unroll
    for (int j = 0; j < 10; ++j)
#pragma unroll
        for (int e = 0; e < 4; ++e) { const int kj = 16 * (2 * u0 + j) + 4 * rg + e, rel = qi + 128 - kj; const bool ok = (rel >= 0) && (rel <= 128) && (n > 0 || kj >= 128);
            const int rc = rel < 0 ? 0 : (rel > 128 ? 128 : rel); const float sc = ok ? s[j][e] + bias[rc] : -1e30f; s[j][e] = sc; mx = fmaxf(mx, sc); }
    mx = fmaxf(mx, __shfl_xor(mx, 16)); mx = fmaxf(mx, __shfl_xor(mx, 32));
    float l = 0.f;
#pragma unroll
    for (int j = 0; j < 10; ++j)
#pragma unroll
        for (int e = 0; e < 4; ++e) { const float p = __expf(s[j][e] - mx); s[j][e] = p; l += p; }
    l += __shfl_xor(l, 16); l += __shfl_xor(l, 32);
    f32x4 oacc[4];
#pragma unroll
    for (int dt = 0; dt < 4; ++dt) oacc[dt] = (f32x4){0.f, 0.f, 0.f, 0.f};
#pragma unroll
    for (int ub = 0; ub < 5; ++ub) {
        u32x4 pw; pw.x = cvt_pk_bf16(s[2 * ub][0], s[2 * ub][1]); pw.y = cvt_pk_bf16(s[2 * ub][2], s[2 * ub][3]); pw.z = cvt_pk_bf16(s[2 * ub + 1][0], s[2 * ub + 1][1]); pw.w = cvt_pk_bf16(s[2 * ub + 1][2], s[2 * ub + 1][3]);
        const bf16x8 pf = __builtin_bit_cast(bf16x8, pw); const int kb = 32 * (u0 + ub) + 4 * rg;
#pragma unroll
        for (int dt = 0; dt < 4; ++dt) { const LAS bf16_t* vp = VT + (16 * dt + iq) * 264 + kb; const u32x2 lo = *(const LAS u32x2*)vp, hi = *(const LAS u32x2*)(vp + 16);
            u32x4 vw; vw.x = lo.x; vw.y = lo.y; vw.z = hi.x; vw.w = hi.y;
            oacc[dt] = __builtin_amdgcn_mfma_f32_16x16x32_bf16(__builtin_bit_cast(bf16x8, vw), pf, oacc[dt], 0, 0, 0); }
    }
    const float il = 1.f / l;
    bf16_t* OG = (bf16_t*)(a.ws + WS_OG) + (size_t)g * T * 256; float* LSE = (float*)(a.ws + WS_LSE) + (size_t)g * T * 4;
#pragma unroll
    for (int dt = 0; dt < 4; ++dt) { u32x2 o; o.x = cvt_pk_bf16(oacc[dt][0] * il, oacc[dt][1] * il); o.y = cvt_pk_bf16(oacc[dt][2] * il, oacc[dt][3] * il);
        *(u32x2*)(OG + tq * 256 + hd * 64 + 16 * dt + 4 * rg) = o; }
    if (rg == 0) LSE[tq * 4 + hd] = mx + logf(l);
}

__device__ __forceinline__ void p5_combine(const Args& a, int wg, int G) {
    const bf16_t* OG = (const bf16_t*)(a.ws + WS_OG); const float* LSE = (const float*)(a.ws + WS_LSE); bf16_t* ATT = (bf16_t*)(a.ws + WS_ATT);
    for (int it = wg * 512 + threadIdx.x; it < T * 32; it += G * 512) {
        const int t = it >> 5, hs = (it >> 3) & 3, d8 = (it & 7) * 8;
        const float l0 = LSE[(size_t)t * 4 + hs], l1 = LSE[(size_t)T * 4 + (size_t)t * 4 + hs], l2 = LSE[(size_t)2 * T * 4 + (size_t)t * 4 + hs];
        const float m = fmaxf(l0, fmaxf(l1, l2)); float w0 = __expf(l0 - m), w1 = __expf(l1 - m), w2 = __expf(l2 - m); const float iz = 1.f / (w0 + w1 + w2); w0 *= iz; w1 *= iz; w2 *= iz;
        float o0[8], o1[8], o2[8], o[8]; const size_t off = (size_t)t * 256 + hs * 64 + d8;
        unpack8(*(const u32x4*)(OG + off), o0); unpack8(*(const u32x4*)(OG + (size_t)T * 256 + off), o1); unpack8(*(const u32x4*)(OG + (size_t)2 * T * 256 + off), o2);
#pragma unroll
        for (int e = 0; e < 8; ++e) o[e] = w0 * o0[e] + w1 * o1[e] + w2 * o2[e];
        *(u32x4*)(ATT + off) = pack8(o);
    }
}

__device__ __forceinline__ void p8_router(const Args& a, LAS unsigned char* lds, int wg, int G) {
    const int tid = threadIdx.x, lane = tid & 63, wave = tid >> 6; const int gw = wg * 8 + wave, NGW = G * 8;
    unsigned char* ws = a.ws;
    {
        LAS float* scr = (LAS float*)(lds + wave * 16384);
        constexpr int I_GU = 32 * 32 * 16, I_DN = 32 * 32 * 8;
        for (int it = gw; it < I_GU + I_DN; it += NGW) {
            if (it < I_GU) { const int e = it >> 9, r = it & 511, nb = r >> 4, kb = r & 15, n0 = nb * 32, pn = n0 >> 8, j = n0 & 255;
                const float* src = (j < 128 ? a.in[I_WEG] : a.in[I_WEU]) + (size_t)e * D * DE;
                tr_item((bf16_t*)(ws + WS_WGU) + (size_t)e * 1024 * 1024, D, n0, kb * 64, src, DE, kb * 64, 128 * pn + (j & 127), 64, scr, lane); }
            else { const int r0 = it - I_GU, e = r0 >> 8, r = r0 & 255, nb = r >> 3, kb = r & 7;
                tr_item((bf16_t*)(ws + WS_WD) + (size_t)e * 1024 * 512, DE, nb * 32, kb * 64, a.in[I_WED] + (size_t)e * DE * D, D, kb * 64, nb * 32, 64, scr, lane); }
        }
    }
    const float* x2 = a.out; const float* gn = a.in[I_N2G]; bf16_t* H2 = (bf16_t*)(ws + WS_H);
    const float* Wg = a.in[I_WGR]; const float* We = a.in[I_WER]; const float* bg = a.in[I_BGR]; const float* be = a.in[I_BER];
    unsigned* cnt = (unsigned*)(ws + WS_CTL) + CW_CNT; int* lists = (int*)(ws + WS_LIST); float* tokg = (float*)(ws + WS_TOKG);
    f32x4 g4[4];
#pragma unroll
    for (int j = 0; j < 4; ++j) g4[j] = *(const f32x4*)(gn + 4 * lane + 256 * j);
    for (int m = gw; m < T; m += NGW) {
        const f32x4* xr = (const f32x4*)(x2 + (size_t)m * D) + lane; f32x4 v[4]; float s = 0.f;
#pragma unroll
        for (int j = 0; j < 4; ++j) { v[j] = xr[64 * j]; s += (v[j].x * v[j].x + v[j].y * v[j].y) + (v[j].z * v[j].z + v[j].w * v[j].w); }
        const float rstd = rsqrtf(wave_sum(s) * (1.f / D) + 1e-6f);
        u32x2* o8 = (u32x2*)(H2 + (size_t)m * D) + lane;
        float lg[4] = {0.f, 0.f, 0.f, 0.f}, le[32];
        int ln = lane; asm volatile("" : "+v"(ln));
#pragma unroll
        for (int e = 0; e < 32; ++e) le[e] = 0.f;
#pragma unroll
        for (int j = 0; j < 4; ++j) { v[j].x *= rstd * g4[j].x; v[j].y *= rstd * g4[j].y; v[j].z *= rstd * g4[j].z; v[j].w *= rstd * g4[j].w;
            u32x2 o; o.x = cvt_pk_bf16(v[j].x, v[j].y); o.y = cvt_pk_bf16(v[j].z, v[j].w); o8[64 * j] = o;
#pragma unroll
            for (int q = 0; q < 4; ++q) { const int c = 4 * ln + 256 * j + q; const float h = v[j][q];
                const f32x4 wg4 = *(const f32x4*)(Wg + (size_t)c * 4); lg[0] += h * wg4[0]; lg[1] += h * wg4[1]; lg[2] += h * wg4[2]; lg[3] += h * wg4[3];
#pragma unroll
                for (int e4 = 0; e4 < 8; ++e4) { const f32x4 w4 = *(const f32x4*)(We + (size_t)c * 32 + 4 * e4); le[4 * e4 + 0] += h * w4[0]; le[4 * e4 + 1] += h * w4[1]; le[4 * e4 + 2] += h * w4[2]; le[4 * e4 + 3] += h * w4[3]; }
                asm volatile("" ::: "memory"); } }
#pragma unroll
        for (int e = 0; e < 4; ++e) lg[e] = wave_sum(lg[e]) + bg[e];
#pragma unroll
        for (int e = 0; e < 32; ++e) le[e] = wave_sum(le[e]) + be[e];
        int grp = 0; float gm = lg[0];
#pragma unroll
        for (int e = 1; e < 4; ++e) if (lg[e] > gm) { gm = lg[e]; grp = e; }
        float gz = 0.f;
#pragma unroll
        for (int e = 0; e < 4; ++e) gz += __expf(lg[e] - gm);
        const float grp_p = 1.f / gz;
        float sel[8];
#pragma unroll
        for (int e = 0; e < 8; ++e) sel[e] = grp == 0 ? le[e] : (grp == 1 ? le[8 + e] : (grp == 2 ? le[16 + e] : le[24 + e]));
        int i1 = 0; float m1 = sel[0];
#pragma unroll
        for (int e = 1; e < 8; ++e) if (sel[e] > m1) { m1 = sel[e]; i1 = e; }
        int i2 = -1; float m2 = -3.0e38f;
#pragma unroll
        for (int e = 0; e < 8; ++e) if (e != i1 && sel[e] > m2) { m2 = sel[e]; i2 = e; }
        const float e2 = __expf(m2 - m1), gate1 = grp_p / (1.f + e2), gate2 = grp_p * e2 / (1.f + e2);
        if (lane == 0) { const int l1 = grp * 8 + i1, l2 = 32 + grp * 8 + i2;
            const unsigned p1 = atomicAdd(cnt + l1, 1u), p2 = atomicAdd(cnt + l2, 1u);
            lists[(size_t)l1 * T + p1] = m; lists[(size_t)l2 * T + p2] = m; tokg[(size_t)m * 2] = gate1; tokg[(size_t)m * 2 + 1] = gate2; }
    }
}

__global__ void __launch_bounds__(512, 2) hybrid_fwd(Args args) {
    extern __shared__ __attribute__((aligned(16))) unsigned char lds_raw[];
    LAS unsigned char* lds = (LAS unsigned char*)lds_raw;
    const int tid = threadIdx.x, wg = blockIdx.x, G = gridDim.x;
    unsigned char* ws = args.ws;
    volatile LAS unsigned* MISC = (volatile LAS unsigned*)(lds + LDS_MISC);
    if (tid < 16) MISC[tid] = 0u;
    __syncthreads();
    XcdBarrier bar; bar.bar = (unsigned*)(ws + WS_CTL) + CW_BAR; bar.x = 0; bar.st = nullptr;
    if (MK_N_LAUNCHES == 1) bar = xcd_barrier_post((unsigned*)(ws + WS_CTL) + CW_BAR, MISC);
    const int lo = args.ph_lo, hi = args.ph_hi;
#ifndef PHASE_MASK
#define PHASE_MASK 0xFFF
#endif
#define IN(k) (((PHASE_MASK >> (k)) & 1) && lo <= (k) && (k) < hi)
#define SEAM(k) do { if (IN(k) && IN((k) + 1)) xcd_barrier(bar); } while (0)
#define NAIVE(k) ((NAIVE_GEMM_MASK >> (k)) & 1)

    if (IN(0)) { p0_prologue(args, lds, wg, G); }
    SEAM(0);
    if (IN(1)) {
        pg8::StaticOrder S; S.init(ws + WS_H, ws + WS_WIN, T, NIN, D, G, wg);
        FIn f{(bf16_t*)(ws + WS_QKV), (bf16_t*)(ws + WS_PR), (bf16_t*)args.out};
        if (NAIVE(1)) pg8::gemm_naive<false>(D, S, f); else { pg8::EpiRow8<FIn> E{f}; pg8::gemm_phase(lds, D, S, E); }
    }
    SEAM(1);
    if (IN(2)) { p2_lora_in(args, wg, G); }
    SEAM(2);
    if (IN(3)) {
        pg8::StaticOrder S; S.init(ws + WS_H, ws + WS_WLORA, T, 1536, LK, G, wg);
        FLora f{(bf16_t*)(ws + WS_LAG), args.in[I_W0], args.in[I_A0]};
        if (NAIVE(3)) pg8::gemm_naive<false>(LK, S, f); else { pg8::EpiRow8<FLora> E{f}; pg8::gemm_phase(lds, LK, S, E); }
    }
    SEAM(3);
    if (IN(4)) {
        const int nscan = G / 2;
        if (wg < nscan) { for (int u = wg; u < BATCH * 8; u += nscan) scan_unit(args, lds, u >> 3, u & 7); }
        else { for (int u = wg - nscan; u < 3072; u += G - nscan) attn_unit(args, lds, u); }
    }
    SEAM(4);
    if (IN(5)) { p5_combine(args, wg, G); }
    SEAM(5);
    if (IN(6)) {
        { pg8::StaticOrder S; S.init(ws + WS_ATT, ws + WS_WATT, T, D, 256, G, wg);
          FMix1 f{(bf16_t*)(ws + WS_H), (const bf16_t*)args.out};
          if (NAIVE(6)) pg8::gemm_naive<false>(256, S, f); else { pg8::EpiRow8<FMix1> E{f}; pg8::gemm_phase(lds, 256, S, E); } }
        VM_WAIT(); __syncthreads();
        { pg8::StaticOrder S; S.init(ws + WS_ORW, ws + WS_WRWKV, T, D, CR, G, wg);
          FMix2 f{(bf16_t*)(ws + WS_H), (const bf16_t*)args.out};
          if (NAIVE(6)) pg8::gemm_naive<false>(CR, S, f); else { pg8::EpiRow8<FMix2> E{f}; pg8::gemm_phase(lds, CR, S, E); } }
    }
    SEAM(6);
    if (IN(7)) {
        pg8::StaticOrder S; S.init(ws + WS_H, ws + WS_WOUT, T, D, D, G, wg);
        FOut f{args.in[I_X], args.out};
        if (NAIVE(7)) pg8::gemm_naive<false>(D, S, f); else { pg8::EpiRow8<FOut> E{f}; pg8::gemm_phase(lds, D, S, E); }
    }
    SEAM(7);
    if (IN(8)) { p8_router(args, lds, wg, G); }
    SEAM(8);
    LAS int* tab = (LAS int*)(lds + LDS_TAB);
    const unsigned* cnt = (const unsigned*)(ws + WS_CTL) + CW_CNT; const int* lists = (const int*)(ws + WS_LIST);
    if (IN(9)) {
        moe_tables(tab, cnt, lists, 0, 64, wg, G);
        MoeOrder S{tab, D, (const char*)(ws + WS_H), (const char*)(ws + WS_WGU), (size_t)1024 * 1024 * 2, 1};
        FGU f{(bf16_t*)(ws + WS_HID), tab};
        if (NAIVE(9)) pg8::gemm_naive<true>(D, S, f); else { pg8::EpiPair8<FGU> E{f}; pg8::gemm_phase(lds, D, S, E); }
    }
    SEAM(9);
    if (IN(10)) {
        moe_tables(tab, cnt, lists, 0, 32, wg, G);
        MoeOrder S{tab, DE, (const char*)(ws + WS_HID), (const char*)(ws + WS_WD), (size_t)1024 * 512 * 2, 0};
        FDown f{args.out, (const float*)(ws + WS_TOKG), tab, 0};
        if (NAIVE(10)) pg8::gemm_naive<false>(DE, S, f); else { pg8::EpiRow8<FDown> E{f}; pg8::gemm_phase(lds, DE, S, E); }
    }
    SEAM(10);
    if (IN(11)) {
        moe_tables(tab, cnt, lists, 32, 64, wg, G);
        MoeOrder S{tab, DE, (const char*)(ws + WS_HID), (const char*)(ws + WS_WD), (size_t)1024 * 512 * 2, 0};
        FDown f{args.out, (const float*)(ws + WS_TOKG), tab, 1};
        if (NAIVE(11)) pg8::gemm_naive<false>(DE, S, f); else { pg8::EpiRow8<FDown> E{f}; pg8::gemm_phase(lds, DE, S, E); }
    }
#undef IN
#undef SEAM
#undef NAIVE
}

extern "C" void kernel_launch(void* const* d_in, const int* in_sizes, int n_in, void* d_out, int out_size, void* d_ws, size_t ws_size, hipStream_t stream) {
    static int grid = 0;
    if (grid == 0) {
        if (n_in != 28 || out_size != T * D || ws_size < WS_END) { fprintf(stderr, "kernel_launch: unexpected problem (n_in %d, out %d, ws %zu)\n", n_in, out_size, ws_size); grid = -1; return; }
        int dev = 0, cus = 0;
        if (hipGetDevice(&dev) != hipSuccess || hipDeviceGetAttribute(&cus, hipDeviceAttributeMultiprocessorCount, dev) != hipSuccess) { grid = -1; return; }
        if (hipFuncSetAttribute((const void*)hybrid_fwd, hipFuncAttributeMaxDynamicSharedMemorySize, LDS_BYTES) != hipSuccess) { fprintf(stderr, "kernel_launch: hipFuncSetAttribute failed\n"); grid = -1; return; }
        int per_cu = 0;
        if (hipOccupancyMaxActiveBlocksPerMultiprocessor(&per_cu, (const void*)hybrid_fwd, 512, LDS_BYTES) != hipSuccess || per_cu < 1) fprintf(stderr, "kernel_launch: occupancy query reports %d\n", per_cu);
        (void)hipGetLastError();
        grid = cus;
    }
    if (grid < 0) return;
    (void)hipMemsetAsync((char*)d_ws + WS_CTL, 0, CTL_ZERO_BYTES, stream);
    Args a{};
    for (int i = 0; i < 28; ++i) a.in[i] = (const float*)d_in[i];
    a.out = (float*)d_out; a.ws = (unsigned char*)d_ws;
    if (MK_N_LAUNCHES == 1) { a.ph_lo = 0; a.ph_hi = NPH; hipLaunchKernelGGL(hybrid_fwd, dim3(grid), dim3(512), LDS_BYTES, stream, a); }
    else { for (int p = 0; p < NPH; ++p) { a.ph_lo = p; a.ph_hi = p + 1; hipLaunchKernelGGL(hybrid_fwd, dim3(grid), dim3(512), LDS_BYTES, stream, a); } }
}
```

```cpp
#include <hip/hip_runtime.h>
#include <cstdio>
#include <cstdint>

#ifndef MK_N_LAUNCHES
#define MK_N_LAUNCHES 1
#endif
#ifndef NAIVE_GEMM_MASK
#define NAIVE_GEMM_MASK 0
#endif

#define LAS __attribute__((address_space(3)))
#define GAS __attribute__((address_space(1)))
typedef unsigned short bf16_t;
typedef short bf16x8 __attribute__((ext_vector_type(8)));
typedef short bf16x4 __attribute__((ext_vector_type(4)));
typedef float f32x4 __attribute__((ext_vector_type(4)));
typedef float f32x2 __attribute__((ext_vector_type(2)));
typedef unsigned u32x4 __attribute__((ext_vector_type(4)));
typedef unsigned u32x2 __attribute__((ext_vector_type(2)));

constexpr int D = 1024, BATCH = 16, SEQ = 2048, T = BATCH * SEQ;
constexpr int AW = 768;
constexpr int RW = 1824;
constexpr int NIN = 6400;
constexpr int CR = 512;
constexpr int LK = 384;
constexpr int NEXP = 32, DE = 512;
constexpr int NLIST = 64;
constexpr int NPH = 12;

constexpr size_t MiB = 1u << 20;
constexpr size_t WS_CTL = 0, CTL_ZERO_BYTES = 1 * MiB;
constexpr size_t WS_LIST = 1 * MiB;
constexpr size_t WS_TOKG = 9 * MiB;
constexpr size_t WS_WIN = 10 * MiB;
constexpr size_t WS_WATT = 23 * MiB;
constexpr size_t WS_WRWKV = 24 * MiB;
constexpr size_t WS_WOUT = 25 * MiB;
constexpr size_t WS_WLORA = 27 * MiB;
constexpr size_t WS_H = 30 * MiB;
constexpr size_t WS_OG = WS_H;
constexpr size_t WS_LSE = WS_H + 48 * MiB;
constexpr size_t WS_QKV = 94 * MiB;
constexpr size_t WS_WGU = WS_QKV;
constexpr size_t WS_WD = WS_QKV + 64 * MiB;
constexpr size_t WS_PR = 238 * MiB;
constexpr size_t WS_HID = WS_PR;
constexpr size_t WS_LAG = 352 * MiB;
constexpr size_t WS_ATT = 448 * MiB;
constexpr size_t WS_ORW = 464 * MiB;
constexpr size_t WS_END = 496 * MiB;

constexpr int CW_TMO = 0;
constexpr int CW_BAR = 4096;
constexpr int CW_CNT = 16384;

constexpr int LDS_BYTES = 147456;
constexpr int LDS_TAB = 131072;
constexpr int LDS_MISC = 147456 - 64;

#define RLX_AGENT __ATOMIC_RELAXED, __HIP_MEMORY_SCOPE_AGENT
#define LDS_WAIT() asm volatile("s_waitcnt lgkmcnt(0)" ::: "memory")
#define VM_WAIT() asm volatile("s_waitcnt vmcnt(0)" ::: "memory")

__device__ __forceinline__ unsigned cvt_pk_bf16(float lo, float hi) { unsigned r; asm volatile("v_cvt_pk_bf16_f32 %0, %1, %2" : "=v"(r) : "v"(lo), "v"(hi)); return r; }
__device__ __forceinline__ float bf_lo(unsigned u) { return __uint_as_float(u << 16); }
__device__ __forceinline__ float bf_hi(unsigned u) { return __uint_as_float(u & 0xffff0000u); }
__device__ __forceinline__ u32x4 pack8(const float (&v)[8]) { u32x4 w; w.x = cvt_pk_bf16(v[0], v[1]); w.y = cvt_pk_bf16(v[2], v[3]); w.z = cvt_pk_bf16(v[4], v[5]); w.w = cvt_pk_bf16(v[6], v[7]); return w; }
__device__ __forceinline__ void unpack8(u32x4 w, float (&v)[8]) { v[0] = bf_lo(w.x); v[1] = bf_hi(w.x); v[2] = bf_lo(w.y); v[3] = bf_hi(w.y); v[4] = bf_lo(w.z); v[5] = bf_hi(w.z); v[6] = bf_lo(w.w); v[7] = bf_hi(w.w); }
__device__ __forceinline__ void unpack4(u32x2 w, float (&v)[4]) { v[0] = bf_lo(w.x); v[1] = bf_hi(w.x); v[2] = bf_lo(w.y); v[3] = bf_hi(w.y); }
__device__ __forceinline__ float sigmoidf_(float x) { return 1.f / (1.f + __expf(-x)); }
__device__ __forceinline__ float wave_sum(float v) {
#pragma unroll
    for (int o = 1; o < 64; o <<= 1) v += __shfl_xor(v, o);
    return v;
}
template <int CTRL> __device__ __forceinline__ float dpp_f(float x) { return __builtin_bit_cast(float, __builtin_amdgcn_mov_dpp(__builtin_bit_cast(int, x), CTRL, 0xf, 0xf, true)); }
__device__ __forceinline__ float red16(float x) { x += dpp_f<0xB1>(x); x += dpp_f<0x4E>(x); x += dpp_f<0x141>(x); x += dpp_f<0x128>(x); return x; }

#define XB_TMO      128
#define XB_XCNT(j)  (256  + 64 * (j))
#define XB_XSUB(j)  (1280 + 64 * (j))
#define XB_XGEN(j)  (2304 + 64 * (j))
#define XB_TOP      3328
#define XB_TOPGEN   3392
#define XCD_BAR_WORDS 3456
#define XB_SPIN_CAP (1u << 18)
__device__ __forceinline__ unsigned xb_ld(unsigned* p)              { return __hip_atomic_load(p, __ATOMIC_RELAXED, __HIP_MEMORY_SCOPE_AGENT); }
__device__ __forceinline__ unsigned xb_add(unsigned* p, unsigned v) { return __hip_atomic_fetch_add(p, v, __ATOMIC_RELAXED, __HIP_MEMORY_SCOPE_AGENT); }
__device__ __forceinline__ unsigned xb_xcc_id() { return (unsigned)__builtin_amdgcn_s_getreg((3 << 11) | 20) & 0xFu; }
#define XB_SPIN(cond, bar) do { unsigned _sp = 0; while (cond) { __builtin_amdgcn_s_sleep(1); \
    if ((++_sp & 255u) == 0u) { if (xb_ld(&(bar)[XB_TMO])) break; if (_sp > XB_SPIN_CAP) { atomicAdd(&(bar)[XB_TMO], 1u); break; } } } } while (0)
struct XcdBarrier { unsigned* bar; unsigned x; volatile LAS unsigned* st; };
__device__ __forceinline__ XcdBarrier xcd_barrier_post(unsigned* bar, volatile LAS unsigned* st) {
    XcdBarrier b; b.bar = bar; b.x = xb_xcc_id(); b.st = st;
    if (threadIdx.x == 0) (void)xb_add(&bar[XB_XCNT(b.x)], 1u);
    return b;
}
__device__ __forceinline__ void xcd_barrier_complete(unsigned* bar, unsigned x, unsigned& nloc, unsigned& nx) {
    const unsigned G = gridDim.x * gridDim.y * gridDim.z;
    unsigned sum, cnt, mine, sp = 0u;
    for (;;) {
        sum = 0u; cnt = 0u; mine = 0u;
#pragma unroll
        for (unsigned j = 0; j < 16; ++j) { const unsigned c = xb_ld(&bar[XB_XCNT(j)]); sum += c; cnt += (c > 0u) ? 1u : 0u; mine = (j == x) ? c : mine; }
        if (sum == G) break;
        __builtin_amdgcn_s_sleep(1);
        if ((++sp & 255u) == 0u) { if (xb_ld(&bar[XB_TMO])) break; if (sp > XB_SPIN_CAP) { atomicAdd(&bar[XB_TMO], 1u); break; } }
    }
    nloc = mine > 0u ? mine : 1u; nx = cnt > 0u ? cnt : 1u;
}
__device__ __forceinline__ void xcd_barrier(const XcdBarrier& b) {
    asm volatile("s_waitcnt vmcnt(0)" ::: "memory");
    __syncthreads();
    if (threadIdx.x == 0) {
        unsigned* bar = b.bar;
        __builtin_amdgcn_s_waitcnt(0);
        unsigned nloc = b.st[0], nx = b.st[1];
        if (nloc == 0u) { xcd_barrier_complete(bar, b.x, nloc, nx); b.st[0] = nloc; b.st[1] = nx; }
        const unsigned old = xb_add(&bar[XB_XSUB(b.x)], 1u);
        const unsigned gen = old / nloc;
        if (old + 1u == (gen + 1u) * nloc) {
            __builtin_amdgcn_fence(__ATOMIC_RELEASE, "agent");
            asm volatile("s_waitcnt vmcnt(0)" ::: "memory");
            const unsigned og = xb_add(&bar[XB_TOP], 1u);
            const unsigned tg = og / nx;
            if (og + 1u == (tg + 1u) * nx) xb_add(&bar[XB_TOPGEN], 1u);
            else XB_SPIN(xb_ld(&bar[XB_TOPGEN]) == tg, bar);
            __builtin_amdgcn_fence(__ATOMIC_ACQUIRE, "agent");
            xb_add(&bar[XB_XGEN(b.x)], 1u);
            asm volatile("s_waitcnt vmcnt(0)" ::: "memory");
        } else {
            XB_SPIN(xb_ld(&bar[XB_XGEN(b.x)]) == gen, bar);
            __builtin_amdgcn_fence(__ATOMIC_ACQUIRE, "agent");
            asm volatile("s_waitcnt vmcnt(0)" ::: "memory");
        }
    }
    __syncthreads();
}

namespace pg8 {
constexpr int BM = 256, BK = 64, HALF = 128, HTB = HALF * BK * 2, NXCD = 8, WGM = 8;
__host__ __device__ __forceinline__ int lds_byte(int r, int c) { const int st = (r >> 4) * 2 + (c >> 5), rr = r & 15, cc = c & 31, ob = rr * 64 + cc * 2; return st * 1024 + (ob ^ (((ob >> 9) & 1) << 5)); }
__host__ __device__ __forceinline__ void stage_rc(int b, int& R, int& C) { const int st = b / 1024, sb = b % 1024, swz = sb ^ (((sb >> 9) & 1) << 5); R = (st >> 1) * 16 + swz / 64; C = (st & 1) * 32 + (swz % 64) / 2; }
__host__ __device__ __forceinline__ int perm32(int rho) { const int n = rho >> 4, i = rho & 15; return 8 * (i >> 2) + 4 * n + (i & 3); }

struct Unit { int pm, pn; const char* A; const char* B; int ui, aux; };

struct StaticOrder {
    static constexpr bool GATHER = false;
    int nM, nN, nwg, G, c; const char* A; const char* Bt; size_t tstep;
    __device__ void init(const void* A_, const void* Bt_, int M, int N, int K, int G_, int c_) { A = (const char*)A_; Bt = (const char*)Bt_; nM = M / BM; nN = N / BM; nwg = nM * nN; G = G_; c = c_; tstep = (size_t)BM * K * 2; }
    __device__ bool next(int i, Unit& u) const {
        const long L = (long)i * G + c; if (L >= nwg) return false;
        int wgid = (int)L; { const int q = nwg / NXCD, r = nwg % NXCD, xcd = wgid % NXCD, off = wgid / NXCD; wgid = (xcd < r ? xcd * (q + 1) : r * (q + 1) + (xcd - r) * q) + off; }
        const int nig = WGM * nN, gid = wgid / nig, fm = gid * WGM, gsz = (nM - fm) < WGM ? (nM - fm) : WGM;
        u.pm = fm + ((wgid % nig) % gsz); u.pn = (wgid % nig) / gsz; u.A = A + (size_t)u.pm * tstep; u.B = Bt + (size_t)u.pn * tstep; u.ui = i; u.aux = 0; return true;
    }
    __device__ __forceinline__ unsigned row_off(const Unit&, int) const { return 0u; }
};

template <class F> struct EpiRow8 {
    F f;
    __device__ __forceinline__ void operator()(const f32x4 (&acc)[2][2][4][2], const Unit& u, int wr, int wc, int fr, int fq) const {
        asm volatile("" : "+v"(fr), "+v"(fq));
#pragma unroll
        for (int ai = 0; ai < 2; ++ai)
#pragma unroll
            for (int m = 0; m < 4; ++m) { const int r = ai * HALF + wr * 64 + m * 16 + fr;
#pragma unroll
                for (int bj = 0; bj < 2; ++bj) { const f32x4 a = acc[ai][bj][m][0], b = acc[ai][bj][m][1]; const float v[8] = {a[0], a[1], a[2], a[3], b[0], b[1], b[2], b[3]};
                    f(u, r, bj * HALF + wc * 32 + 8 * fq, v); }
                asm volatile("" ::: "memory"); }
    }
};
template <class F> struct EpiPair8 {
    F f;
    __device__ __forceinline__ void operator()(const f32x4 (&acc)[2][2][4][2], const Unit& u, int wr, int wc, int fr, int fq) const {
        asm volatile("" : "+v"(fr), "+v"(fq));
#pragma unroll
        for (int ai = 0; ai < 2; ++ai)
#pragma unroll
            for (int m = 0; m < 4; ++m) { const int r = ai * HALF + wr * 64 + m * 16 + fr;
                const f32x4 a = acc[ai][0][m][0], b = acc[ai][0][m][1], c = acc[ai][1][m][0], d = acc[ai][1][m][1];
                const float g[8] = {a[0], a[1], a[2], a[3], b[0], b[1], b[2], b[3]}, up[8] = {c[0], c[1], c[2], c[3], d[0], d[1], d[2], d[3]};
                f(u, r, wc * 32 + 8 * fq, g, up); asm volatile("" ::: "memory"); }
    }
};

template <class Epi, class Sched>
__device__ __forceinline__ void gemm_phase(LAS unsigned char* lds, const int K, const Sched& S, const Epi& E) {
    const int tid = threadIdx.x, wid = __builtin_amdgcn_readfirstlane(tid >> 6), lane = tid & 63, wr = wid >> 2, wc = wid & 3, fr = lane & 15, fq = lane >> 4;
    const int nt = K / BK;
    unsigned voffA[2], voffB[2]; int Rr[2], Cb[2];
#pragma unroll
    for (int i = 0; i < 2; ++i) { int R, C; stage_rc(tid * 16 + i * 8192, R, C); const int Rb = (R & ~31) + perm32(R & 31);
        voffA[i] = (unsigned)(R * K + C) * 2u; voffB[i] = (unsigned)(Rb * K + C) * 2u; Rr[i] = R; Cb[i] = C * 2; }
    const size_t kstep = (size_t)(BK * 2);
    const size_t hstep = (size_t)HALF * K * 2;
    const unsigned ldsw = (unsigned)wid * 1024u;
    const int aoff = lds_byte(wr * 64 + fr, fq * 8), boff = lds_byte(wc * 32 + fr, fq * 8);
#define PG8_SA(b, h) (((b) * 2 + (h)) * HTB)
#define PG8_SB(b, h) ((4 + (b) * 2 + (h)) * HTB)
#define PG8_STAGE_B(bufoff, gbase) do { _Pragma("unroll") for (int _i = 0; _i < 2; ++_i) \
        __builtin_amdgcn_global_load_lds((const unsigned*)((const char*)(gbase) + voffB[_i]), (LAS unsigned*)(lds + (bufoff) + ldsw + _i * 8192), 16, 0, 0); } while (0)
#define PG8_STAGE_A(bufoff, gbase, h) do { _Pragma("unroll") for (int _i = 0; _i < 2; ++_i) { \
        const char* _p; if constexpr (Sched::GATHER) _p = (const char*)(gbase) + ao[h][_i]; else _p = (const char*)(gbase) + (h) * hstep + voffA[_i]; \
        __builtin_amdgcn_global_load_lds((const unsigned*)_p, (LAS unsigned*)(lds + (bufoff) + ldsw + _i * 8192), 16, 0, 0); } } while (0)
#define PG8_LDA(dst, b, h) do { _Pragma("unroll") for (int m = 0; m < 4; ++m) _Pragma("unroll") for (int k = 0; k < 2; ++k) dst[m][k] = *(const LAS bf16x8*)(lds + PG8_SA(b, h) + aoff + m * 2048 + k * 1024); } while (0)
#define PG8_LDB(dst, b, h) do { _Pragma("unroll") for (int n = 0; n < 2; ++n) _Pragma("unroll") for (int k = 0; k < 2; ++k) dst[n][k] = *(const LAS bf16x8*)(lds + PG8_SB(b, h) + boff + n * 2048 + k * 1024); } while (0)
#define PG8_MMA(ai, bj, At, Bt) do { __builtin_amdgcn_s_setprio(1); _Pragma("unroll") for (int m = 0; m < 4; ++m) _Pragma("unroll") for (int n = 0; n < 2; ++n) _Pragma("unroll") for (int k = 0; k < 2; ++k) \
        acc[ai][bj][m][n] = __builtin_amdgcn_mfma_f32_16x16x32_bf16(Bt[n][k], At[m][k], acc[ai][bj][m][n], 0, 0, 0); __builtin_amdgcn_s_setprio(0); } while (0)
#define PG8_WAIT_V(n) asm volatile("s_waitcnt vmcnt(" #n ")" ::: "memory")
#define PG8_WAIT_L(n) asm volatile("s_waitcnt lgkmcnt(" #n ")" ::: "memory")
#define PG8_BAR __builtin_amdgcn_s_barrier()
#define PG8_SCHED __builtin_amdgcn_sched_barrier(0)
    Unit cur, nxt; int ui = 0;
    if (!S.next(0, cur)) return;
    f32x4 acc[2][2][4][2];
#pragma unroll
    for (int a = 0; a < 2; ++a)
#pragma unroll
        for (int b = 0; b < 2; ++b)
#pragma unroll
            for (int m = 0; m < 4; ++m)
#pragma unroll
                for (int n = 0; n < 2; ++n) acc[a][b][m][n] = (f32x4){0.f, 0.f, 0.f, 0.f};
    bf16x8 At[4][2], B0[2][2], B1[2][2];
    const char* cA = cur.A; const char* cB = cur.B;
    unsigned ao[2][2] = {{0u, 0u}, {0u, 0u}};
    if constexpr (Sched::GATHER) {
#pragma unroll
        for (int h = 0; h < 2; ++h)
#pragma unroll
            for (int i = 0; i < 2; ++i) ao[h][i] = S.row_off(cur, h * HALF + Rr[i]) + (unsigned)Cb[i];
    }
    PG8_STAGE_B(PG8_SB(0, 0), cB); PG8_STAGE_B(PG8_SB(0, 1), cB + hstep); PG8_STAGE_A(PG8_SA(0, 0), cA, 0); PG8_STAGE_A(PG8_SA(0, 1), cA, 1);
    if (wr == 1) PG8_BAR;
    PG8_WAIT_V(2); PG8_BAR;
    PG8_STAGE_B(PG8_SB(1, 0), cB + kstep); PG8_STAGE_A(PG8_SA(1, 0), cA + kstep, 0); PG8_STAGE_B(PG8_SB(1, 1), cB + hstep + kstep);
    PG8_WAIT_V(6); PG8_BAR;
    for (;;) {
        const bool has_next = S.next(ui + 1, nxt);
        const char* nA = has_next ? nxt.A : cA; const char* nB = has_next ? nxt.B : cB;
#pragma unroll 1
        for (int t = 0; t < nt; t += 2) {
            const bool last = (t == nt - 2);
            const char* a1 = cA + (size_t)(t + 1) * kstep;
            const char* a2 = last ? nA : cA + (size_t)(t + 2) * kstep; const char* b2 = last ? nB : cB + (size_t)(t + 2) * kstep;
            const char* a3 = a2 + kstep; const char* b3 = b2 + kstep;
            PG8_LDB(B0, 0, 0); PG8_LDB(B1, 0, 1); PG8_SCHED; PG8_LDA(At, 0, 0); PG8_STAGE_A(PG8_SA(1, 1), a1, 1);
            if constexpr (Sched::GATHER) { if (last && has_next) {
#pragma unroll
                for (int h = 0; h < 2; ++h)
#pragma unroll
                    for (int i = 0; i < 2; ++i) ao[h][i] = S.row_off(nxt, h * HALF + Rr[i]) + (unsigned)Cb[i]; } }
            PG8_WAIT_V(8); PG8_WAIT_L(0); PG8_BAR; PG8_MMA(0, 0, At, B0); PG8_MMA(0, 1, At, B1); PG8_BAR; PG8_SCHED;
            PG8_LDA(At, 0, 1); PG8_STAGE_B(PG8_SB(0, 0), b2); PG8_STAGE_B(PG8_SB(0, 1), b2 + hstep); PG8_STAGE_A(PG8_SA(0, 0), a2, 0);
            PG8_WAIT_V(8); PG8_WAIT_L(0); PG8_BAR; PG8_MMA(1, 0, At, B0); PG8_MMA(1, 1, At, B1); PG8_BAR; PG8_SCHED;
            PG8_LDB(B0, 1, 0); PG8_LDB(B1, 1, 1); PG8_SCHED; PG8_LDA(At, 1, 0); PG8_STAGE_A(PG8_SA(0, 1), a2, 1);
            PG8_WAIT_V(8); PG8_WAIT_L(0); PG8_BAR; PG8_MMA(0, 0, At, B0); PG8_MMA(0, 1, At, B1); PG8_BAR; PG8_SCHED;
            PG8_LDA(At, 1, 1); PG8_STAGE_B(PG8_SB(1, 0), b3); PG8_STAGE_B(PG8_SB(1, 1), b3 + hstep); PG8_STAGE_A(PG8_SA(1, 0), a3, 0);
            PG8_WAIT_V(8); PG8_WAIT_L(0); PG8_BAR; PG8_MMA(1, 0, At, B0); PG8_MMA(1, 1, At, B1); PG8_BAR; PG8_SCHED;
        }
        if (wr == 0) PG8_BAR;
        E(acc, cur, wr, wc, fr, fq);
        if (!has_next) break;
#pragma unroll
        for (int a = 0; a < 2; ++a)
#pragma unroll
            for (int b = 0; b < 2; ++b)
#pragma unroll
                for (int m = 0; m < 4; ++m)
#pragma unroll
                    for (int n = 0; n < 2; ++n) acc[a][b][m][n] = (f32x4){0.f, 0.f, 0.f, 0.f};
        cur = nxt; cA = nA; cB = nB; ++ui;
        if (wr == 1) PG8_BAR;
    }
    PG8_WAIT_V(0);
    PG8_BAR;
#undef PG8_SA
#undef PG8_SB
#undef PG8_STAGE_A
#undef PG8_STAGE_B
#undef PG8_LDA
#undef PG8_LDB
#undef PG8_MMA
#undef PG8_WAIT_V
#undef PG8_WAIT_L
#undef PG8_BAR
#undef PG8_SCHED
}

template <bool PAIR, class F, class Sched>
__device__ __forceinline__ void gemm_naive(const int K, const Sched& S, const F& f) {
    Unit u;
    for (int i = 0; S.next(i, u); ++i) {
        const int ncg = PAIR ? 16 : 32;
        for (int it = threadIdx.x; it < 256 * ncg; it += 512) {
            const int r = it & 255, c = (it >> 8) * 8;
            const char* ap = u.A + (Sched::GATHER ? (size_t)S.row_off(u, r) : (size_t)r * K * 2);
            float s0[8], s1[8];
#pragma unroll
            for (int j = 0; j < 8; ++j) { s0[j] = 0.f; s1[j] = 0.f; }
            for (int k = 0; k < K; k += 8) {
                float a[8]; unpack8(*(const u32x4*)(ap + (size_t)k * 2), a);
#pragma unroll
                for (int j = 0; j < 8; ++j) { float b[8]; unpack8(*(const u32x4*)(u.B + ((size_t)(c + j) * K + k) * 2), b);
#pragma unroll
                    for (int e = 0; e < 8; ++e) s0[j] += a[e] * b[e];
                    if constexpr (PAIR) { unpack8(*(const u32x4*)(u.B + ((size_t)(c + 128 + j) * K + k) * 2), b);
#pragma unroll
                        for (int e = 0; e < 8; ++e) s1[j] += a[e] * b[e]; } }
            }
            if constexpr (PAIR) f(u, r, c, s0, s1); else f(u, r, c, s0);
        }
    }
}
}

struct Args { const float* in[28]; float* out; unsigned char* ws; int ph_lo, ph_hi; };
enum { I_X = 0, I_N1G, I_WIN, I_QNG, I_KNG, I_RELB, I_WATT, I_MU, I_W0, I_WUP, I_A0, I_AUP, I_GUP, I_KK, I_KA, I_RK, I_LNW, I_LNB, I_WRWKV, I_WOUT, I_N2G, I_WGR, I_BGR, I_WER, I_BER, I_WEG, I_WEU, I_WED };

__device__ __forceinline__ void tr_item(bf16_t* WT, int Kd, int n0, int k0, const float* src, int ld, int ks0, int cs0, int kvalid, LAS float* scr, int lane) {
#pragma unroll 8
    for (int i = 0; i < 32; ++i) { const int kk = 2 * i + (lane >> 5); float v = 0.f; if (src != nullptr && kk < kvalid) v = src[(size_t)(ks0 + kk) * ld + cs0 + (lane & 31)]; scr[kk * 33 + (lane & 31)] = v; }
    LDS_WAIT();
    const int c = lane & 7;
#pragma unroll
    for (int j = 0; j < 4; ++j) { const int n = (lane >> 3) + 8 * j; const LAS float* s = scr + (8 * c) * 33 + n;
        u32x4 o; o.x = cvt_pk_bf16(s[0 * 33], s[1 * 33]); o.y = cvt_pk_bf16(s[2 * 33], s[3 * 33]); o.z = cvt_pk_bf16(s[4 * 33], s[5 * 33]); o.w = cvt_pk_bf16(s[6 * 33], s[7 * 33]);
        *(u32x4*)(WT + (size_t)(n0 + n) * Kd + k0 + 8 * c) = o; }
    LDS_WAIT();
}

__device__ __forceinline__ void p0_prologue(const Args& a, LAS unsigned char* lds, int wg, int G) {
    const int tid = threadIdx.x, lane = tid & 63, wave = tid >> 6;
    LAS float* scr = (LAS float*)(lds + wave * 16384);
    const int gw = wg * 8 + wave, NGW = G * 8;
    unsigned char* ws = a.ws;
    constexpr int I_IN = 200 * 16, I_ATT = 32 * 4, I_RWK = 32 * 8, I_OUT = 32 * 16, I_LORA = 48 * 6;
    for (int it = gw; it < I_IN + I_ATT + I_RWK + I_OUT + I_LORA; it += NGW) {
        int r = it;
        if (r < I_IN) { const int nb = r / 16, kb = r % 16, n0 = nb * 32; const float* src = a.in[I_WIN]; int cs0 = n0;
            if (n0 >= 4128 && n0 < 4352) src = nullptr; else if (n0 >= 4352) cs0 = 4128 + (n0 - 4352);
            tr_item((bf16_t*)(ws + WS_WIN), D, n0, kb * 64, src, 6176, kb * 64, cs0, 64, scr, lane); continue; } r -= I_IN;
        if (r < I_ATT) { const int nb = r / 4, kb = r % 4; tr_item((bf16_t*)(ws + WS_WATT), 256, nb * 32, kb * 64, a.in[I_WATT], D, kb * 64, nb * 32, 64, scr, lane); continue; } r -= I_ATT;
        if (r < I_RWK) { const int nb = r / 8, kb = r % 8; tr_item((bf16_t*)(ws + WS_WRWKV), 512, nb * 32, kb * 64, a.in[I_WRWKV], D, kb * 64, nb * 32, 64, scr, lane); continue; } r -= I_RWK;
        if (r < I_OUT) { const int nb = r / 16, kb = r % 16; tr_item((bf16_t*)(ws + WS_WOUT), D, nb * 32, kb * 64, a.in[I_WOUT], D, kb * 64, nb * 32, 64, scr, lane); continue; } r -= I_OUT;
        { const int nb = r / 6, kb = r % 6, n0 = nb * 32; const float* src = nullptr; int ks0 = 0, cs0 = 0, kv = 64;
            if (nb < 16) { if (kb == 0) { src = a.in[I_WUP]; cs0 = n0; } }
            else if (nb < 32) { if (kb == 1) { src = a.in[I_AUP]; cs0 = n0 - 512; } }
            else { if (kb >= 2 && kb <= 4) { src = a.in[I_GUP]; cs0 = n0 - 1024; ks0 = (kb - 2) * 64; kv = (kb == 4) ? 32 : 64; } }
            tr_item((bf16_t*)(ws + WS_WLORA), LK, n0, kb * 64, src, CR, ks0, cs0, kv, scr, lane); }
    }
    const float* x = a.in[I_X]; const float* gn = a.in[I_N1G]; bf16_t* H = (bf16_t*)(ws + WS_H);
    f32x4 g4[4];
#pragma unroll
    for (int j = 0; j < 4; ++j) g4[j] = *(const f32x4*)(gn + 4 * lane + 256 * j);
    for (int m = gw; m < T; m += NGW) {
        const f32x4* xr = (const f32x4*)(x + (size_t)m * D) + lane; f32x4 v[4]; float s = 0.f;
#pragma unroll
        for (int j = 0; j < 4; ++j) { v[j] = xr[64 * j]; s += (v[j].x * v[j].x + v[j].y * v[j].y) + (v[j].z * v[j].z + v[j].w * v[j].w); }
        const float rstd = rsqrtf(wave_sum(s) * (1.f / D) + 1e-6f);
        u32x2* o8 = (u32x2*)(H + (size_t)m * D) + lane;
#pragma unroll
        for (int j = 0; j < 4; ++j) { u32x2 o; o.x = cvt_pk_bf16(v[j].x * rstd * g4[j].x, v[j].y * rstd * g4[j].y); o.y = cvt_pk_bf16(v[j].z * rstd * g4[j].z, v[j].w * rstd * g4[j].w); o8[64 * j] = o; }
    }
}

struct FIn {
    bf16_t *Q, *PR, *GATE;
    __device__ __forceinline__ void operator()(const pg8::Unit& u, int r, int c, const float (&v)[8]) const {
        const size_t row = (size_t)u.pm * 256 + r; const int pn = u.pn;
        if (pn < 9) { bf16_t* base = Q + (size_t)(pn / 3) * ((size_t)T * AW); *(u32x4*)(base + row * AW + (pn % 3) * 256 + c) = pack8(v); }
        else if (pn < 17) { const int j = (pn - 9) * 256 + c; if (j < RW) *(u32x4*)(PR + row * RW + j) = pack8(v); }
        else { const int j = (pn - 17) * 256 + c; float s[8];
#pragma unroll
            for (int e = 0; e < 8; ++e) s[e] = sigmoidf_(v[e]);
            *(u32x4*)(GATE + row * 2048 + j) = pack8(s); }
    }
};
struct FLora {
    bf16_t* LAG; const float* w0; const float* a0;
    __device__ __forceinline__ void operator()(const pg8::Unit& u, int r, int c, const float (&v)[8]) const {
        const size_t row = (size_t)u.pm * 256 + r; const int col = u.pn * 256 + c, which = u.pn >> 1, cc = col & 511; float o[8];
        const float* bias = which == 0 ? w0 : a0;
        const f32x4 b0 = *(const f32x4*)(bias + cc), b1 = *(const f32x4*)(bias + cc + 4);
        const float bv[8] = {b0[0], b0[1], b0[2], b0[3], b1[0], b1[1], b1[2], b1[3]};
#pragma unroll
        for (int e = 0; e < 8; ++e) {
            const float z = bv[e] + v[e];
            const float sg = 1.f / (1.f + __expf(-z));
            const float sp = fmaxf(-z, 0.f) + __logf(1.f + __expf(-fabsf(z)));
            const float ld = -__expf(-sp - 0.5f);
            o[e] = which == 0 ? ld : (which == 1 ? sg : v[e]);
        }
        *(u32x4*)(LAG + row * 1536 + col) = pack8(o);
    }
};
struct FMix1 {
    bf16_t* MIXED; const bf16_t* GATE;
    __device__ __forceinline__ void operator()(const pg8::Unit& u, int r, int c, const float (&v)[8]) const {
        const size_t row = (size_t)u.pm * 256 + r; const int col = u.pn * 256 + c; float g[8], o[8]; unpack8(*(const u32x4*)(GATE + row * 2048 + col), g);
#pragma unroll
        for (int e = 0; e < 8; ++e) o[e] = g[e] * v[e];
        *(u32x4*)(MIXED + row * D + col) = pack8(o);
    }
};
struct FMix2 {
    bf16_t* MIXED; const bf16_t* GATE;
    __device__ __forceinline__ void operator()(const pg8::Unit& u, int r, int c, const float (&v)[8]) const {
        const size_t row = (size_t)u.pm * 256 + r; const int col = u.pn * 256 + c; float g[8], m[8], o[8]; unpack8(*(const u32x4*)(GATE + row * 2048 + 1024 + col), g);
        unpack8(*(const u32x4*)(MIXED + row * D + col), m);
#pragma unroll
        for (int e = 0; e < 8; ++e) o[e] = m[e] + g[e] * v[e];
        *(u32x4*)(MIXED + row * D + col) = pack8(o);
    }
};
struct FOut {
    const float* x; float* out;
    __device__ __forceinline__ void operator()(const pg8::Unit& u, int r, int c, const float (&v)[8]) const {
        const size_t off = ((size_t)u.pm * 256 + r) * D + u.pn * 256 + c; const f32x4 x0 = *(const f32x4*)(x + off), x1 = *(const f32x4*)(x + off + 4);
        *(f32x4*)(out + off) = (f32x4){x0[0] + v[0], x0[1] + v[1], x0[2] + v[2], x0[3] + v[3]}; *(f32x4*)(out + off + 4) = (f32x4){x1[0] + v[4], x1[1] + v[5], x1[2] + v[6], x1[3] + v[7]};
    }
};

struct MoeOrder {
    static constexpr bool GATHER = true;
    LAS int* tab; int K; const char* Abase; const char* Wbase; size_t wexp; int gatherA;
    __device__ bool next(int i, pg8::Unit& u) const {
        if (i >= 8) return false; const LAS int* d = tab + 160 + 4 * i; if (d[3] == 0) return false;
        const int l = d[0], rt = d[1], pn = d[2]; u.pm = rt; u.pn = pn; u.ui = i; u.aux = l;
        u.A = gatherA ? Abase : Abase + (size_t)(tab[l] + rt) * 256 * (size_t)K * 2;
        u.B = Wbase + (size_t)(l & 31) * wexp + (size_t)pn * 256 * (size_t)K * 2; return true;
    }
    __device__ __forceinline__ unsigned row_off(const pg8::Unit& u, int r) const {
        if (gatherA) { int tok = tab[256 + u.ui * 256 + r]; tok = tok < 0 ? 0 : tok; return (unsigned)tok * (unsigned)(K * 2); }
        return (unsigned)r * (unsigned)(K * 2);
    }
};
__device__ __forceinline__ void moe_tables(LAS int* tab, const unsigned* cnt, const int* lists, int l_lo, int l_hi, int wg, int G) {
    const int tid = threadIdx.x;
    __syncthreads();
    if (tid < 64) tab[80 + tid] = (int)cnt[tid];
    __syncthreads();
    if (tid == 0) { int s = 0; for (int l = 0; l < 64; ++l) { tab[l] = s; s += (tab[80 + l] + 255) >> 8; } tab[64] = s; }
    __syncthreads();
    const int t_lo = tab[l_lo], t_hi = tab[l_hi];
    if (tid < 8) { const int L = tid * G + wg, tile = t_lo + (L >> 2); LAS int* d = tab + 160 + 4 * tid;
        if (tile < t_hi) { int l = l_lo; while (tab[l + 1] <= tile) ++l; d[0] = l; d[1] = tile - tab[l]; d[2] = L & 3; d[3] = 1; } else { d[0] = 0; d[1] = 0; d[2] = 0; d[3] = 0; } }
    __syncthreads();
    for (int i = 0; i < 8; ++i) { const LAS int* d = tab + 160 + 4 * i; if (d[3] == 0) break; const int l = d[0], rt = d[1];
        if (tid < 256) { const int pos = rt * 256 + tid; tab[256 + i * 256 + tid] = pos < tab[80 + l] ? lists[(size_t)l * T + pos] : -1; } }
    __syncthreads();
}
struct FGU {
    bf16_t* HID; const LAS int* tab;
    __device__ __forceinline__ void operator()(const pg8::Unit& u, int r, int c, const float (&g)[8], const float (&up)[8]) const {
        const size_t hrow = (size_t)(tab[u.aux] + u.pm) * 256 + r; float o[8];
#pragma unroll
        for (int e = 0; e < 8; ++e) o[e] = g[e] * sigmoidf_(g[e]) * up[e];
        *(u32x4*)(HID + hrow * DE + u.pn * 128 + c) = pack8(o);
    }
};
struct FDown {
    float* out; const float* tokg; const LAS int* tab; int k;
    __device__ __forceinline__ void operator()(const pg8::Unit& u, int r, int c, const float (&v)[8]) const {
        const int tok = tab[256 + u.ui * 256 + r]; if (tok < 0) return;
        const float g = tokg[tok * 2 + k]; float* p = out + (size_t)tok * D + u.pn * 256 + c; const f32x4 x0 = *(const f32x4*)p, x1 = *(const f32x4*)(p + 4);
        *(f32x4*)p = (f32x4){x0[0] + g * v[0], x0[1] + g * v[1], x0[2] + g * v[2], x0[3] + g * v[3]}; *(f32x4*)(p + 4) = (f32x4){x1[0] + g * v[4], x1[1] + g * v[5], x1[2] + g * v[6], x1[3] + g * v[7]};
    }
};

__device__ __forceinline__ void p2_lora_in(const Args& a, int wg, int G) {
    const bf16_t* PR = (const bf16_t*)(a.ws + WS_PR); bf16_t* AP = (bf16_t*)(a.ws + WS_H); const float* mu = a.in[I_MU];
    for (int it = wg * 512 + threadIdx.x; it < T * 48; it += G * 512) {
        const int t = it / 48, j = (it % 48) * 8; float o[8];
        if (j < 288) { float p[8], q[8]; unpack8(*(const u32x4*)(PR + (size_t)t * RW + 1536 + j), p);
            if ((t & (SEQ - 1)) != 0) unpack8(*(const u32x4*)(PR + (size_t)(t - 1) * RW + 1536 + j), q); else {
#pragma unroll
                for (int e = 0; e < 8; ++e) q[e] = 0.f; }
#pragma unroll
            for (int e = 0; e < 8; ++e) { const float pm = p[e] + (q[e] - p[e]) * mu[1536 + j + e]; o[e] = j < 64 ? tanhf(pm) : (j < 128 ? pm : sigmoidf_(pm)); }
        } else {
#pragma unroll
            for (int e = 0; e < 8; ++e) o[e] = 0.f; }
        *(u32x4*)(AP + (size_t)t * LK + j) = pack8(o);
    }
}

__device__ __forceinline__ void scan_unit(const Args& a, LAS unsigned char* lds, int b, int hd) {
    constexpr int TC = 32;
    LAS float* buf = (LAS float*)lds;
    LAS float* obuf = buf + 2 * TC * 7 * 64;
    LAS float* bon = obuf + TC * 64;
    const int tid = threadIdx.x, w = tid >> 6, lane = tid & 63, c = lane & 15, rp = lane >> 4;
    const int row0 = 8 * w + rp, row1 = row0 + 4;
    const int tt = tid >> 4, d4 = (tid & 15) * 4, ch0 = hd * 64 + d4;
    const bf16_t* PR = (const bf16_t*)(a.ws + WS_PR); const bf16_t* LAG = (const bf16_t*)(a.ws + WS_LAG); bf16_t* ORW = (bf16_t*)(a.ws + WS_ORW);
    const f32x4 mu_r = *(const f32x4*)(a.in[I_MU] + ch0), mu_k = *(const f32x4*)(a.in[I_MU] + 512 + ch0), mu_v = *(const f32x4*)(a.in[I_MU] + 1024 + ch0);
    const f32x4 kkp = *(const f32x4*)(a.in[I_KK] + ch0), kap = *(const f32x4*)(a.in[I_KA] + ch0), rkp = *(const f32x4*)(a.in[I_RK] + ch0);
    const f32x4 lnw = *(const f32x4*)(a.in[I_LNW] + ch0), lnb = *(const f32x4*)(a.in[I_LNB] + ch0);
    float S0[4] = {0.f, 0.f, 0.f, 0.f}, S1[4] = {0.f, 0.f, 0.f, 0.f};
    u32x2 pr_r, pr_k, pr_v, pp_r, pp_k, pp_v, p_ld, p_a, p_g;
    auto prefetch = [&](int ch) {
        const int s = ch * TC + tt; const size_t t = (size_t)b * SEQ + s;
        pr_r = *(const u32x2*)(PR + t * RW + ch0); pr_k = *(const u32x2*)(PR + t * RW + 512 + ch0); pr_v = *(const u32x2*)(PR + t * RW + 1024 + ch0);
        if (s > 0) { pp_r = *(const u32x2*)(PR + (t - 1) * RW + ch0); pp_k = *(const u32x2*)(PR + (t - 1) * RW + 512 + ch0); pp_v = *(const u32x2*)(PR + (t - 1) * RW + 1024 + ch0); }
        else { pp_r = (u32x2){0u, 0u}; pp_k = pp_r; pp_v = pp_r; }
        p_ld = *(const u32x2*)(LAG + t * 1536 + ch0); p_a = *(const u32x2*)(LAG + t * 1536 + 512 + ch0); p_g = *(const u32x2*)(LAG + t * 1536 + 1024 + ch0);
    };
    prefetch(0);
    for (int ch = 0; ch < SEQ / TC; ++ch) {
        const int bi = ch & 1; LAS float* B = buf + bi * (TC * 7 * 64) + tt * (7 * 64);
        {
            float r[4], k[4], v[4], pr[4], pk[4], pv[4], ld[4], aa[4], g[4];
            unpack4(pr_r, r); unpack4(pr_k, k); unpack4(pr_v, v); unpack4(pp_r, pr); unpack4(pp_k, pk); unpack4(pp_v, pv); unpack4(p_ld, ld); unpack4(p_a, aa); unpack4(p_g, g);
            float kk[4], kp[4], bb[4], wv[4]; float ssq = 0.f, bsum = 0.f;
#pragma unroll
            for (int e = 0; e < 4; ++e) { r[e] = r[e] + (pr[e] - r[e]) * mu_r[e]; k[e] = k[e] + (pk[e] - k[e]) * mu_k[e]; v[e] = v[e] + (pv[e] - v[e]) * mu_v[e];
                wv[e] = __expf(ld[e]); kk[e] = k[e] * kkp[e]; ssq += kk[e] * kk[e]; kp[e] = k[e] * (1.f + (aa[e] - 1.f) * kap[e]); bsum += r[e] * kp[e] * rkp[e]; }
            ssq = red16(ssq); bsum = red16(bsum);
            const float inv = 1.f / fmaxf(sqrtf(ssq), 1e-12f);
#pragma unroll
            for (int e = 0; e < 4; ++e) { kk[e] *= inv; bb[e] = kk[e] * aa[e]; }
            *(LAS f32x4*)(B + 0 * 64 + d4) = (f32x4){kk[0], kk[1], kk[2], kk[3]};
            *(LAS f32x4*)(B + 1 * 64 + d4) = (f32x4){wv[0], wv[1], wv[2], wv[3]};
            *(LAS f32x4*)(B + 2 * 64 + d4) = (f32x4){bb[0], bb[1], bb[2], bb[3]};
            *(LAS f32x4*)(B + 3 * 64 + d4) = (f32x4){kp[0], kp[1], kp[2], kp[3]};
            *(LAS f32x4*)(B + 4 * 64 + d4) = (f32x4){r[0], r[1], r[2], r[3]};
            *(LAS f32x4*)(B + 5 * 64 + d4) = (f32x4){v[0], v[1], v[2], v[3]};
            *(LAS f32x4*)(B + 6 * 64 + d4) = (f32x4){g[0], g[1], g[2], g[3]};
            if ((tid & 15) == 0) bon[bi * TC + tt] = bsum;
        }
        if (ch + 1 < SEQ / TC) prefetch(ch + 1);
        __syncthreads();
        {
            const LAS float* Bc = buf + bi * (TC * 7 * 64);
#pragma unroll 2
            for (int s = 0; s < TC; ++s) {
                const LAS float* Bs = Bc + s * (7 * 64);
                const f32x4 kk4 = *(const LAS f32x4*)(Bs + 0 * 64 + 4 * c), w4 = *(const LAS f32x4*)(Bs + 1 * 64 + 4 * c), b4 = *(const LAS f32x4*)(Bs + 2 * 64 + 4 * c);
                const f32x4 k4 = *(const LAS f32x4*)(Bs + 3 * 64 + 4 * c), r4 = *(const LAS f32x4*)(Bs + 4 * 64 + 4 * c);
                const float v0 = Bs[5 * 64 + row0], v1 = Bs[5 * 64 + row1];
                float p0 = S0[0] * kk4[0] + S0[1] * kk4[1] + S0[2] * kk4[2] + S0[3] * kk4[3];
                float p1 = S1[0] * kk4[0] + S1[1] * kk4[1] + S1[2] * kk4[2] + S1[3] * kk4[3];
                p0 = red16(p0); p1 = red16(p1);
                float q0 = 0.f, q1 = 0.f;
#pragma unroll
                for (int e = 0; e < 4; ++e) { S0[e] = S0[e] * w4[e] + (v0 * k4[e] - p0 * b4[e]); S1[e] = S1[e] * w4[e] + (v1 * k4[e] - p1 * b4[e]); q0 += S0[e] * r4[e]; q1 += S1[e] * r4[e]; }
                q0 = red16(q0); q1 = red16(q1);
                if (c == 0) { obuf[s * 64 + row0] = q0; obuf[s * 64 + row1] = q1; }
            }
        }
        __syncthreads();
        {
            const f32x4 o4 = *(const LAS f32x4*)(obuf + tt * 64 + d4); const f32x4 v4 = *(const LAS f32x4*)(B + 5 * 64 + d4), g4 = *(const LAS f32x4*)(B + 6 * 64 + d4);
            const float mean = red16((o4[0] + o4[1]) + (o4[2] + o4[3])) * (1.f / 64.f);
            float dv[4], q = 0.f;
#pragma unroll
            for (int e = 0; e < 4; ++e) { dv[e] = o4[e] - mean; q += dv[e] * dv[e]; }
            const float rs = rsqrtf(red16(q) * (1.f / 64.f) + 64e-5f), bs = bon[bi * TC + tt];
            float y[4];
#pragma unroll
            for (int e = 0; e < 4; ++e) y[e] = (dv[e] * rs * lnw[e] + lnb[e] + bs * v4[e]) * g4[e];
            const size_t t = (size_t)b * SEQ + ch * TC + tt;
            u32x2 o; o.x = cvt_pk_bf16(y[0], y[1]); o.y = cvt_pk_bf16(y[2], y[3]);
            *(u32x2*)(ORW + t * CR + ch0) = o;
        }
    }
    __syncthreads();
}

__device__ __forceinline__ int t5_bucket(int dist) {
    if (dist < 16) return dist;
    const float d = (float)dist; int large = 16 + (int)(logf(d / 16.f) / 4.852030263919617f * 16.f); return large < 31 ? large : 31;
}
__device__ __forceinline__ void attn_unit(const Args& a, LAS unsigned char* lds, int unit) {
    const int g = unit >> 10, rem = unit & 1023; int dil, b, r, hd, n;
    b = rem >> 6;
    if (g == 0) { dil = 1; r = 0; hd = (rem >> 4) & 3; n = rem & 15; }
    else if (g == 1) { dil = 4; r = (rem >> 4) & 3; hd = (rem >> 2) & 3; n = rem & 3; }
    else { dil = 16; r = (rem >> 2) & 15; hd = rem & 3; n = 0; }
    const int head = 4 * g + hd, colq = head * 64;
    const bf16_t* Q = (const bf16_t*)(a.ws + WS_QKV); const bf16_t* Kb = Q + (size_t)T * AW; const bf16_t* Vb = Kb + (size_t)T * AW;
    LAS bf16_t* Ks = (LAS bf16_t*)lds;
    LAS bf16_t* VT = (LAS bf16_t*)(lds + 36864);
    LAS float* bias = (LAS float*)(lds + 36864 + 33792);
    const int tid = threadIdx.x, lane = tid & 63, w = tid >> 6;
    __syncthreads();
    {
        const int key = tid >> 1, half = tid & 1, lk = 128 * (n - 1) + key;
        float kv[32], vv[32];
        if (lk >= 0) { const size_t tok = (size_t)b * SEQ + (size_t)lk * dil + r; const u32x4* kp = (const u32x4*)(Kb + tok * AW + colq + 32 * half); const u32x4* vp = (const u32x4*)(Vb + tok * AW + colq + 32 * half);
#pragma unroll
            for (int j = 0; j < 4; ++j) { float t8[8]; unpack8(kp[j], t8);
#pragma unroll
                for (int e = 0; e < 8; ++e) kv[8 * j + e] = t8[e];
                unpack8(vp[j], t8);
#pragma unroll
                for (int e = 0; e < 8; ++e) vv[8 * j + e] = t8[e]; }
        } else {
#pragma unroll
            for (int e = 0; e < 32; ++e) { kv[e] = 0.f; vv[e] = 0.f; } }
        float ssq = 0.f;
#pragma unroll
        for (int e = 0; e < 32; ++e) ssq += kv[e] * kv[e];
        ssq += __shfl_xor(ssq, 1);
        const float rstd = rsqrtf(ssq * (1.f / 64.f) + 1e-6f); const float* kg = a.in[I_KNG] + g * 64 + 32 * half;
#pragma unroll
        for (int j = 0; j < 4; ++j) { float t8[8];
#pragma unroll
            for (int e = 0; e < 8; ++e) t8[e] = kv[8 * j + e] * rstd * kg[8 * j + e];
            *(LAS u32x4*)(Ks + key * 72 + 32 * half + 8 * j) = pack8(t8); }
#pragma unroll
        for (int e = 0; e < 32; e += 2) { const unsigned pk = cvt_pk_bf16(vv[e], vv[e + 1]); VT[(32 * half + e) * 264 + key] = (bf16_t)(pk & 0xffffu); VT[(32 * half + e + 1) * 264 + key] = (bf16_t)(pk >> 16); }
        if (tid < 129) bias[tid] = a.in[I_RELB][t5_bucket(tid * dil) * 12 + head];
    }
    __syncthreads();
    const int iq = lane & 15, rg = lane >> 4, qi = 16 * w + iq;
    const size_t tq = (size_t)b * SEQ + (size_t)(128 * n + qi) * dil + r;
    bf16x8 qf[2];
    {
        float q0[8], q1[8]; unpack8(*(const u32x4*)(Q + tq * AW + colq + 8 * rg), q0); unpack8(*(const u32x4*)(Q + tq * AW + colq + 32 + 8 * rg), q1);
        float ssq = 0.f;
#pragma unroll
        for (int e = 0; e < 8; ++e) ssq += q0[e] * q0[e] + q1[e] * q1[e];
        ssq += __shfl_xor(ssq, 16); ssq += __shfl_xor(ssq, 32);
        const float rstd = rsqrtf(ssq * (1.f / 64.f) + 1e-6f) * 0.125f; const float* qg = a.in[I_QNG] + g * 64;
#pragma unroll
        for (int e = 0; e < 8; ++e) { q0[e] *= rstd * qg[8 * rg + e]; q1[e] *= rstd * qg[32 + 8 * rg + e]; }
        qf[0] = __builtin_bit_cast(bf16x8, pack8(q0)); qf[1] = __builtin_bit_cast(bf16x8, pack8(q1));
    }
    const int u0 = w >> 1;
    f32x4 s[10];
#pragma unroll
    for (int j = 0; j < 10; ++j) { const int kt = 2 * u0 + j;
        const bf16x8 k0 = *(const LAS bf16x8*)(Ks + (16 * kt + iq) * 72 + 8 * rg), k1 = *(const LAS bf16x8*)(Ks + (16 * kt + iq) * 72 + 32 + 8 * rg);
        f32x4 z = (f32x4){0.f, 0.f, 0.f, 0.f};
        z = __builtin_amdgcn_mfma_f32_16x16x32_bf16(k0, qf[0], z, 0, 0, 0); s[j] = __builtin_amdgcn_mfma_f32_16x16x32_bf16(k1, qf[1], z, 0, 0, 0); }
    float mx = -1e30f;
#pragma unroll
    for (int j = 0; j < 10; ++j)
#pragma unroll
        for (int e = 0; e < 4; ++e) { const int kj = 16 * (2 * u0 + j) + 4 * rg + e, rel = qi + 128 - kj; const bool ok = (rel >= 0) && (rel <= 128) && (n > 0 || kj >= 128);
            const int rc = rel < 0 ? 0 : (rel > 128 ? 128 : rel); const float sc = ok ? s[j][e] + bias[rc] : -1e30f; s[j][e] = sc; mx = fmaxf(mx, sc); }
    mx = fmaxf(mx, __shfl_xor(mx, 16)); mx = fmaxf(mx, __shfl_xor(mx, 32));
    float l = 0.f;
#pragma unroll
    for (int j = 0; j < 10; ++j)
#pragma unroll
        for (int e = 0; e < 4; ++e) { const float p = __expf(s[j][e] - mx); s[j][e] = p; l += p; }
    l += __shfl_xor(l, 16); l += __shfl_xor(l, 32);
    f32x4 oacc[4];
#pragma unroll
    for (int dt = 0; dt < 4; ++dt) oacc[dt] = (f32x4){0.f, 0.f, 0.f, 0.f};
#pragma unroll
    for (int ub = 0; ub < 5; ++ub) {
        u32x4 pw; pw.x = cvt_pk_bf16(s[2 * ub][0], s[2 * ub][1]); pw.y = cvt_pk_bf16(s[2 * ub][2], s[2 * ub][3]); pw.z = cvt_pk_bf16(s[2 * ub + 1][0], s[2 * ub + 1][1]); pw.w = cvt_pk_bf16(s[2 * ub + 1][2], s[2 * ub + 1][3]);
        const bf16x8 pf = __builtin_bit_cast(bf16x8, pw); const int kb = 32 * (u0 + ub) + 4 * rg;
#pragma unroll
        for (int dt = 0; dt < 4; ++dt) { const LAS bf16_t* vp = VT + (16 * dt + iq) * 264 + kb; const u32x2 lo = *(const LAS u32x2*)vp, hi = *(const LAS u32x2*)(vp + 16);
            u32x4 vw; vw.x = lo.x; vw.y = lo.y; vw.z = hi.x; vw.w = hi.y;
            oacc[dt] = __builtin_amdgcn_mfma_f32_16x16x32_bf16(__builtin_bit_cast(bf16x8, vw), pf, oacc[dt], 0, 0, 0); }
    }
    const float il = 1.f / l;
    bf16_t* OG = (bf16_t*)(a.ws + WS_OG) + (size_t)g * T * 256; float* LSE = (float*)(a.ws + WS_LSE) + (size_t)g * T * 4;
#pragma unroll
    for (int dt = 0; dt < 4; ++dt) { u32x2 o; o.x = cvt_pk_bf16(oacc[dt][0] * il, oacc[dt][1] * il); o.y = cvt_pk_bf16(oacc[dt][2] * il, oacc[dt][3] * il);
        *(u32x2*)(OG + tq * 256 + hd * 64 + 16 * dt + 4 * rg) = o; }
    if (rg == 0) LSE[tq * 4 + hd] = mx + logf(l);
}

__device__ __forceinline__ void p5_combine(const Args& a, int wg, int G) {
    const bf16_t* OG = (const bf16_t*)(a.ws + WS_OG); const float* LSE = (const float*)(a.ws + WS_LSE); bf16_t* ATT = (bf16_t*)(a.ws + WS_ATT);
    for (int it = wg * 512 + threadIdx.x; it < T * 32; it += G * 512) {
        const int t = it >> 5, hs = (it >> 3) & 3, d8 = (it & 7) * 8;
        const float l0 = LSE[(size_t)t * 4 + hs], l1 = LSE[(size_t)T * 4 + (size_t)t * 4 + hs], l2 = LSE[(size_t)2 * T * 4 + (size_t)t * 4 + hs];
        const float m = fmaxf(l0, fmaxf(l1, l2)); float w0 = __expf(l0 - m), w1 = __expf(l1 - m), w2 = __expf(l2 - m); const float iz = 1.f / (w0 + w1 + w2); w0 *= iz; w1 *= iz; w2 *= iz;
        float o0[8], o1[8], o2[8], o[8]; const size_t off = (size_t)t * 256 + hs * 64 + d8;
        unpack8(*(const u32x4*)(OG + off), o0); unpack8(*(const u32x4*)(OG + (size_t)T * 256 + off), o1); unpack8(*(const u32x4*)(OG + (size_t)2 * T * 256 + off), o2);
#pragma unroll
        for (int e = 0; e < 8; ++e) o[e] = w0 * o0[e] + w1 * o1[e] + w2 * o2[e];
        *(u32x4*)(ATT + off) = pack8(o);
    }
}

__device__ __forceinline__ void p8_router(const Args& a, LAS unsigned char* lds, int wg, int G) {
    const int tid = threadIdx.x, lane = tid & 63, wave = tid >> 6; const int gw = wg * 8 + wave, NGW = G * 8;
    unsigned char* ws = a.ws;
    {
        LAS float* scr = (LAS float*)(lds + wave * 16384);
        constexpr int I_GU = 32 * 32 * 16, I_DN = 32 * 32 * 8;
        for (int it = gw; it < I_GU + I_DN; it += NGW) {
            if (it < I_GU) { const int e = it >> 9, r = it & 511, nb = r >> 4, kb = r & 15, n0 = nb * 32, pn = n0 >> 8, j = n0 & 255;
                const float* src = (j < 128 ? a.in[I_WEG] : a.in[I_WEU]) + (size_t)e * D * DE;
                tr_item((bf16_t*)(ws + WS_WGU) + (size_t)e * 1024 * 1024, D, n0, kb * 64, src, DE, kb * 64, 128 * pn + (j & 127), 64, scr, lane); }
            else { const int r0 = it - I_GU, e = r0 >> 8, r = r0 & 255, nb = r >> 3, kb = r & 7;
                tr_item((bf16_t*)(ws + WS_WD) + (size_t)e * 1024 * 512, DE, nb * 32, kb * 64, a.in[I_WED] + (size_t)e * DE * D, D, kb * 64, nb * 32, 64, scr, lane); }
        }
    }
    const float* x2 = a.out; const float* gn = a.in[I_N2G]; bf16_t* H2 = (bf16_t*)(ws + WS_H);
    const float* Wg = a.in[I_WGR]; const float* We = a.in[I_WER]; const float* bg = a.in[I_BGR]; const float* be = a.in[I_BER];
    unsigned* cnt = (unsigned*)(ws + WS_CTL) + CW_CNT; int* lists = (int*)(ws + WS_LIST); float* tokg = (float*)(ws + WS_TOKG);
    f32x4 g4[4];
#pragma unroll
    for (int j = 0; j < 4; ++j) g4[j] = *(const f32x4*)(gn + 4 * lane + 256 * j);
    for (int m = gw; m < T; m += NGW) {
        const f32x4* xr = (const f32x4*)(x2 + (size_t)m * D) + lane; f32x4 v[4]; float s = 0.f;
#pragma unroll
        for (int j = 0; j < 4; ++j) { v[j] = xr[64 * j]; s += (v[j].x * v[j].x + v[j].y * v[j].y) + (v[j].z * v[j].z + v[j].w * v[j].w); }
        const float rstd = rsqrtf(wave_sum(s) * (1.f / D) + 1e-6f);
        u32x2* o8 = (u32x2*)(H2 + (size_t)m * D) + lane;
        float lg[4] = {0.f, 0.f, 0.f, 0.f}, le[32];
        int ln = lane; asm volatile("" : "+v"(ln));
#pragma unroll
        for (int e = 0; e < 32; ++e) le[e] = 0.f;
#pragma unroll
        for (int j = 0; j < 4; ++j) { v[j].x *= rstd * g4[j].x; v[j].y *= rstd * g4[j].y; v[j].z *= rstd * g4[j].z; v[j].w *= rstd * g4[j].w;
            u32x2 o; o.x = cvt_pk_bf16(v[j].x, v[j].y); o.y = cvt_pk_bf16(v[j].z, v[j].w); o8[64 * j] = o;
#pragma unroll
            for (int q = 0; q < 4; ++q) { const int c = 4 * ln + 256 * j + q; const float h = v[j][q];
                const f32x4 wg4 = *(const f32x4*)(Wg + (size_t)c * 4); lg[0] += h * wg4[0]; lg[1] += h * wg4[1]; lg[2] += h * wg4[2]; lg[3] += h * wg4[3];
#pragma unroll
                for (int e4 = 0; e4 < 8; ++e4) { const f32x4 w4 = *(const f32x4*)(We + (size_t)c * 32 + 4 * e4); le[4 * e4 + 0] += h * w4[0]; le[4 * e4 + 1] += h * w4[1]; le[4 * e4 + 2] += h * w4[2]; le[4 * e4 + 3] += h * w4[3]; }
                asm volatile("" ::: "memory"); } }
#pragma unroll
        for (int e = 0; e < 4; ++e) lg[e] = wave_sum(lg[e]) + bg[e];
#pragma unroll
        for (int e = 0; e < 32; ++e) le[e] = wave_sum(le[e]) + be[e];
        int grp = 0; float gm = lg[0];
#pragma unroll
        for (int e = 1; e < 4; ++e) if (lg[e] > gm) { gm = lg[e]; grp = e; }
        float gz = 0.f;
#pragma unroll
        for (int e = 0; e < 4; ++e) gz += __expf(lg[e] - gm);
        const float grp_p = 1.f / gz;
        float sel[8];
#pragma unroll
        for (int e = 0; e < 8; ++e) sel[e] = grp == 0 ? le[e] : (grp == 1 ? le[8 + e] : (grp == 2 ? le[16 + e] : le[24 + e]));
        int i1 = 0; float m1 = sel[0];
#pragma unroll
        for (int e = 1; e < 8; ++e) if (sel[e] > m1) { m1 = sel[e]; i1 = e; }
        int i2 = -1; float m2 = -3.0e38f;
#pragma unroll
        for (int e = 0; e < 8; ++e) if (e != i1 && sel[e] > m2) { m2 = sel[e]; i2 = e; }
        const float e2 = __expf(m2 - m1), gate1 = grp_p / (1.f + e2), gate2 = grp_p * e2 / (1.f + e2);
        if (lane == 0) { const int l1 = grp * 8 + i1, l2 = 32 + grp * 8 + i2;
            const unsigned p1 = atomicAdd(cnt + l1, 1u), p2 = atomicAdd(cnt + l2, 1u);
            lists[(size_t)l1 * T + p1] = m; lists[(size_t)l2 * T + p2] = m; tokg[(size_t)m * 2] = gate1; tokg[(size_t)m * 2 + 1] = gate2; }
    }
}

__global__ void __launch_bounds__(512, 2) hybrid_fwd(Args args) {
    extern __shared__ __attribute__((aligned(16))) unsigned char lds_raw[];
    LAS unsigned char* lds = (LAS unsigned char*)lds_raw;
    const int tid = threadIdx.x, wg = blockIdx.x, G = gridDim.x;
    unsigned char* ws = args.ws;
    volatile LAS unsigned* MISC = (volatile LAS unsigned*)(lds + LDS_MISC);
    if (tid < 16) MISC[tid] = 0u;
    __syncthreads();
    XcdBarrier bar; bar.bar = (unsigned*)(ws + WS_CTL) + CW_BAR; bar.x = 0; bar.st = nullptr;
    if (MK_N_LAUNCHES == 1) bar = xcd_barrier_post((unsigned*)(ws + WS_CTL) + CW_BAR, MISC);
    const int lo = args.ph_lo, hi = args.ph_hi;
#ifndef PHASE_MASK
#define PHASE_MASK 0xFFF
#endif
#define IN(k) (((PHASE_MASK >> (k)) & 1) && lo <= (k) && (k) < hi)
#define SEAM(k) do { if (IN(k) && IN((k) + 1)) xcd_barrier(bar); } while (0)
#define NAIVE(k) ((NAIVE_GEMM_MASK >> (k)) & 1)

    if (IN(0)) { p0_prologue(args, lds, wg, G); }
    SEAM(0);
    if (IN(1)) {
        pg8::StaticOrder S; S.init(ws + WS_H, ws + WS_WIN, T, NIN, D, G, wg);
        FIn f{(bf16_t*)(ws + WS_QKV), (bf16_t*)(ws + WS_PR), (bf16_t*)args.out};
        if (NAIVE(1)) pg8::gemm_naive<false>(D, S, f); else { pg8::EpiRow8<FIn> E{f}; pg8::gemm_phase(lds, D, S, E); }
    }
    SEAM(1);
    if (IN(2)) { p2_lora_in(args, wg, G); }
    SEAM(2);
    if (IN(3)) {
        pg8::StaticOrder S; S.init(ws + WS_H, ws + WS_WLORA, T, 1536, LK, G, wg);
        FLora f{(bf16_t*)(ws + WS_LAG), args.in[I_W0], args.in[I_A0]};
        if (NAIVE(3)) pg8::gemm_naive<false>(LK, S, f); else { pg8::EpiRow8<FLora> E{f}; pg8::gemm_phase(lds, LK, S, E); }
    }
    SEAM(3);
    if (IN(4)) {
        const int nscan = G / 2;
        if (wg < nscan) { for (int u = wg; u < BATCH * 8; u += nscan) scan_unit(args, lds, u >> 3, u & 7); }
        else { for (int u = wg - nscan; u < 3072; u += G - nscan) attn_unit(args, lds, u); }
    }
    SEAM(4);
    if (IN(5)) { p5_combine(args, wg, G); }
    SEAM(5);
    if (IN(6)) {
        { pg8::StaticOrder S; S.init(ws + WS_ATT, ws + WS_WATT, T, D, 256, G, wg);
          FMix1 f{(bf16_t*)(ws + WS_H), (const bf16_t*)args.out};
          if (NAIVE(6)) pg8::gemm_naive<false>(256, S, f); else { pg8::EpiRow8<FMix1> E{f}; pg8::gemm_phase(lds, 256, S, E); } }
        VM_WAIT(); __syncthreads();
        { pg8::StaticOrder S; S.init(ws + WS_ORW, ws + WS_WRWKV, T, D, CR, G, wg);
          FMix2 f{(bf16_t*)(ws + WS_H), (const bf16_t*)args.out};
          if (NAIVE(6)) pg8::gemm_naive<false>(CR, S, f); else { pg8::EpiRow8<FMix2> E{f}; pg8::gemm_phase(lds, CR, S, E); } }
    }
    SEAM(6);
    if (IN(7)) {
        pg8::StaticOrder S; S.init(ws + WS_H, ws + WS_WOUT, T, D, D, G, wg);
        FOut f{args.in[I_X], args.out};
        if (NAIVE(7)) pg8::gemm_naive<false>(D, S, f); else { pg8::EpiRow8<FOut> E{f}; pg8::gemm_phase(lds, D, S, E); }
    }
    SEAM(7);
    if (IN(8)) { p8_router(args, lds, wg, G); }
    SEAM(8);
    LAS int* tab = (LAS int*)(lds + LDS_TAB);
    const unsigned* cnt = (const unsigned*)(ws + WS_CTL) + CW_CNT; const int* lists = (const int*)(ws + WS_LIST);
    if (IN(9)) {
        moe_tables(tab, cnt, lists, 0, 64, wg, G);
        MoeOrder S{tab, D, (const char*)(ws + WS_H), (const char*)(ws + WS_WGU), (size_t)1024 * 1024 * 2, 1};
        FGU f{(bf16_t*)(ws + WS_HID), tab};
        if (NAIVE(9)) pg8::gemm_naive<true>(D, S, f); else { pg8::EpiPair8<FGU> E{f}; pg8::gemm_phase(lds, D, S, E); }
    }
    SEAM(9);
    if (IN(10)) {
        moe_tables(tab, cnt, lists, 0, 32, wg, G);
        MoeOrder S{tab, DE, (const char*)(ws + WS_HID), (const char*)(ws + WS_WD), (size_t)1024 * 512 * 2, 0};
        FDown f{args.out, (const float*)(ws + WS_TOKG), tab, 0};
        if (NAIVE(10)) pg8::gemm_naive<false>(DE, S, f); else { pg8::EpiRow8<FDown> E{f}; pg8::gemm_phase(lds, DE, S, E); }
    }
    SEAM(10);
    if (IN(11)) {
        moe_tables(tab, cnt, lists, 32, 64, wg, G);
        MoeOrder S{tab, DE, (const char*)(ws + WS_HID), (const char*)(ws + WS_WD), (size_t)1024 * 512 * 2, 0};
        FDown f{args.out, (const float*)(ws + WS_TOKG), tab, 1};
        if (NAIVE(11)) pg8::gemm_naive<false>(DE, S, f); else { pg8::EpiRow8<FDown> E{f}; pg8::gemm_phase(lds, DE, S, E); }
    }
#undef IN
#undef SEAM
#undef NAIVE
}

extern "C" void kernel_launch(void* const* d_in, const int* in_sizes, int n_in, void* d_out, int out_size, void* d_ws, size_t ws_size, hipStream_t stream) {
    static int grid = 0;
    if (grid == 0) {
        if (n_in != 28 || out_size != T * D || ws_size < WS_END) { fprintf(stderr, "kernel_launch: unexpected problem (n_in %d, out %d, ws %zu)\n", n_in, out_size, ws_size); grid = -1; return; }
        int dev = 0, cus = 0;
        if (hipGetDevice(&dev) != hipSuccess || hipDeviceGetAttribute(&cus, hipDeviceAttributeMultiprocessorCount, dev) != hipSuccess) { grid = -1; return; }
        if (hipFuncSetAttribute((const void*)hybrid_fwd, hipFuncAttributeMaxDynamicSharedMemorySize, LDS_BYTES) != hipSuccess) { fprintf(stderr, "kernel_launch: hipFuncSetAttribute failed\n"); grid = -1; return; }
        int per_cu = 0;
        if (hipOccupancyMaxActiveBlocksPerMultiprocessor(&per_cu, (const void*)hybrid_fwd, 512, LDS_BYTES) != hipSuccess || per_cu < 1) fprintf(stderr, "kernel_launch: occupancy query reports %d\n", per_cu);
        (void)hipGetLastError();
        grid = cus;
    }
    if (grid < 0) return;
    (void)hipMemsetAsync((char*)d_ws + WS_CTL, 0, CTL_ZERO_BYTES, stream);
    Args a{};
    for (int i = 0; i < 28; ++i) a.in[i] = (const float*)d_in[i];
    a.out = (float*)d_out; a.ws = (unsigned char*)d_ws;
    if (MK_N_LAUNCHES == 1) { a.ph_lo = 0; a.ph_hi = NPH; hipLaunchKernelGGL(hybrid_fwd, dim3(grid), dim3(512), LDS_BYTES, stream, a); }
    else { for (int p = 0; p < NPH; ++p) { a.ph_lo = p; a.ph_hi = p + 1; hipLaunchKernelGGL(hybrid_fwd, dim3(grid), dim3(512), LDS_BYTES, stream, a); } }
}
```

```cpp
#include <hip/hip_runtime.h>
#include <cstdio>
#include <cstdint>

#ifndef MK_N_LAUNCHES
#define MK_N_LAUNCHES 1
#endif
#ifndef NAIVE_GEMM_MASK
#define NAIVE_GEMM_MASK 0
#endif

#define LAS __attribute__((address_space(3)))
#define GAS __attribute__((address_space(1)))
typedef unsigned short bf16_t;
typedef short bf16x8 __attribute__((ext_vector_type(8)));
typedef short bf16x4 __attribute__((ext_vector_type(4)));
typedef float f32x4 __attribute__((ext_vector_type(4)));
typedef float f32x2 __attribute__((ext_vector_type(2)));
typedef unsigned u32x4 __attribute__((ext_vector_type(4)));
typedef unsigned u32x2 __attribute__((ext_vector_type(2)));

constexpr int D = 1024, BATCH = 16, SEQ = 2048, T = BATCH * SEQ;
constexpr int AW = 768;
constexpr int RW = 1824;
constexpr int NIN = 6400;
constexpr int CR = 512;
constexpr int LK = 384;
constexpr int NEXP = 32, DE = 512;
constexpr int NLIST = 64;
constexpr int NPH = 12;

constexpr size_t MiB = 1u << 20;
constexpr size_t WS_CTL = 0, CTL_ZERO_BYTES = 1 * MiB;
constexpr size_t WS_LIST = 1 * MiB;
constexpr size_t WS_TOKG = 9 * MiB;
constexpr size_t WS_WIN = 10 * MiB;
constexpr size_t WS_WATT = 23 * MiB;
constexpr size_t WS_WRWKV = 24 * MiB;
constexpr size_t WS_WOUT = 25 * MiB;
constexpr size_t WS_WLORA = 27 * MiB;
constexpr size_t WS_WR = 29 * MiB;
constexpr size_t WS_H = 30 * MiB;
constexpr size_t WS_OG = WS_H;
constexpr size_t WS_LSE = WS_H + 48 * MiB;
constexpr size_t WS_QKV = 94 * MiB;
constexpr size_t WS_WGU = WS_QKV;
constexpr size_t WS_WD = WS_QKV + 64 * MiB;
constexpr size_t WS_PR = 238 * MiB;
constexpr size_t WS_HID = WS_PR;
constexpr size_t WS_LAG = 352 * MiB;
constexpr size_t WS_ATT = 448 * MiB;
constexpr size_t WS_ORW = 464 * MiB;
constexpr size_t WS_END = 496 * MiB;

constexpr int CW_TMO = 0;
constexpr int CW_BAR = 4096;
constexpr int CW_CNT = 16384;

constexpr int LDS_BYTES = 147456;
constexpr int LDS_TAB = 131072;
constexpr int LDS_MISC = 147456 - 64;

#define RLX_AGENT __ATOMIC_RELAXED, __HIP_MEMORY_SCOPE_AGENT
#define LDS_WAIT() asm volatile("s_waitcnt lgkmcnt(0)" ::: "memory")
#define VM_WAIT() asm volatile("s_waitcnt vmcnt(0)" ::: "memory")

__device__ __forceinline__ unsigned cvt_pk_bf16(float lo, float hi) { unsigned r; asm volatile("v_cvt_pk_bf16_f32 %0, %1, %2" : "=v"(r) : "v"(lo), "v"(hi)); return r; }
__device__ __forceinline__ float bf_lo(unsigned u) { return __uint_as_float(u << 16); }
__device__ __forceinline__ float bf_hi(unsigned u) { return __uint_as_float(u & 0xffff0000u); }
__device__ __forceinline__ u32x4 pack8(const float (&v)[8]) { u32x4 w; w.x = cvt_pk_bf16(v[0], v[1]); w.y = cvt_pk_bf16(v[2], v[3]); w.z = cvt_pk_bf16(v[4], v[5]); w.w = cvt_pk_bf16(v[6], v[7]); return w; }
__device__ __forceinline__ void unpack8(u32x4 w, float (&v)[8]) { v[0] = bf_lo(w.x); v[1] = bf_hi(w.x); v[2] = bf_lo(w.y); v[3] = bf_hi(w.y); v[4] = bf_lo(w.z); v[5] = bf_hi(w.z); v[6] = bf_lo(w.w); v[7] = bf_hi(w.w); }
__device__ __forceinline__ void unpack4(u32x2 w, float (&v)[4]) { v[0] = bf_lo(w.x); v[1] = bf_hi(w.x); v[2] = bf_lo(w.y); v[3] = bf_hi(w.y); }
__device__ __forceinline__ float sigmoidf_(float x) { return 1.f / (1.f + __expf(-x)); }
__device__ __forceinline__ float wave_sum(float v) {
#pragma unroll
    for (int o = 1; o < 64; o <<= 1) v += __shfl_xor(v, o);
    return v;
}
template <int CTRL> __device__ __forceinline__ float dpp_f(float x) { return __builtin_bit_cast(float, __builtin_amdgcn_mov_dpp(__builtin_bit_cast(int, x), CTRL, 0xf, 0xf, true)); }
__device__ __forceinline__ float red16(float x) { x += dpp_f<0xB1>(x); x += dpp_f<0x4E>(x); x += dpp_f<0x141>(x); x += dpp_f<0x128>(x); return x; }

__device__ __forceinline__ float red8(float x) { x += dpp_f<0xB1>(x); x += dpp_f<0x4E>(x); x += dpp_f<0x141>(x); return x; }
__device__ __forceinline__ void red8x2(float& x, float& y) {
    asm("s_nop 1\n\t"
        "v_add_f32_dpp %0, %0, %0 quad_perm:[1,0,3,2] row_mask:0xf bank_mask:0xf bound_ctrl:1\n\t"
        "v_add_f32_dpp %1, %1, %1 quad_perm:[1,0,3,2] row_mask:0xf bank_mask:0xf bound_ctrl:1\n\t"
        "s_nop 0\n\t"
        "v_add_f32_dpp %0, %0, %0 quad_perm:[2,3,0,1] row_mask:0xf bank_mask:0xf bound_ctrl:1\n\t"
        "v_add_f32_dpp %1, %1, %1 quad_perm:[2,3,0,1] row_mask:0xf bank_mask:0xf bound_ctrl:1\n\t"
        "s_nop 0\n\t"
        "v_add_f32_dpp %0, %0, %0 row_half_mirror row_mask:0xf bank_mask:0xf bound_ctrl:1\n\t"
        "v_add_f32_dpp %1, %1, %1 row_half_mirror row_mask:0xf bank_mask:0xf bound_ctrl:1"
        : "+v"(x), "+v"(y));
}
__device__ __forceinline__ float fma_s(float a, float b, float c) { float r; asm("v_fma_f32 %0, %1, %2, %3" : "=v"(r) : "v"(a), "v"(b), "v"(c)); return r; }
__device__ __forceinline__ float mul_s(float a, float b) { float r; asm("v_mul_f32_e32 %0, %1, %2" : "=v"(r) : "v"(a), "v"(b)); return r; }
#define XB_TMO      128
#define XB_XCNT(j)  (256  + 64 * (j))
#define XB_XSUB(j)  (1280 + 64 * (j))
#define XB_XGEN(j)  (2304 + 64 * (j))
#define XB_TOP      3328
#define XB_TOPGEN   3392
#define XCD_BAR_WORDS 3456
#define XB_SPIN_CAP (1u << 18)
__device__ __forceinline__ unsigned xb_ld(unsigned* p)              { return __hip_atomic_load(p, __ATOMIC_RELAXED, __HIP_MEMORY_SCOPE_AGENT); }
__device__ __forceinline__ unsigned xb_add(unsigned* p, unsigned v) { return __hip_atomic_fetch_add(p, v, __ATOMIC_RELAXED, __HIP_MEMORY_SCOPE_AGENT); }
__device__ __forceinline__ unsigned xb_xcc_id() { return (unsigned)__builtin_amdgcn_s_getreg((3 << 11) | 20) & 0xFu; }
#define XB_SPIN(cond, bar) do { unsigned _sp = 0; while (cond) { __builtin_amdgcn_s_sleep(1); \
    if ((++_sp & 255u) == 0u) { if (xb_ld(&(bar)[XB_TMO])) break; if (_sp > XB_SPIN_CAP) { atomicAdd(&(bar)[XB_TMO], 1u); break; } } } } while (0)
struct XcdBarrier { unsigned* bar; unsigned x; volatile LAS unsigned* st; };
__device__ __forceinline__ XcdBarrier xcd_barrier_post(unsigned* bar, volatile LAS unsigned* st) {
    XcdBarrier b; b.bar = bar; b.x = xb_xcc_id(); b.st = st;
    if (threadIdx.x == 0) (void)xb_add(&bar[XB_XCNT(b.x)], 1u);
    return b;
}
__device__ __forceinline__ void xcd_barrier_complete(unsigned* bar, unsigned x, unsigned& nloc, unsigned& nx) {
    const unsigned G = gridDim.x * gridDim.y * gridDim.z;
    unsigned sum, cnt, mine, sp = 0u;
    for (;;) {
        sum = 0u; cnt = 0u; mine = 0u;
#pragma unroll
        for (unsigned j = 0; j < 16; ++j) { const unsigned c = xb_ld(&bar[XB_XCNT(j)]); sum += c; cnt += (c > 0u) ? 1u : 0u; mine = (j == x) ? c : mine; }
        if (sum == G) break;
        __builtin_amdgcn_s_sleep(1);
        if ((++sp & 255u) == 0u) { if (xb_ld(&bar[XB_TMO])) break; if (sp > XB_SPIN_CAP) { atomicAdd(&bar[XB_TMO], 1u); break; } }
    }
    nloc = mine > 0u ? mine : 1u; nx = cnt > 0u ? cnt : 1u;
}
__device__ __forceinline__ void xcd_barrier(const XcdBarrier& b) {
    asm volatile("s_waitcnt vmcnt(0)" ::: "memory");
    __syncthreads();
    if (threadIdx.x == 0) {
        unsigned* bar = b.bar;
        __builtin_amdgcn_s_waitcnt(0);
        unsigned nloc = b.st[0], nx = b.st[1];
        if (nloc == 0u) { xcd_barrier_complete(bar, b.x, nloc, nx); b.st[0] = nloc; b.st[1] = nx; }
        const unsigned old = xb_add(&bar[XB_XSUB(b.x)], 1u);
        const unsigned gen = old / nloc;
        if (old + 1u == (gen + 1u) * nloc) {
            __builtin_amdgcn_fence(__ATOMIC_RELEASE, "agent");
            asm volatile("s_waitcnt vmcnt(0)" ::: "memory");
            const unsigned og = xb_add(&bar[XB_TOP], 1u);
            const unsigned tg = og / nx;
            if (og + 1u == (tg + 1u) * nx) xb_add(&bar[XB_TOPGEN], 1u);
            else XB_SPIN(xb_ld(&bar[XB_TOPGEN]) == tg, bar);
            __builtin_amdgcn_fence(__ATOMIC_ACQUIRE, "agent");
            xb_add(&bar[XB_XGEN(b.x)], 1u);
            asm volatile("s_waitcnt vmcnt(0)" ::: "memory");
        } else {
            XB_SPIN(xb_ld(&bar[XB_XGEN(b.x)]) == gen, bar);
            __builtin_amdgcn_fence(__ATOMIC_ACQUIRE, "agent");
            asm volatile("s_waitcnt vmcnt(0)" ::: "memory");
        }
    }
    __syncthreads();
}

namespace pg8 {
constexpr int BM = 256, BK = 64, HALF = 128, HTB = HALF * BK * 2, NXCD = 8, WGM = 8;
__host__ __device__ __forceinline__ int lds_byte(int r, int c) { const int st = (r >> 4) * 2 + (c >> 5), rr = r & 15, cc = c & 31, ob = rr * 64 + cc * 2; return st * 1024 + (ob ^ (((ob >> 9) & 1) << 5)); }
__host__ __device__ __forceinline__ void stage_rc(int b, int& R, int& C) { const int st = b / 1024, sb = b % 1024, swz = sb ^ (((sb >> 9) & 1) << 5); R = (st >> 1) * 16 + swz / 64; C = (st & 1) * 32 + (swz % 64) / 2; }
__host__ __device__ __forceinline__ int perm32(int rho) { const int n = rho >> 4, i = rho & 15; return 8 * (i >> 2) + 4 * n + (i & 3); }

struct Unit { int pm, pn; const char* A; const char* B; int ui, aux; };

struct StaticOrder {
    static constexpr bool GATHER = false;
    int nM, nN, nwg, G, c; const char* A; const char* Bt; size_t tstep;
    __device__ void init(const void* A_, const void* Bt_, int M, int N, int K, int G_, int c_) { A = (const char*)A_; Bt = (const char*)Bt_; nM = M / BM; nN = N / BM; nwg = nM * nN; G = G_; c = c_; tstep = (size_t)BM * K * 2; }
    __device__ bool next(int i, Unit& u) const {
        const long L = (long)i * G + c; if (L >= nwg) return false;
        int wgid = (int)L; { const int q = nwg / NXCD, r = nwg % NXCD, xcd = wgid % NXCD, off = wgid / NXCD; wgid = (xcd < r ? xcd * (q + 1) : r * (q + 1) + (xcd - r) * q) + off; }
        const int nig = WGM * nN, gid = wgid / nig, fm = gid * WGM, gsz = (nM - fm) < WGM ? (nM - fm) : WGM;
        u.pm = fm + ((wgid % nig) % gsz); u.pn = (wgid % nig) / gsz; u.A = A + (size_t)u.pm * tstep; u.B = Bt + (size_t)u.pn * tstep; u.ui = i; u.aux = 0; return true;
    }
    __device__ __forceinline__ unsigned row_off(const Unit&, int) const { return 0u; }
};

template <class F> struct EpiRow8 {
    F f;
    __device__ __forceinline__ void operator()(const f32x4 (&acc)[2][2][4][2], const Unit& u, int wr, int wc, int fr, int fq) const {
        asm volatile("" : "+v"(fr), "+v"(fq));
#pragma unroll
        for (int ai = 0; ai < 2; ++ai)
#pragma unroll
            for (int m = 0; m < 4; ++m) { const int r = ai * HALF + wr * 64 + m * 16 + fr;
#pragma unroll
                for (int bj = 0; bj < 2; ++bj) { const f32x4 a = acc[ai][bj][m][0], b = acc[ai][bj][m][1]; const float v[8] = {a[0], a[1], a[2], a[3], b[0], b[1], b[2], b[3]};
                    f(u, r, bj * HALF + wc * 32 + 8 * fq, v); }
                asm volatile("" ::: "memory"); }
    }
};
template <class F> struct EpiPair8 {
    F f;
    __device__ __forceinline__ void operator()(const f32x4 (&acc)[2][2][4][2], const Unit& u, int wr, int wc, int fr, int fq) const {
        asm volatile("" : "+v"(fr), "+v"(fq));
#pragma unroll
        for (int ai = 0; ai < 2; ++ai)
#pragma unroll
            for (int m = 0; m < 4; ++m) { const int r = ai * HALF + wr * 64 + m * 16 + fr;
                const f32x4 a = acc[ai][0][m][0], b = acc[ai][0][m][1], c = acc[ai][1][m][0], d = acc[ai][1][m][1];
                const float g[8] = {a[0], a[1], a[2], a[3], b[0], b[1], b[2], b[3]}, up[8] = {c[0], c[1], c[2], c[3], d[0], d[1], d[2], d[3]};
                f(u, r, wc * 32 + 8 * fq, g, up); asm volatile("" ::: "memory"); }
    }
};

template <class Epi, class Sched>
__device__ __forceinline__ void gemm_phase(LAS unsigned char* lds, const int K, const Sched& S, const Epi& E) {
    const int tid = threadIdx.x, wid = __builtin_amdgcn_readfirstlane(tid >> 6), lane = tid & 63, wr = wid >> 2, wc = wid & 3, fr = lane & 15, fq = lane >> 4;
    const int nt = K / BK;
    unsigned voffA[2], voffB[2]; int Rr[2], Cb[2];
#pragma unroll
    for (int i = 0; i < 2; ++i) { int R, C; stage_rc(tid * 16 + i * 8192, R, C); const int Rb = (R & ~31) + perm32(R & 31);
        voffA[i] = (unsigned)(R * K + C) * 2u; voffB[i] = (unsigned)(Rb * K + C) * 2u; Rr[i] = R; Cb[i] = C * 2; }
    const size_t kstep = (size_t)(BK * 2);
    const size_t hstep = (size_t)HALF * K * 2;
    const unsigned ldsw = (unsigned)wid * 1024u;
    const int aoff = lds_byte(wr * 64 + fr, fq * 8), boff = lds_byte(wc * 32 + fr, fq * 8);
#define PG8_SA(b, h) (((b) * 2 + (h)) * HTB)
#define PG8_SB(b, h) ((4 + (b) * 2 + (h)) * HTB)
#define PG8_STAGE_B(bufoff, gbase) do { _Pragma("unroll") for (int _i = 0; _i < 2; ++_i) \
        __builtin_amdgcn_global_load_lds((const unsigned*)((const char*)(gbase) + voffB[_i]), (LAS unsigned*)(lds + (bufoff) + ldsw + _i * 8192), 16, 0, 0); } while (0)
#define PG8_STAGE_A(bufoff, gbase, h) do { _Pragma("unroll") for (int _i = 0; _i < 2; ++_i) { \
        const char* _p; if constexpr (Sched::GATHER) _p = (const char*)(gbase) + ao[h][_i]; else _p = (const char*)(gbase) + (h) * hstep + voffA[_i]; \
        __builtin_amdgcn_global_load_lds((const unsigned*)_p, (LAS unsigned*)(lds + (bufoff) + ldsw + _i * 8192), 16, 0, 0); } } while (0)
#define PG8_LDA(dst, b, h) do { _Pragma("unroll") for (int m = 0; m < 4; ++m) _Pragma("unroll") for (int k = 0; k < 2; ++k) dst[m][k] = *(const LAS bf16x8*)(lds + PG8_SA(b, h) + aoff + m * 2048 + k * 1024); } while (0)
#define PG8_LDB(dst, b, h) do { _Pragma("unroll") for (int n = 0; n < 2; ++n) _Pragma("unroll") for (int k = 0; k < 2; ++k) dst[n][k] = *(const LAS bf16x8*)(lds + PG8_SB(b, h) + boff + n * 2048 + k * 1024); } while (0)
#define PG8_MMA(ai, bj, At, Bt) do { __builtin_amdgcn_s_setprio(1); _Pragma("unroll") for (int m = 0; m < 4; ++m) _Pragma("unroll") for (int n = 0; n < 2; ++n) _Pragma("unroll") for (int k = 0; k < 2; ++k) \
        acc[ai][bj][m][n] = __builtin_amdgcn_mfma_f32_16x16x32_bf16(Bt[n][k], At[m][k], acc[ai][bj][m][n], 0, 0, 0); __builtin_amdgcn_s_setprio(0); } while (0)
#define PG8_WAIT_V(n) asm volatile("s_waitcnt vmcnt(" #n ")" ::: "memory")
#define PG8_WAIT_L(n) asm volatile("s_waitcnt lgkmcnt(" #n ")" ::: "memory")
#define PG8_BAR __builtin_amdgcn_s_barrier()
#define PG8_SCHED __builtin_amdgcn_sched_barrier(0)
    Unit cur, nxt; int ui = 0;
    if (!S.next(0, cur)) return;
    f32x4 acc[2][2][4][2];
#pragma unroll
    for (int a = 0; a < 2; ++a)
#pragma unroll
        for (int b = 0; b < 2; ++b)
#pragma unroll
            for (int m = 0; m < 4; ++m)
#pragma unroll
                for (int n = 0; n < 2; ++n) acc[a][b][m][n] = (f32x4){0.f, 0.f, 0.f, 0.f};
    bf16x8 At[4][2], B0[2][2], B1[2][2];
    const char* cA = cur.A; const char* cB = cur.B;
    unsigned ao[2][2] = {{0u, 0u}, {0u, 0u}};
    if constexpr (Sched::GATHER) {
#pragma unroll
        for (int h = 0; h < 2; ++h)
#pragma unroll
            for (int i = 0; i < 2; ++i) ao[h][i] = S.row_off(cur, h * HALF + Rr[i]) + (unsigned)Cb[i];
    }
    PG8_STAGE_B(PG8_SB(0, 0), cB); PG8_STAGE_B(PG8_SB(0, 1), cB + hstep); PG8_STAGE_A(PG8_SA(0, 0), cA, 0); PG8_STAGE_A(PG8_SA(0, 1), cA, 1);
    if (wr == 1) PG8_BAR;
    PG8_WAIT_V(2); PG8_BAR;
    PG8_STAGE_B(PG8_SB(1, 0), cB + kstep); PG8_STAGE_A(PG8_SA(1, 0), cA + kstep, 0); PG8_STAGE_B(PG8_SB(1, 1), cB + hstep + kstep);
    PG8_WAIT_V(6); PG8_BAR;
    for (;;) {
        const bool has_next = S.next(ui + 1, nxt);
        const char* nA = has_next ? nxt.A : cA; const char* nB = has_next ? nxt.B : cB;
#pragma unroll 1
        for (int t = 0; t < nt; t += 2) {
            const bool last = (t == nt - 2);
            const char* a1 = cA + (size_t)(t + 1) * kstep;
            const char* a2 = last ? nA : cA + (size_t)(t + 2) * kstep; const char* b2 = last ? nB : cB + (size_t)(t + 2) * kstep;
            const char* a3 = a2 + kstep; const char* b3 = b2 + kstep;
            PG8_LDB(B0, 0, 0); PG8_LDB(B1, 0, 1); PG8_SCHED; PG8_LDA(At, 0, 0); PG8_STAGE_A(PG8_SA(1, 1), a1, 1);
            if constexpr (Sched::GATHER) { if (last && has_next) {
#pragma unroll
                for (int h = 0; h < 2; ++h)
#pragma unroll
                    for (int i = 0; i < 2; ++i) ao[h][i] = S.row_off(nxt, h * HALF + Rr[i]) + (unsigned)Cb[i]; } }
            PG8_WAIT_V(8); PG8_WAIT_L(0); PG8_BAR; PG8_MMA(0, 0, At, B0); PG8_MMA(0, 1, At, B1); PG8_BAR; PG8_SCHED;
            PG8_LDA(At, 0, 1); PG8_STAGE_B(PG8_SB(0, 0), b2); PG8_STAGE_B(PG8_SB(0, 1), b2 + hstep); PG8_STAGE_A(PG8_SA(0, 0), a2, 0);
            PG8_WAIT_V(8); PG8_WAIT_L(0); PG8_BAR; PG8_MMA(1, 0, At, B0); PG8_MMA(1, 1, At, B1); PG8_BAR; PG8_SCHED;
            PG8_LDB(B0, 1, 0); PG8_LDB(B1, 1, 1); PG8_SCHED; PG8_LDA(At, 1, 0); PG8_STAGE_A(PG8_SA(0, 1), a2, 1);
            PG8_WAIT_V(8); PG8_WAIT_L(0); PG8_BAR; PG8_MMA(0, 0, At, B0); PG8_MMA(0, 1, At, B1); PG8_BAR; PG8_SCHED;
            PG8_LDA(At, 1, 1); PG8_STAGE_B(PG8_SB(1, 0), b3); PG8_STAGE_B(PG8_SB(1, 1), b3 + hstep); PG8_STAGE_A(PG8_SA(1, 0), a3, 0);
            PG8_WAIT_V(8); PG8_WAIT_L(0); PG8_BAR; PG8_MMA(1, 0, At, B0); PG8_MMA(1, 1, At, B1); PG8_BAR; PG8_SCHED;
        }
        if (wr == 0) PG8_BAR;
        E(acc, cur, wr, wc, fr, fq);
        if (!has_next) break;
#pragma unroll
        for (int a = 0; a < 2; ++a)
#pragma unroll
            for (int b = 0; b < 2; ++b)
#pragma unroll
                for (int m = 0; m < 4; ++m)
#pragma unroll
                    for (int n = 0; n < 2; ++n) acc[a][b][m][n] = (f32x4){0.f, 0.f, 0.f, 0.f};
        cur = nxt; cA = nA; cB = nB; ++ui;
        if (wr == 1) PG8_BAR;
    }
    PG8_WAIT_V(0);
    PG8_BAR;
#undef PG8_SA
#undef PG8_SB
#undef PG8_STAGE_A
#undef PG8_STAGE_B
#undef PG8_LDA
#undef PG8_LDB
#undef PG8_MMA
#undef PG8_WAIT_V
#undef PG8_WAIT_L
#undef PG8_BAR
#undef PG8_SCHED
}

template <bool PAIR, class F, class Sched>
__device__ __forceinline__ void gemm_naive(const int K, const Sched& S, const F& f) {
    Unit u;
    for (int i = 0; S.next(i, u); ++i) {
        const int ncg = PAIR ? 16 : 32;
        for (int it = threadIdx.x; it < 256 * ncg; it += 512) {
            const int r = it & 255, c = (it >> 8) * 8;
            const char* ap = u.A + (Sched::GATHER ? (size_t)S.row_off(u, r) : (size_t)r * K * 2);
            float s0[8], s1[8];
#pragma unroll
            for (int j = 0; j < 8; ++j) { s0[j] = 0.f; s1[j] = 0.f; }
            for (int k = 0; k < K; k += 8) {
                float a[8]; unpack8(*(const u32x4*)(ap + (size_t)k * 2), a);
#pragma unroll
                for (int j = 0; j < 8; ++j) { float b[8]; unpack8(*(const u32x4*)(u.B + ((size_t)(c + j) * K + k) * 2), b);
#pragma unroll
                    for (int e = 0; e < 8; ++e) s0[j] += a[e] * b[e];
                    if constexpr (PAIR) { unpack8(*(const u32x4*)(u.B + ((size_t)(c + 128 + j) * K + k) * 2), b);
#pragma unroll
                        for (int e = 0; e < 8; ++e) s1[j] += a[e] * b[e]; } }
            }
            if constexpr (PAIR) f(u, r, c, s0, s1); else f(u, r, c, s0);
        }
    }
}
}

struct Args { const float* in[28]; float* out; unsigned char* ws; int ph_lo, ph_hi; };
enum { I_X = 0, I_N1G, I_WIN, I_QNG, I_KNG, I_RELB, I_WATT, I_MU, I_W0, I_WUP, I_A0, I_AUP, I_GUP, I_KK, I_KA, I_RK, I_LNW, I_LNB, I_WRWKV, I_WOUT, I_N2G, I_WGR, I_BGR, I_WER, I_BER, I_WEG, I_WEU, I_WED };

__device__ __forceinline__ void tr_item(bf16_t* WT, int Kd, int n0, int k0, const float* src, int ld, int ks0, int cs0, int kvalid, LAS float* scr, int lane) {
    float v[32];
#pragma unroll
    for (int i = 0; i < 32; ++i) { const int kk = 2 * i + (lane >> 5); v[i] = 0.f; if (src != nullptr && kk < kvalid) v[i] = src[(size_t)(ks0 + kk) * ld + cs0 + (lane & 31)]; }
#pragma unroll
    for (int i = 0; i < 32; ++i) { const int kk = 2 * i + (lane >> 5); scr[kk * 33 + (lane & 31)] = v[i]; }
    LDS_WAIT();
    const int c = lane & 7;
#pragma unroll
    for (int j = 0; j < 4; ++j) { const int n = (lane >> 3) + 8 * j; const LAS float* s = scr + (8 * c) * 33 + n;
        u32x4 o; o.x = cvt_pk_bf16(s[0 * 33], s[1 * 33]); o.y = cvt_pk_bf16(s[2 * 33], s[3 * 33]); o.z = cvt_pk_bf16(s[4 * 33], s[5 * 33]); o.w = cvt_pk_bf16(s[6 * 33], s[7 * 33]);
        *(u32x4*)(WT + (size_t)(n0 + n) * Kd + k0 + 8 * c) = o; }
    LDS_WAIT();
}

__device__ __forceinline__ void p0_prologue(const Args& a, LAS unsigned char* lds, int wg, int G) {
    const int tid = threadIdx.x, lane = tid & 63, wave = tid >> 6;
    LAS float* scr = (LAS float*)(lds + wave * 16384);
    const int gw = wg * 8 + wave, NGW = G * 8;
    unsigned char* ws = a.ws;
    constexpr int I_IN = 200 * 16, I_ATT = 32 * 4, I_RWK = 32 * 8, I_OUT = 32 * 16, I_LORA = 48 * 6;
    for (int it = gw; it < I_IN + I_ATT + I_RWK + I_OUT + I_LORA; it += NGW) {
        int r = it;
        if (r < I_IN) { const int nb = r / 16, kb = r % 16, n0 = nb * 32; const float* src = a.in[I_WIN]; int cs0 = n0;
            if (n0 >= 4128 && n0 < 4352) src = nullptr; else if (n0 >= 4352) cs0 = 4128 + (n0 - 4352);
            tr_item((bf16_t*)(ws + WS_WIN), D, n0, kb * 64, src, 6176, kb * 64, cs0, 64, scr, lane); continue; } r -= I_IN;
        if (r < I_ATT) { const int nb = r / 4, kb = r % 4; tr_item((bf16_t*)(ws + WS_WATT), 256, nb * 32, kb * 64, a.in[I_WATT], D, kb * 64, nb * 32, 64, scr, lane); continue; } r -= I_ATT;
        if (r < I_RWK) { const int nb = r / 8, kb = r % 8; tr_item((bf16_t*)(ws + WS_WRWKV), 512, nb * 32, kb * 64, a.in[I_WRWKV], D, kb * 64, nb * 32, 64, scr, lane); continue; } r -= I_RWK;
        if (r < I_OUT) { const int nb = r / 16, kb = r % 16; tr_item((bf16_t*)(ws + WS_WOUT), D, nb * 32, kb * 64, a.in[I_WOUT], D, kb * 64, nb * 32, 64, scr, lane); continue; } r -= I_OUT;
        { const int nb = r / 6, kb = r % 6, n0 = nb * 32; const float* src = nullptr; int ks0 = 0, cs0 = 0, kv = 64;
            if (nb < 16) { if (kb == 0) { src = a.in[I_WUP]; cs0 = n0; } }
            else if (nb < 32) { if (kb == 1) { src = a.in[I_AUP]; cs0 = n0 - 512; } }
            else { if (kb >= 2 && kb <= 4) { src = a.in[I_GUP]; cs0 = n0 - 1024; ks0 = (kb - 2) * 64; kv = (kb == 4) ? 32 : 64; } }
            tr_item((bf16_t*)(ws + WS_WLORA), LK, n0, kb * 64, src, CR, ks0, cs0, kv, scr, lane); }
    }
    {
        bf16_t* WR = (bf16_t*)(ws + WS_WR); const float* g2 = a.in[I_N2G];
        for (int it = wg * 512 + tid; it < 48 * D; it += G * 512) { const int j = it >> 10, c = it & 1023; float w = 0.f;
            if (j < 4) w = g2[c] * a.in[I_WGR][(size_t)c * 4 + j]; else if (j < 36) w = g2[c] * a.in[I_WER][(size_t)c * 32 + (j - 4)];
            const unsigned hi = cvt_pk_bf16(w, 0.f) & 0xffffu; const float lo = w - bf_lo(hi);
            WR[it] = (bf16_t)hi; WR[48 * D + it] = (bf16_t)(cvt_pk_bf16(lo, 0.f) & 0xffffu); }
    }
    const float* x = a.in[I_X]; const float* gn = a.in[I_N1G]; bf16_t* H = (bf16_t*)(ws + WS_H);
    f32x4 g4[4];
#pragma unroll
    for (int j = 0; j < 4; ++j) g4[j] = *(const f32x4*)(gn + 4 * lane + 256 * j);
    for (int m = gw; m < T; m += NGW) {
        const f32x4* xr = (const f32x4*)(x + (size_t)m * D) + lane; f32x4 v[4]; float s = 0.f;
#pragma unroll
        for (int j = 0; j < 4; ++j) { v[j] = xr[64 * j]; s += (v[j].x * v[j].x + v[j].y * v[j].y) + (v[j].z * v[j].z + v[j].w * v[j].w); }
        const float rstd = rsqrtf(wave_sum(s) * (1.f / D) + 1e-6f);
        u32x2* o8 = (u32x2*)(H + (size_t)m * D) + lane;
#pragma unroll
        for (int j = 0; j < 4; ++j) { u32x2 o; o.x = cvt_pk_bf16(v[j].x * rstd * g4[j].x, v[j].y * rstd * g4[j].y); o.y = cvt_pk_bf16(v[j].z * rstd * g4[j].z, v[j].w * rstd * g4[j].w); o8[64 * j] = o; }
    }
}

struct FIn {
    bf16_t *Q, *PR, *GATE;
    __device__ __forceinline__ void operator()(const pg8::Unit& u, int r, int c, const float (&v)[8]) const {
        const size_t row = (size_t)u.pm * 256 + r; const int pn = u.pn;
        if (pn < 9) { bf16_t* base = Q + (size_t)(pn / 3) * ((size_t)T * AW); *(u32x4*)(base + row * AW + (pn % 3) * 256 + c) = pack8(v); }
        else if (pn < 17) { const int j = (pn - 9) * 256 + c; if (j < RW) *(u32x4*)(PR + row * RW + j) = pack8(v); }
        else { const int j = (pn - 17) * 256 + c; float s[8];
#pragma unroll
            for (int e = 0; e < 8; ++e) s[e] = sigmoidf_(v[e]);
            *(u32x4*)(GATE + row * 2048 + j) = pack8(s); }
    }
};
struct FLora {
    bf16_t* LAG; const float* w0; const float* a0;
    __device__ __forceinline__ void operator()(const pg8::Unit& u, int r, int c, const float (&v)[8]) const {
        const size_t row = (size_t)u.pm * 256 + r; const int col = u.pn * 256 + c, which = u.pn >> 1, cc = col & 511; float o[8];
        const float* bias = which == 0 ? w0 : a0;
        const f32x4 b0 = *(const f32x4*)(bias + cc), b1 = *(const f32x4*)(bias + cc + 4);
        const float bv[8] = {b0[0], b0[1], b0[2], b0[3], b1[0], b1[1], b1[2], b1[3]};
#pragma unroll
        for (int e = 0; e < 8; ++e) {
            const float z = bv[e] + v[e];
            const float sg = 1.f / (1.f + __expf(-z));
            const float sp = fmaxf(-z, 0.f) + __logf(1.f + __expf(-fabsf(z)));
            const float ld = -__expf(-sp - 0.5f);
            o[e] = which == 0 ? ld : (which == 1 ? sg : v[e]);
        }
        *(u32x4*)(LAG + row * 1536 + col) = pack8(o);
    }
};
struct FMix1 {
    bf16_t* MIXED; const bf16_t* GATE;
    __device__ __forceinline__ void operator()(const pg8::Unit& u, int r, int c, const float (&v)[8]) const {
        const size_t row = (size_t)u.pm * 256 + r; const int col = u.pn * 256 + c; float g[8], o[8]; unpack8(*(const u32x4*)(GATE + row * 2048 + col), g);
#pragma unroll
        for (int e = 0; e < 8; ++e) o[e] = g[e] * v[e];
        *(u32x4*)(MIXED + row * D + col) = pack8(o);
    }
};
struct FMix2 {
    bf16_t* MIXED; const bf16_t* GATE;
    __device__ __forceinline__ void operator()(const pg8::Unit& u, int r, int c, const float (&v)[8]) const {
        const size_t row = (size_t)u.pm * 256 + r; const int col = u.pn * 256 + c; float g[8], m[8], o[8]; unpack8(*(const u32x4*)(GATE + row * 2048 + 1024 + col), g);
        unpack8(*(const u32x4*)(MIXED + row * D + col), m);
#pragma unroll
        for (int e = 0; e < 8; ++e) o[e] = m[e] + g[e] * v[e];
        *(u32x4*)(MIXED + row * D + col) = pack8(o);
    }
};
struct FOut {
    const float* x; float* out;
    __device__ __forceinline__ void operator()(const pg8::Unit& u, int r, int c, const float (&v)[8]) const {
        const size_t off = ((size_t)u.pm * 256 + r) * D + u.pn * 256 + c; const f32x4 x0 = *(const f32x4*)(x + off), x1 = *(const f32x4*)(x + off + 4);
        *(f32x4*)(out + off) = (f32x4){x0[0] + v[0], x0[1] + v[1], x0[2] + v[2], x0[3] + v[3]}; *(f32x4*)(out + off + 4) = (f32x4){x1[0] + v[4], x1[1] + v[5], x1[2] + v[6], x1[3] + v[7]};
    }
};

struct MoeOrder {
    static constexpr bool GATHER = true;
    LAS int* tab; int K; const char* Abase; const char* Wbase; size_t wexp; int gatherA;
    __device__ bool next(int i, pg8::Unit& u) const {
        if (i >= 8) return false; const LAS int* d = tab + 160 + 4 * i; if (d[3] == 0) return false;
        const int l = d[0], rt = d[1], pn = d[2]; u.pm = rt; u.pn = pn; u.ui = i; u.aux = l;
        u.A = gatherA ? Abase : Abase + (size_t)(tab[l] + rt) * 256 * (size_t)K * 2;
        u.B = Wbase + (size_t)(l & 31) * wexp + (size_t)pn * 256 * (size_t)K * 2; return true;
    }
    __device__ __forceinline__ unsigned row_off(const pg8::Unit& u, int r) const {
        if (gatherA) { int tok = tab[256 + u.ui * 256 + r]; tok = tok < 0 ? 0 : tok; return (unsigned)tok * (unsigned)(K * 2); }
        return (unsigned)r * (unsigned)(K * 2);
    }
};
__device__ __forceinline__ void moe_tables(LAS int* tab, const unsigned* cnt, const int* lists, int l_lo, int l_hi, int wg, int G) {
    const int tid = threadIdx.x;
    __syncthreads();
    if (tid < 64) tab[80 + tid] = (int)cnt[tid];
    __syncthreads();
    if (tid == 0) { int s = 0; for (int l = 0; l < 64; ++l) { tab[l] = s; s += (tab[80 + l] + 255) >> 8; } tab[64] = s; }
    __syncthreads();
    const int t_lo = tab[l_lo], t_hi = tab[l_hi];
    if (tid < 8) { const int L = tid * G + wg, tile = t_lo + (L >> 2); LAS int* d = tab + 160 + 4 * tid;
        if (tile < t_hi) { int l = l_lo; while (tab[l + 1] <= tile) ++l; d[0] = l; d[1] = tile - tab[l]; d[2] = L & 3; d[3] = 1; } else { d[0] = 0; d[1] = 0; d[2] = 0; d[3] = 0; } }
    __syncthreads();
    for (int i = 0; i < 8; ++i) { const LAS int* d = tab + 160 + 4 * i; if (d[3] == 0) break; const int l = d[0], rt = d[1];
        if (tid < 256) { const int pos = rt * 256 + tid; tab[256 + i * 256 + tid] = pos < tab[80 + l] ? lists[(size_t)l * T + pos] : -1; } }
    __syncthreads();
}
struct FGU {
    bf16_t* HID; const LAS int* tab;
    __device__ __forceinline__ void operator()(const pg8::Unit& u, int r, int c, const float (&g)[8], const float (&up)[8]) const {
        const size_t hrow = (size_t)(tab[u.aux] + u.pm) * 256 + r; float o[8];
#pragma unroll
        for (int e = 0; e < 8; ++e) o[e] = g[e] * sigmoidf_(g[e]) * up[e];
        *(u32x4*)(HID + hrow * DE + u.pn * 128 + c) = pack8(o);
    }
};
struct FDown {
    float* out; const float* tokg; const LAS int* tab; int k; int dry;
    __device__ __forceinline__ void operator()(const pg8::Unit& u, int r, int c, const float (&v)[8]) const {
        const int tok = tab[256 + u.ui * 256 + r]; if (tok < 0 || dry) return;
        const float g = tokg[tok * 2 + k]; float* p = out + (size_t)tok * D + u.pn * 256 + c; const f32x4 x0 = *(const f32x4*)p, x1 = *(const f32x4*)(p + 4);
        *(f32x4*)p = (f32x4){x0[0] + g * v[0], x0[1] + g * v[1], x0[2] + g * v[2], x0[3] + g * v[3]}; *(f32x4*)(p + 4) = (f32x4){x1[0] + g * v[4], x1[1] + g * v[5], x1[2] + g * v[6], x1[3] + g * v[7]};
    }
};

__device__ __forceinline__ void p2_lora_in(const Args& a, int wg, int G) {
    const bf16_t* PR = (const bf16_t*)(a.ws + WS_PR); bf16_t* AP = (bf16_t*)(a.ws + WS_H); const float* mu = a.in[I_MU];
    for (int it = wg * 512 + threadIdx.x; it < T * 48; it += G * 512) {
        const int t = it / 48, j = (it % 48) * 8; float o[8];
        if (j < 288) { float p[8], q[8]; unpack8(*(const u32x4*)(PR + (size_t)t * RW + 1536 + j), p);
            if ((t & (SEQ - 1)) != 0) unpack8(*(const u32x4*)(PR + (size_t)(t - 1) * RW + 1536 + j), q); else {
#pragma unroll
                for (int e = 0; e < 8; ++e) q[e] = 0.f; }
#pragma unroll
            for (int e = 0; e < 8; ++e) { const float pm = p[e] + (q[e] - p[e]) * mu[1536 + j + e]; o[e] = j < 64 ? tanhf(pm) : (j < 128 ? pm : sigmoidf_(pm)); }
        } else {
#pragma unroll
            for (int e = 0; e < 8; ++e) o[e] = 0.f; }
        *(u32x4*)(AP + (size_t)t * LK + j) = pack8(o);
    }
}

template <int VAR> __device__ __forceinline__ void scan_unit(const Args& a, LAS unsigned char* lds, int b, int hd, int dummy) {
    constexpr int TC = 32;
    LAS float* buf = (LAS float*)lds;
    LAS float* obuf = buf + 2 * TC * 7 * 64;
    LAS float* bon = obuf + TC * 64;
    const int tid = threadIdx.x, w = tid >> 6, lane = tid & 63;
    const int c = lane & 7, rp = lane >> 3;
    const int row0 = 16 * (w & 3) + rp;
    const int tt = tid >> 4, d4 = (tid & 15) * 4, ch0 = hd * 64 + d4;
    const bf16_t* PR = (const bf16_t*)(a.ws + WS_PR); const bf16_t* LAG = (const bf16_t*)(a.ws + WS_LAG); bf16_t* ORW = (bf16_t*)(a.ws + WS_ORW);
    const f32x4 mu_r = *(const f32x4*)(a.in[I_MU] + ch0), mu_k = *(const f32x4*)(a.in[I_MU] + 512 + ch0), mu_v = *(const f32x4*)(a.in[I_MU] + 1024 + ch0);
    const f32x4 kkp = *(const f32x4*)(a.in[I_KK] + ch0), kap = *(const f32x4*)(a.in[I_KA] + ch0), rkp = *(const f32x4*)(a.in[I_RK] + ch0);
    const f32x4 lnw = *(const f32x4*)(a.in[I_LNW] + ch0), lnb = *(const f32x4*)(a.in[I_LNB] + ch0);
    f32x2 Sx[8];
#pragma unroll
    for (int e = 0; e < 8; ++e) Sx[e] = (f32x2){0.f, 0.f};
    u32x2 pr_r, pr_k, pr_v, pp_r, pp_k, pp_v, p_ld, p_a, p_g;
    auto prefetch = [&](int ch) {
        const int s = ch * TC + tt; const size_t t = (size_t)b * SEQ + s;
        pr_r = *(const u32x2*)(PR + t * RW + ch0); pr_k = *(const u32x2*)(PR + t * RW + 512 + ch0); pr_v = *(const u32x2*)(PR + t * RW + 1024 + ch0);
        if (s > 0) { pp_r = *(const u32x2*)(PR + (t - 1) * RW + ch0); pp_k = *(const u32x2*)(PR + (t - 1) * RW + 512 + ch0); pp_v = *(const u32x2*)(PR + (t - 1) * RW + 1024 + ch0); }
        else { pp_r = (u32x2){0u, 0u}; pp_k = pp_r; pp_v = pp_r; }
        p_ld = *(const u32x2*)(LAG + t * 1536 + ch0); p_a = *(const u32x2*)(LAG + t * 1536 + 512 + ch0); p_g = *(const u32x2*)(LAG + t * 1536 + 1024 + ch0);
    };
    prefetch(0);
    for (int ch = 0; ch < SEQ / TC; ++ch) {
        const int bi = ch & 1; LAS float* B = buf + bi * (TC * 7 * 64) + tt * (7 * 64);
        {
            float r[4], k[4], v[4], pr[4], pk[4], pv[4], ld[4], aa[4], g[4];
            unpack4(pr_r, r); unpack4(pr_k, k); unpack4(pr_v, v); unpack4(pp_r, pr); unpack4(pp_k, pk); unpack4(pp_v, pv); unpack4(p_ld, ld); unpack4(p_a, aa); unpack4(p_g, g);
            float kk[4], kp[4], bb[4], wv[4]; float ssq = 0.f, bsum = 0.f;
#pragma unroll
            for (int e = 0; e < 4; ++e) { r[e] = r[e] + (pr[e] - r[e]) * mu_r[e]; k[e] = k[e] + (pk[e] - k[e]) * mu_k[e]; v[e] = v[e] + (pv[e] - v[e]) * mu_v[e];
                wv[e] = __expf(ld[e]); kk[e] = k[e] * kkp[e]; ssq += kk[e] * kk[e]; kp[e] = k[e] * (1.f + (aa[e] - 1.f) * kap[e]); bsum += r[e] * kp[e] * rkp[e]; }
            ssq = red16(ssq); bsum = red16(bsum);
            const float inv = 1.f / fmaxf(sqrtf(ssq), 1e-12f);
#pragma unroll
            for (int e = 0; e < 4; ++e) { kk[e] *= inv; bb[e] = kk[e] * aa[e]; }
            *(LAS f32x4*)(B + 0 * 64 + d4) = (f32x4){kk[0], kk[1], kk[2], kk[3]};
            *(LAS f32x4*)(B + 1 * 64 + d4) = (f32x4){wv[0], wv[1], wv[2], wv[3]};
            *(LAS f32x4*)(B + 2 * 64 + d4) = (f32x4){bb[0], bb[1], bb[2], bb[3]};
            *(LAS f32x4*)(B + 3 * 64 + d4) = (f32x4){kp[0], kp[1], kp[2], kp[3]};
            *(LAS f32x4*)(B + 4 * 64 + d4) = (f32x4){r[0], r[1], r[2], r[3]};
            *(LAS f32x4*)(B + 5 * 64 + d4) = (f32x4){v[0], v[1], v[2], v[3]};
            *(LAS f32x4*)(B + 6 * 64 + d4) = (f32x4){g[0], g[1], g[2], g[3]};
            if ((tid & 15) == 0) bon[bi * TC + tt] = bsum;
        }
        if (ch + 1 < SEQ / TC) prefetch(ch + 1);
        __syncthreads();
        if (w < 4) {
            const LAS float* Bc = buf + bi * (TC * 7 * 64);
#define SCAN_LD(dst, base, q) do { dst[0] = *(const LAS f32x4*)((base) + (q) * 64 + 8 * c); dst[1] = *(const LAS f32x4*)((base) + (q) * 64 + 8 * c + 4); } while (0)
            f32x4 kk8[2], w8[2], b8[2], k8[2], r8[2]; f32x2 vv;
            SCAN_LD(kk8, Bc, 0); SCAN_LD(w8, Bc, 1); SCAN_LD(b8, Bc, 2); SCAN_LD(k8, Bc, 3); SCAN_LD(r8, Bc, 4); vv = (f32x2){Bc[5 * 64 + row0], Bc[5 * 64 + row0 + 8]};
#pragma unroll 1
            for (int s0 = 0; s0 < TC; s0 += 8) {
                f32x2 keep = (f32x2){0.f, 0.f};
#pragma unroll
                for (int si = 0; si < 8; ++si) {
                    const LAS float* Bn = Bc + (s0 + si + 1) * (7 * 64);
                    f32x4 kk8n[2], w8n[2], b8n[2], k8n[2], r8n[2]; f32x2 vvn;
                    SCAN_LD(kk8n, Bn, 0); SCAN_LD(w8n, Bn, 1); SCAN_LD(b8n, Bn, 2); SCAN_LD(k8n, Bn, 3); SCAN_LD(r8n, Bn, 4); vvn = (f32x2){Bn[5 * 64 + row0], Bn[5 * 64 + row0 + 8]};
                    __builtin_amdgcn_sched_barrier(0x7);
                    f32x2 pa = Sx[0] * kk8[0][0], pb = Sx[4] * kk8[1][0];
#pragma unroll
                    for (int e = 1; e < 4; ++e) { pa = Sx[e] * kk8[0][e] + pa; pb = Sx[4 + e] * kk8[1][e] + pb; }
                    f32x2 p = pa + pb;
                    if constexpr (VAR != 3) { float px = p.x, py = p.y; red8x2(px, py); p = (f32x2){px, py}; }
                    p = -p;
                    f32x2 qa, qb;
#pragma unroll
                    for (int e = 0; e < 4; ++e) {
                        f32x2 t0 = vv * k8[0][e]; t0 = p * b8[0][e] + t0; Sx[e] = Sx[e] * w8[0][e] + t0;
                        f32x2 t1 = vv * k8[1][e]; t1 = p * b8[1][e] + t1; Sx[4 + e] = Sx[4 + e] * w8[1][e] + t1;
                        if (e == 0) { qa = Sx[0] * r8[0][0]; qb = Sx[4] * r8[1][0]; } else { qa = Sx[e] * r8[0][e] + qa; qb = Sx[4 + e] * r8[1][e] + qb; }
                    }
                    f32x2 q = qa + qb;
                    if constexpr (VAR != 3) { float qx = q.x, qy = q.y; red8x2(qx, qy); q = (f32x2){qx, qy}; }
                    keep = (c == si) ? q : keep;
#pragma unroll
                    for (int h = 0; h < 2; ++h) { kk8[h] = kk8n[h]; w8[h] = w8n[h]; b8[h] = b8n[h]; k8[h] = k8n[h]; r8[h] = r8n[h]; }
                    vv = vvn;
                }
                obuf[(s0 + c) * 64 + row0] = keep.x; obuf[(s0 + c) * 64 + row0 + 8] = keep.y;
            }
#undef SCAN_LD
        }
        __syncthreads();
        {
            const f32x4 o4 = *(const LAS f32x4*)(obuf + tt * 64 + d4); const f32x4 v4 = *(const LAS f32x4*)(B + 5 * 64 + d4), g4 = *(const LAS f32x4*)(B + 6 * 64 + d4);
            const float mean = red16((o4[0] + o4[1]) + (o4[2] + o4[3])) * (1.f / 64.f);
            float dv[4], q = 0.f;
#pragma unroll
            for (int e = 0; e < 4; ++e) { dv[e] = o4[e] - mean; q += dv[e] * dv[e]; }
            const float rs = rsqrtf(red16(q) * (1.f / 64.f) + 64e-5f), bs = bon[bi * TC + tt];
            float y[4];
#pragma unroll
            for (int e = 0; e < 4; ++e) y[e] = (dv[e] * rs * lnw[e] + lnb[e] + bs * v4[e]) * g4[e];
            const size_t t = (size_t)b * SEQ + ch * TC + tt;
            u32x2 o; o.x = cvt_pk_bf16(y[0], y[1]); o.y = cvt_pk_bf16(y[2], y[3]);
            if (dummy) *(u32x2*)((bf16_t*)(a.ws + WS_END) + ((t * CR + ch0) & (size_t)0x3fffff)) = o; else *(u32x2*)(ORW + t * CR + ch0) = o;
        }
    }
    __syncthreads();
}

__device__ __forceinline__ int t5_bucket(int dist) {
    if (dist < 16) return dist;
    const float d = (float)dist; int large = 16 + (int)(logf(d / 16.f) / 4.852030263919617f * 16.f); return large < 31 ? large : 31;
}
__device__ __forceinline__ void attn_unit(const Args& a, LAS unsigned char* lds, int unit) {
    const int g = unit >> 10, rem = unit & 1023; int dil, b, r, hd, n;
    b = rem >> 6;
    if (g == 0) { dil = 1; r = 0; hd = (rem >> 4) & 3; n = rem & 15; }
    else if (g == 1) { dil = 4; r = (rem >> 4) & 3; hd = (rem >> 2) & 3; n = rem & 3; }
    else { dil = 16; r = (rem >> 2) & 15; hd = rem & 3; n = 0; }
    const int head = 4 * g + hd, colq = head * 64;
    const bf16_t* Q = (const bf16_t*)(a.ws + WS_QKV); const bf16_t* Kb = Q + (size_t)T * AW; const bf16_t* Vb = Kb + (size_t)T * AW;
    LAS bf16_t* Ks = (LAS bf16_t*)lds;
    LAS bf16_t* VT = (LAS bf16_t*)(lds + 36864);
    LAS float* bias = (LAS float*)(lds + 36864 + 33792);
    const int tid = threadIdx.x, lane = tid & 63, w = tid >> 6;
    __syncthreads();
    {
        const int key = tid >> 1, half = tid & 1, lk = 128 * (n - 1) + key;
        float kv[32], vv[32];
        if (lk >= 0) { const size_t tok = (size_t)b * SEQ + (size_t)lk * dil + r; const u32x4* kp = (const u32x4*)(Kb + tok * AW + colq + 32 * half); const u32x4* vp = (const u32x4*)(Vb + tok * AW + colq + 32 * half);
#pragma unroll
            for (int j = 0; j < 4; ++j) { float t8[8]; unpack8(kp[j], t8);
#pragma unroll
                for (int e = 0; e < 8; ++e) kv[8 * j + e] = t8[e];
                unpack8(vp[j], t8);
#pragma unroll
                for (int e = 0; e < 8; ++e) vv[8 * j + e] = t8[e]; }
        } else {
#pragma unroll
            for (int e = 0; e < 32; ++e) { kv[e] = 0.f; vv[e] = 0.f; } }
        float ssq = 0.f;
#pragma unroll
        for (int e = 0; e < 32; ++e) ssq += kv[e] * kv[e];
        ssq += __shfl_xor(ssq, 1);
        const float rstd = rsqrtf(ssq * (1.f / 64.f) + 1e-6f); const float* kg = a.in[I_KNG] + g * 64 + 32 * half;
#pragma unroll
        for (int j = 0; j < 4; ++j) { float t8[8];
#pragma unroll
            for (int e = 0; e < 8; ++e) t8[e] = kv[8 * j + e] * rstd * kg[8 * j + e];
            *(LAS u32x4*)(Ks + key * 72 + 32 * half + 8 * j) = pack8(t8); }
#pragma unroll
        for (int e = 0; e < 32; e += 2) { const unsigned pk = cvt_pk_bf16(vv[e], vv[e + 1]); VT[(32 * half + e) * 264 + key] = (bf16_t)(pk & 0xffffu); VT[(32 * half + e + 1) * 264 + key] = (bf16_t)(pk >> 16); }
        if (tid < 129) bias[tid] = a.in[I_RELB][t5_bucket(tid * dil) * 12 + head];
    }
    __syncthreads();
    const int iq = lane & 15, rg = lane >> 4, qi = 16 * w + iq;
    const size_t tq = (size_t)b * SEQ + (size_t)(128 * n + qi) * dil + r;
    bf16x8 qf[2];
    {
        float q0[8], q1[8]; unpack8(*(const u32x4*)(Q + tq * AW + colq + 8 * rg), q0); unpack8(*(const u32x4*)(Q + tq * AW + colq + 32 + 8 * rg), q1);
        float ssq = 0.f;
#pragma unroll
        for (int e = 0; e < 8; ++e) ssq += q0[e] * q0[e] + q1[e] * q1[e];
        ssq += __shfl_xor(ssq, 16); ssq += __shfl_xor(ssq, 32);
        const float rstd = rsqrtf(ssq * (1.f / 64.f) + 1e-6f) * 0.125f; const float* qg = a.in[I_QNG] + g * 64;
#pragma unroll
        for (int e = 0; e < 8; ++e) { q0[e] *= rstd * qg[8 * rg + e]; q1[e] *= rstd * qg[32 + 8 * rg + e]; }
        qf[0] = __builtin_bit_cast(bf16x8, pack8(q0)); qf[1] = __builtin_bit_cast(bf16x8, pack8(q1));
    }
    const int u0 = w >> 1;
    f32x4 s[10];
#pragma unroll
    for (int j = 0; j < 10; ++j) { const int kt = 2 * u0 + j;
        const bf16x8 k0 = *(const LAS bf16x8*)(Ks + (16 * kt + iq) * 72 + 8 * rg), k1 = *(const LAS bf16x8*)(Ks + (16 * kt + iq) * 72 + 32 + 8 * rg);
        f32x4 z = (f32x4){0.f, 0.f, 0.f, 0.f};
        z = __builtin_amdgcn_mfma_f32_16x16x32_bf16(k0, qf[0], z, 0, 0, 0); s[j] = __builtin_amdgcn_mfma_f32_16x16x32_bf16(k1, qf[1], z, 0, 0, 0); }
    float mx = -1e30f;
#pragma unroll
    for (int j = 0; j < 10; ++j)
#pragma unroll
        for (int e = 0; e < 4; ++e) { const int kj = 16 * (2 * u0 + j) + 4 * rg + e, rel = qi + 128 - kj; const bool ok = (rel >= 0) && (rel <= 128) && (n > 0 || kj >= 128);
            const int rc = rel < 0 ? 0 : (rel > 128 ? 128 : rel); const float sc = ok ? s[j][e] + bias[rc] : -1e30f; s[j][e] = sc; mx = fmaxf(mx, sc); }
    mx = fmaxf(mx, __shfl_xor(mx, 16)); mx = fmaxf(mx, __shfl_xor(mx, 32));
    float l = 0.f;
#pragma unroll
    for (int j = 0; j < 10; ++j)
#pragma unroll
        for (int e = 0; e < 4; ++e) { const float p = __expf(s[j][e] - mx); s[j][e] = p; l += p; }
    l += __shfl_xor(l, 16); l += __shfl_xor(l, 32);
    f32x4 oacc[4];
#pragma unroll
    for (int dt = 0; dt < 4; ++dt) oacc[dt] = (f32x4){0.f, 0.f, 0.f, 0.f};
#pragma unroll
    for (int ub = 0; ub < 5; ++ub) {
        u32x4 pw; pw.x = cvt_pk_bf16(s[2 * ub][0], s[2 * ub][1]); pw.y = cvt_pk_bf16(s[2 * ub][2], s[2 * ub][3]); pw.z = cvt_pk_bf16(s[2 * ub + 1][0], s[2 * ub + 1][1]); pw.w = cvt_pk_bf16(s[2 * ub + 1][2], s[2 * ub + 1][3]);
        const bf16x8 pf = __builtin_bit_cast(bf16x8, pw); const int kb = 32 * (u0 + ub) + 4 * rg;
#pragma unroll
        for (int dt = 0; dt < 4; ++dt) { const LAS bf16_t* vp = VT + (16 * dt + iq) * 264 + kb; const u32x2 lo = *(const LAS u32x2*)vp, hi = *(const LAS u32x2*)(vp + 16);
            u32x4 vw; vw.x = lo.x; vw.y = lo.y; vw.z = hi.x; vw.w = hi.y;
            oacc[dt] = __builtin_amdgcn_mfma_f32_16x16x32_bf16(__builtin_bit_cast(bf16x8, vw), pf, oacc[dt], 0, 0, 0); }
    }
    const float il = 1.f / l;
    bf16_t* OG = (bf16_t*)(a.ws + WS_OG) + (size_t)g * T * 256; float* LSE = (float*)(a.ws + WS_LSE) + (size_t)g * T * 4;
#pragma unroll
    for (int dt = 0; dt < 4; ++dt) { u32x2 o; o.x = cvt_pk_bf16(oacc[dt][0] * il, oacc[dt][1] * il); o.y = cvt_pk_bf16(oacc[dt][2] * il, oacc[dt][3] * il);
        *(u32x2*)(OG + tq * 256 + hd * 64 + 16 * dt + 4 * rg) = o; }
    if (rg == 0) LSE[tq * 4 + hd] = mx + logf(l);
}

__device__ __forceinline__ void p5_combine(const Args& a, int wg, int G) {
    const bf16_t* OG = (const bf16_t*)(a.ws + WS_OG); const float* LSE = (const float*)(a.ws + WS_LSE); bf16_t* ATT = (bf16_t*)(a.ws + WS_ATT);
    for (int it = wg * 512 + threadIdx.x; it < T * 32; it += G * 512) {
        const int t = it >> 5, hs = (it >> 3) & 3, d8 = (it & 7) * 8;
        const float l0 = LSE[(size_t)t * 4 + hs], l1 = LSE[(size_t)T * 4 + (size_t)t * 4 + hs], l2 = LSE[(size_t)2 * T * 4 + (size_t)t * 4 + hs];
        const float m = fmaxf(l0, fmaxf(l1, l2)); float w0 = __expf(l0 - m), w1 = __expf(l1 - m), w2 = __expf(l2 - m); const float iz = 1.f / (w0 + w1 + w2); w0 *= iz; w1 *= iz; w2 *= iz;
        float o0[8], o1[8], o2[8], o[8]; const size_t off = (size_t)t * 256 + hs * 64 + d8;
        unpack8(*(const u32x4*)(OG + off), o0); unpack8(*(const u32x4*)(OG + (size_t)T * 256 + off), o1); unpack8(*(const u32x4*)(OG + (size_t)2 * T * 256 + off), o2);
#pragma unroll
        for (int e = 0; e < 8; ++e) o[e] = w0 * o0[e] + w1 * o1[e] + w2 * o2[e];
        *(u32x4*)(ATT + off) = pack8(o);
    }
}

__device__ __forceinline__ void p8_router(const Args& a, LAS unsigned char* lds, int wg, int G, int dry) {
    const int tid = threadIdx.x, lane = tid & 63, wave = tid >> 6; const int gw = wg * 8 + wave, NGW = G * 8;
    unsigned char* ws = a.ws;
    {
        LAS float* scr = (LAS float*)(lds + wave * 16384);
        constexpr int I_GU = 32 * 32 * 16, I_DN = 32 * 32 * 8;
        for (int it = gw; it < I_GU + I_DN; it += NGW) {
            if (it < I_GU) { const int e = it >> 9, r = it & 511, nb = r >> 4, kb = r & 15, n0 = nb * 32, pn = n0 >> 8, j = n0 & 255;
                const float* src = (j < 128 ? a.in[I_WEG] : a.in[I_WEU]) + (size_t)e * D * DE;
                tr_item((bf16_t*)(ws + WS_WGU) + (size_t)e * 1024 * 1024, D, n0, kb * 64, src, DE, kb * 64, 128 * pn + (j & 127), 64, scr, lane); }
            else { const int r0 = it - I_GU, e = r0 >> 8, r = r0 & 255, nb = r >> 3, kb = r & 7;
                tr_item((bf16_t*)(ws + WS_WD) + (size_t)e * 1024 * 512, DE, nb * 32, kb * 64, a.in[I_WED] + (size_t)e * DE * D, D, kb * 64, nb * 32, 64, scr, lane); }
        }
    }
    const float* x2 = a.out; const float* gn = a.in[I_N2G]; bf16_t* H2 = (bf16_t*)(ws + WS_H);
    const float* bg = a.in[I_BGR]; const float* be = a.in[I_BER];
    unsigned* cnt = (unsigned*)(ws + WS_CTL) + CW_CNT; int* lists = (int*)(ws + WS_LIST); float* tokg = (float*)(ws + WS_TOKG);
    const bf16_t* Whi = (const bf16_t*)(ws + WS_WR); const bf16_t* Wlo = Whi + 48 * D;
    LAS float* lgt = (LAS float*)(lds + wave * 16384);
    const int tk = lane & 15, kg = lane >> 4;
    for (int tile = gw; tile < T / 16; tile += NGW) {
        const int m0 = tile * 16; const float* xr = x2 + (size_t)(m0 + tk) * D + 8 * kg;
        f32x4 acc[3]; acc[0] = (f32x4){0.f, 0.f, 0.f, 0.f}; acc[1] = acc[0]; acc[2] = acc[0]; float ssq = 0.f;
#pragma unroll 2
        for (int kk = 0; kk < 32; ++kk) {
            const f32x4 x0 = *(const f32x4*)(xr + 32 * kk), x1 = *(const f32x4*)(xr + 32 * kk + 4);
            const float xv[8] = {x0[0], x0[1], x0[2], x0[3], x1[0], x1[1], x1[2], x1[3]}; float hv[8], lv[8];
#pragma unroll
            for (int e = 0; e < 8; ++e) ssq += xv[e] * xv[e];
            const u32x4 hw = pack8(xv); unpack8(hw, hv);
#pragma unroll
            for (int e = 0; e < 8; ++e) lv[e] = xv[e] - hv[e];
            const bf16x8 ahi = __builtin_bit_cast(bf16x8, hw), alo = __builtin_bit_cast(bf16x8, pack8(lv));
#pragma unroll
            for (int nt = 0; nt < 3; ++nt) { const size_t wo = (size_t)(16 * nt + tk) * D + 32 * kk + 8 * kg;
                const bf16x8 bh = *(const bf16x8*)(Whi + wo), bl = *(const bf16x8*)(Wlo + wo);
                acc[nt] = __builtin_amdgcn_mfma_f32_16x16x32_bf16(ahi, bh, acc[nt], 0, 0, 0);
                acc[nt] = __builtin_amdgcn_mfma_f32_16x16x32_bf16(alo, bh, acc[nt], 0, 0, 0);
                acc[nt] = __builtin_amdgcn_mfma_f32_16x16x32_bf16(ahi, bl, acc[nt], 0, 0, 0); }
        }
        ssq += __shfl_xor(ssq, 16); ssq += __shfl_xor(ssq, 32);
        const float rstd = rsqrtf(ssq * (1.f / D) + 1e-6f);
#pragma unroll
        for (int nt = 0; nt < 3; ++nt)
#pragma unroll
            for (int e = 0; e < 4; ++e) lgt[(4 * kg + e) * 49 + 16 * nt + tk] = acc[nt][e];
        LDS_WAIT();
        if (lane < 16) {
            const LAS float* L = lgt + lane * 49; float lg[4], le[32];
#pragma unroll
            for (int e = 0; e < 4; ++e) lg[e] = L[e] * rstd + bg[e];
#pragma unroll
            for (int e = 0; e < 32; ++e) le[e] = L[4 + e] * rstd + be[e];
            int grp = 0; float gm = lg[0];
#pragma unroll
            for (int e = 1; e < 4; ++e) if (lg[e] > gm) { gm = lg[e]; grp = e; }
            float gz = 0.f;
#pragma unroll
            for (int e = 0; e < 4; ++e) gz += __expf(lg[e] - gm);
            const float grp_p = 1.f / gz;
            float sel[8];
#pragma unroll
            for (int e = 0; e < 8; ++e) sel[e] = grp == 0 ? le[e] : (grp == 1 ? le[8 + e] : (grp == 2 ? le[16 + e] : le[24 + e]));
            int i1 = 0; float m1 = sel[0];
#pragma unroll
            for (int e = 1; e < 8; ++e) if (sel[e] > m1) { m1 = sel[e]; i1 = e; }
            int i2 = 0; float m2 = -3.0e38f;
#pragma unroll
            for (int e = 0; e < 8; ++e) if (e != i1 && sel[e] > m2) { m2 = sel[e]; i2 = e; }
            const float e2 = __expf(m2 - m1), gate1 = grp_p / (1.f + e2), gate2 = grp_p * e2 / (1.f + e2);
            const int m = m0 + lane;
            if (!dry) { const int l1 = grp * 8 + i1, l2 = 32 + grp * 8 + i2;
                const unsigned p1 = atomicAdd(cnt + l1, 1u), p2 = atomicAdd(cnt + l2, 1u);
                lists[(size_t)l1 * T + p1] = m; lists[(size_t)l2 * T + p2] = m; }
            tokg[(size_t)m * 2] = gate1; tokg[(size_t)m * 2 + 1] = gate2;
        }
        LDS_WAIT();
        bf16_t* hr = H2 + (size_t)(m0 + tk) * D + 8 * kg;
#pragma unroll 4
        for (int kk = 0; kk < 32; ++kk) {
            const f32x4 x0 = *(const f32x4*)(xr + 32 * kk), x1 = *(const f32x4*)(xr + 32 * kk + 4);
            const f32x4 g0 = *(const f32x4*)(gn + 32 * kk + 8 * kg), g1 = *(const f32x4*)(gn + 32 * kk + 8 * kg + 4);
            const float hv[8] = {x0[0] * rstd * g0[0], x0[1] * rstd * g0[1], x0[2] * rstd * g0[2], x0[3] * rstd * g0[3], x1[0] * rstd * g1[0], x1[1] * rstd * g1[1], x1[2] * rstd * g1[2], x1[3] * rstd * g1[3]};
            *(u32x4*)(hr + 32 * kk) = pack8(hv);
        }
    }
}

__global__ void __launch_bounds__(512, 2) hybrid_fwd(Args args) {
    extern __shared__ __attribute__((aligned(16))) unsigned char lds_raw[];
    LAS unsigned char* lds = (LAS unsigned char*)lds_raw;
    const int tid = threadIdx.x, wg = blockIdx.x, G = gridDim.x;
    unsigned char* ws = args.ws;
    volatile LAS unsigned* MISC = (volatile LAS unsigned*)(lds + LDS_MISC);
    if (tid < 16) MISC[tid] = 0u;
    __syncthreads();
    XcdBarrier bar; bar.bar = (unsigned*)(ws + WS_CTL) + CW_BAR; bar.x = 0; bar.st = nullptr;
    if (MK_N_LAUNCHES == 1) bar = xcd_barrier_post((unsigned*)(ws + WS_CTL) + CW_BAR, MISC);
    const int lo = args.ph_lo, hi = args.ph_hi;
#ifndef PHASE_MASK
#define PHASE_MASK 0xFFF
#endif
#define IN(k) (((PHASE_MASK >> (k)) & 1) && lo <= (k) && (k) < hi)
#define SEAM(k) do { if (IN(k) && IN((k) + 1)) xcd_barrier(bar); } while (0)
#define NAIVE(k) ((NAIVE_GEMM_MASK >> (k)) & 1)

#ifndef REPEAT_MASK
#define REPEAT_MASK 0
#endif
#define REPS(k) for (int rep = 0; rep < 1 + ((REPEAT_MASK >> (k)) & 1); ++rep)
#define REPBAR() do { if (rep) xcd_barrier(bar); } while (0)
    if (IN(0)) REPS(0) { REPBAR(); p0_prologue(args, lds, wg, G); }
    SEAM(0);
    if (IN(1)) REPS(1) {
        REPBAR();
        pg8::StaticOrder S; S.init(ws + WS_H, ws + WS_WIN, T, NIN, D, G, wg);
        FIn f{(bf16_t*)(ws + WS_QKV), (bf16_t*)(ws + WS_PR), (bf16_t*)args.out};
        if (NAIVE(1)) pg8::gemm_naive<false>(D, S, f); else { pg8::EpiRow8<FIn> E{f}; pg8::gemm_phase(lds, D, S, E); }
    }
    SEAM(1);
    if (IN(2)) REPS(2) { REPBAR(); p2_lora_in(args, wg, G); }
    SEAM(2);
    if (IN(3)) REPS(3) {
        REPBAR();
        pg8::StaticOrder S; S.init(ws + WS_H, ws + WS_WLORA, T, 1536, LK, G, wg);
        FLora f{(bf16_t*)(ws + WS_LAG), args.in[I_W0], args.in[I_A0]};
        if (NAIVE(3)) pg8::gemm_naive<false>(LK, S, f); else { pg8::EpiRow8<FLora> E{f}; pg8::gemm_phase(lds, LK, S, E); }
    }
    SEAM(3);
    if (IN(4)) REPS(4) {
        REPBAR();
        const int nscan = G / 2;
#ifndef PROBE_SCAN_VARIANT
#define PROBE_SCAN_VARIANT 0
#endif
#ifdef PROBE_SKIP_SCAN_REP
        if (wg < nscan) { if (!rep) for (int u = wg; u < BATCH * 8; u += nscan) scan_unit<0>(args, lds, u >> 3, u & 7, 0); }
#else
        if (wg < nscan) { if (!rep) { for (int u = wg; u < BATCH * 8; u += nscan) scan_unit<0>(args, lds, u >> 3, u & 7, 0); }
                          else { for (int u = wg; u < BATCH * 8; u += nscan) scan_unit<PROBE_SCAN_VARIANT>(args, lds, u >> 3, u & 7, 1); } }
#endif
#ifdef PROBE_SKIP_ATTN_REP
        else { if (!rep) for (int u = wg - nscan; u < 3072; u += G - nscan) attn_unit(args, lds, u); }
#else
        else { for (int u = wg - nscan; u < 3072; u += G - nscan) attn_unit(args, lds, u); }
#endif
    }
    SEAM(4);
    if (IN(5)) REPS(5) { REPBAR(); p5_combine(args, wg, G); }
    SEAM(5);
    if (IN(6)) REPS(6) {
        REPBAR();
        { pg8::StaticOrder S; S.init(ws + WS_ATT, ws + WS_WATT, T, D, 256, G, wg);
          FMix1 f{(bf16_t*)(ws + WS_H), (const bf16_t*)args.out};
          if (NAIVE(6)) pg8::gemm_naive<false>(256, S, f); else { pg8::EpiRow8<FMix1> E{f}; pg8::gemm_phase(lds, 256, S, E); } }
        VM_WAIT(); __syncthreads();
        { pg8::StaticOrder S; S.init(ws + WS_ORW, ws + WS_WRWKV, T, D, CR, G, wg);
          FMix2 f{(bf16_t*)(ws + WS_H), (const bf16_t*)args.out};
          if (NAIVE(6)) pg8::gemm_naive<false>(CR, S, f); else { pg8::EpiRow8<FMix2> E{f}; pg8::gemm_phase(lds, CR, S, E); } }
    }
    SEAM(6);
    if (IN(7)) REPS(7) {
        REPBAR();
        pg8::StaticOrder S; S.init(ws + WS_H, ws + WS_WOUT, T, D, D, G, wg);
        FOut f{args.in[I_X], args.out};
        if (NAIVE(7)) pg8::gemm_naive<false>(D, S, f); else { pg8::EpiRow8<FOut> E{f}; pg8::gemm_phase(lds, D, S, E); }
    }
    SEAM(7);
    if (IN(8)) REPS(8) { REPBAR(); p8_router(args, lds, wg, G, rep); }
    SEAM(8);
    LAS int* tab = (LAS int*)(lds + LDS_TAB);
    const unsigned* cnt = (const unsigned*)(ws + WS_CTL) + CW_CNT; const int* lists = (const int*)(ws + WS_LIST);
    if (IN(9)) REPS(9) {
        REPBAR();
        moe_tables(tab, cnt, lists, 0, 64, wg, G);
        MoeOrder S{tab, D, (const char*)(ws + WS_H), (const char*)(ws + WS_WGU), (size_t)1024 * 1024 * 2, 1};
        FGU f{(bf16_t*)(ws + WS_HID), tab};
        if (NAIVE(9)) pg8::gemm_naive<true>(D, S, f); else { pg8::EpiPair8<FGU> E{f}; pg8::gemm_phase(lds, D, S, E); }
    }
    SEAM(9);
    if (IN(10)) REPS(10) {
        REPBAR();
        moe_tables(tab, cnt, lists, 0, 32, wg, G);
        MoeOrder S{tab, DE, (const char*)(ws + WS_HID), (const char*)(ws + WS_WD), (size_t)1024 * 512 * 2, 0};
        FDown f{args.out, (const float*)(ws + WS_TOKG), tab, 0, rep};
        if (NAIVE(10)) pg8::gemm_naive<false>(DE, S, f); else { pg8::EpiRow8<FDown> E{f}; pg8::gemm_phase(lds, DE, S, E); }
    }
    SEAM(10);
    if (IN(11)) REPS(11) {
        REPBAR();
        moe_tables(tab, cnt, lists, 32, 64, wg, G);
        MoeOrder S{tab, DE, (const char*)(ws + WS_HID), (const char*)(ws + WS_WD), (size_t)1024 * 512 * 2, 0};
        FDown f{args.out, (const float*)(ws + WS_TOKG), tab, 1, rep};
        if (NAIVE(11)) pg8::gemm_naive<false>(DE, S, f); else { pg8::EpiRow8<FDown> E{f}; pg8::gemm_phase(lds, DE, S, E); }
    }
#undef IN
#undef SEAM
#undef NAIVE
}

extern "C" void kernel_launch(void* const* d_in, const int* in_sizes, int n_in, void* d_out, int out_size, void* d_ws, size_t ws_size, hipStream_t stream) {
    static int grid = 0;
    if (grid == 0) {
        if (n_in != 28 || out_size != T * D || ws_size < WS_END) { fprintf(stderr, "kernel_launch: unexpected problem (n_in %d, out %d, ws %zu)\n", n_in, out_size, ws_size); grid = -1; return; }
        int dev = 0, cus = 0;
        if (hipGetDevice(&dev) != hipSuccess || hipDeviceGetAttribute(&cus, hipDeviceAttributeMultiprocessorCount, dev) != hipSuccess) { grid = -1; return; }
        if (hipFuncSetAttribute((const void*)hybrid_fwd, hipFuncAttributeMaxDynamicSharedMemorySize, LDS_BYTES) != hipSuccess) { fprintf(stderr, "kernel_launch: hipFuncSetAttribute failed\n"); grid = -1; return; }
        int per_cu = 0;
        if (hipOccupancyMaxActiveBlocksPerMultiprocessor(&per_cu, (const void*)hybrid_fwd, 512, LDS_BYTES) != hipSuccess || per_cu < 1) fprintf(stderr, "kernel_launch: occupancy query reports %d\n", per_cu);
        (void)hipGetLastError();
        grid = cus;
    }
    if (grid < 0) return;
    (void)hipMemsetAsync((char*)d_ws + WS_CTL, 0, CTL_ZERO_BYTES, stream);
    Args a{};
    for (int i = 0; i < 28; ++i) a.in[i] = (const float*)d_in[i];
    a.out = (float*)d_out; a.ws = (unsigned char*)d_ws;
    if (MK_N_LAUNCHES == 1) { a.ph_lo = 0; a.ph_hi = NPH; hipLaunchKernelGGL(hybrid_fwd, dim3(grid), dim3(512), LDS_BYTES, stream, a); }
    else { for (int p = 0; p < NPH; ++p) { a.ph_lo = p; a.ph_hi = p + 1; hipLaunchKernelGGL(hybrid_fwd, dim3(grid), dim3(512), LDS_BYTES, stream, a); } }
}
```

```cpp
#include <hip/hip_runtime.h>
#include <cstdio>
#include <cstdint>

#ifndef MK_N_LAUNCHES
#define MK_N_LAUNCHES 1
#endif
#ifndef NAIVE_GEMM_MASK
#define NAIVE_GEMM_MASK 0
#endif

#define LAS __attribute__((address_space(3)))
#define GAS __attribute__((address_space(1)))
typedef unsigned short bf16_t;
typedef short bf16x8 __attribute__((ext_vector_type(8)));
typedef short bf16x4 __attribute__((ext_vector_type(4)));
typedef float f32x4 __attribute__((ext_vector_type(4)));
typedef float f32x2 __attribute__((ext_vector_type(2)));
typedef unsigned u32x4 __attribute__((ext_vector_type(4)));
typedef unsigned u32x2 __attribute__((ext_vector_type(2)));

constexpr int D = 1024, BATCH = 16, SEQ = 2048, T = BATCH * SEQ;
constexpr int AW = 768;
constexpr int RW = 1824;
constexpr int NIN = 6144;
constexpr int CR = 512;
constexpr int LK = 384;
constexpr int NEXP = 32, DE = 512;
constexpr int NLIST = 64;
constexpr int NPH = 12;

constexpr size_t MiB = 1u << 20;
constexpr size_t WS_CTL = 0, CTL_ZERO_BYTES = 1 * MiB;
constexpr size_t WS_LIST = 1 * MiB;
constexpr size_t WS_TOKG = 9 * MiB;
constexpr size_t WS_WIN = 10 * MiB;
constexpr size_t WS_WATT = 23 * MiB;
constexpr size_t WS_WRWKV = 24 * MiB;
constexpr size_t WS_WOUT = 25 * MiB;
constexpr size_t WS_WLORA = 27 * MiB;
constexpr size_t WS_WR = 29 * MiB;
constexpr size_t WS_H = 30 * MiB;
constexpr size_t WS_OG = WS_H;
constexpr size_t WS_LSE = WS_H + 48 * MiB;
constexpr size_t WS_QKV = 94 * MiB;
constexpr size_t WS_WGU = WS_QKV;
constexpr size_t WS_WD = WS_QKV + 64 * MiB;
constexpr size_t WS_PR = 238 * MiB;
constexpr size_t WS_HID = WS_PR;
constexpr size_t WS_LAG = 352 * MiB;
constexpr size_t WS_ATT = 448 * MiB;
constexpr size_t WS_AP = WS_ATT;
constexpr size_t WS_ORW = 464 * MiB;
constexpr size_t WS_END = 496 * MiB;

constexpr int CW_TMO = 0;
constexpr int CW_BAR = 4096;
constexpr int CW_CNT = 16384;
constexpr int CW_QH = 20480;

constexpr int LDS_BYTES = 147456;
constexpr int LDS_TAB = 131072;
constexpr int LDS_MISC = 147456 - 64;

#define RLX_AGENT __ATOMIC_RELAXED, __HIP_MEMORY_SCOPE_AGENT
#define LDS_WAIT() asm volatile("s_waitcnt lgkmcnt(0)" ::: "memory")
#define VM_WAIT() asm volatile("s_waitcnt vmcnt(0)" ::: "memory")

typedef __bf16 bf16x2_t __attribute__((ext_vector_type(2)));
__device__ __forceinline__ unsigned cvt_pk_bf16(float lo, float hi) { const f32x2 v = {lo, hi}; const bf16x2_t b = __builtin_convertvector(v, bf16x2_t); return __builtin_bit_cast(unsigned, b); }
__device__ __forceinline__ float bf_lo(unsigned u) { return __uint_as_float(u << 16); }
__device__ __forceinline__ float bf_hi(unsigned u) { return __uint_as_float(u & 0xffff0000u); }
__device__ __forceinline__ u32x4 pack8(const float (&v)[8]) { u32x4 w; w.x = cvt_pk_bf16(v[0], v[1]); w.y = cvt_pk_bf16(v[2], v[3]); w.z = cvt_pk_bf16(v[4], v[5]); w.w = cvt_pk_bf16(v[6], v[7]); return w; }
__device__ __forceinline__ void unpack8(u32x4 w, float (&v)[8]) { v[0] = bf_lo(w.x); v[1] = bf_hi(w.x); v[2] = bf_lo(w.y); v[3] = bf_hi(w.y); v[4] = bf_lo(w.z); v[5] = bf_hi(w.z); v[6] = bf_lo(w.w); v[7] = bf_hi(w.w); }
__device__ __forceinline__ void unpack4(u32x2 w, float (&v)[4]) { v[0] = bf_lo(w.x); v[1] = bf_hi(w.x); v[2] = bf_lo(w.y); v[3] = bf_hi(w.y); }
__device__ __forceinline__ float sigmoidf_(float x) { return 1.f / (1.f + __expf(-x)); }
__device__ __forceinline__ float wave_sum(float v) {
#pragma unroll
    for (int o = 1; o < 64; o <<= 1) v += __shfl_xor(v, o);
    return v;
}
template <int CTRL> __device__ __forceinline__ float dpp_f(float x) { return __builtin_bit_cast(float, __builtin_amdgcn_mov_dpp(__builtin_bit_cast(int, x), CTRL, 0xf, 0xf, true)); }
__device__ __forceinline__ float red16(float x) { x += dpp_f<0xB1>(x); x += dpp_f<0x4E>(x); x += dpp_f<0x141>(x); x += dpp_f<0x128>(x); return x; }

__device__ __forceinline__ float red8(float x) { x += dpp_f<0xB1>(x); x += dpp_f<0x4E>(x); x += dpp_f<0x141>(x); return x; }
__device__ __forceinline__ void red8x2(float& x, float& y) {
    asm("s_nop 1\n\t"
        "v_add_f32_dpp %0, %0, %0 quad_perm:[1,0,3,2] row_mask:0xf bank_mask:0xf bound_ctrl:1\n\t"
        "v_add_f32_dpp %1, %1, %1 quad_perm:[1,0,3,2] row_mask:0xf bank_mask:0xf bound_ctrl:1\n\t"
        "s_nop 0\n\t"
        "v_add_f32_dpp %0, %0, %0 quad_perm:[2,3,0,1] row_mask:0xf bank_mask:0xf bound_ctrl:1\n\t"
        "v_add_f32_dpp %1, %1, %1 quad_perm:[2,3,0,1] row_mask:0xf bank_mask:0xf bound_ctrl:1\n\t"
        "s_nop 0\n\t"
        "v_add_f32_dpp %0, %0, %0 row_half_mirror row_mask:0xf bank_mask:0xf bound_ctrl:1\n\t"
        "v_add_f32_dpp %1, %1, %1 row_half_mirror row_mask:0xf bank_mask:0xf bound_ctrl:1"
        : "+v"(x), "+v"(y));
}
__device__ __forceinline__ float fma_s(float a, float b, float c) { float r; asm("v_fma_f32 %0, %1, %2, %3" : "=v"(r) : "v"(a), "v"(b), "v"(c)); return r; }
__device__ __forceinline__ float mul_s(float a, float b) { float r; asm("v_mul_f32_e32 %0, %1, %2" : "=v"(r) : "v"(a), "v"(b)); return r; }
#define XB_TMO      128
#define XB_XCNT(j)  (256  + 64 * (j))
#define XB_XSUB(j)  (1280 + 64 * (j))
#define XB_XGEN(j)  (2304 + 64 * (j))
#define XB_TOP      3328
#define XB_TOPGEN   3392
#define XCD_BAR_WORDS 3456
#define XB_SPIN_CAP (1u << 18)
__device__ __forceinline__ unsigned xb_ld(unsigned* p)              { return __hip_atomic_load(p, __ATOMIC_RELAXED, __HIP_MEMORY_SCOPE_AGENT); }
__device__ __forceinline__ unsigned xb_add(unsigned* p, unsigned v) { return __hip_atomic_fetch_add(p, v, __ATOMIC_RELAXED, __HIP_MEMORY_SCOPE_AGENT); }
__device__ __forceinline__ unsigned xb_xcc_id() { return (unsigned)__builtin_amdgcn_s_getreg((3 << 11) | 20) & 0xFu; }
#define XB_SPIN(cond, bar) do { unsigned _sp = 0; while (cond) { __builtin_amdgcn_s_sleep(1); \
    if ((++_sp & 255u) == 0u) { if (xb_ld(&(bar)[XB_TMO])) break; if (_sp > XB_SPIN_CAP) { atomicAdd(&(bar)[XB_TMO], 1u); break; } } } } while (0)
struct XcdBarrier { unsigned* bar; unsigned x; volatile LAS unsigned* st; };
__device__ __forceinline__ XcdBarrier xcd_barrier_post(unsigned* bar, volatile LAS unsigned* st) {
    XcdBarrier b; b.bar = bar; b.x = xb_xcc_id(); b.st = st;
    if (threadIdx.x == 0) (void)xb_add(&bar[XB_XCNT(b.x)], 1u);
    return b;
}
__device__ __forceinline__ void xcd_barrier_complete(unsigned* bar, unsigned x, unsigned& nloc, unsigned& nx) {
    const unsigned G = gridDim.x * gridDim.y * gridDim.z;
    unsigned sum, cnt, mine, sp = 0u;
    for (;;) {
        sum = 0u; cnt = 0u; mine = 0u;
#pragma unroll
        for (unsigned j = 0; j < 16; ++j) { const unsigned c = xb_ld(&bar[XB_XCNT(j)]); sum += c; cnt += (c > 0u) ? 1u : 0u; mine = (j == x) ? c : mine; }
        if (sum == G) break;
        __builtin_amdgcn_s_sleep(1);
        if ((++sp & 255u) == 0u) { if (xb_ld(&bar[XB_TMO])) break; if (sp > XB_SPIN_CAP) { atomicAdd(&bar[XB_TMO], 1u); break; } }
    }
    nloc = mine > 0u ? mine : 1u; nx = cnt > 0u ? cnt : 1u;
}
__device__ __forceinline__ void xcd_barrier(const XcdBarrier& b) {
    asm volatile("s_waitcnt vmcnt(0)" ::: "memory");
    __syncthreads();
    if (threadIdx.x == 0) {
        unsigned* bar = b.bar;
        __builtin_amdgcn_s_waitcnt(0);
        unsigned nloc = b.st[0], nx = b.st[1];
        if (nloc == 0u) { xcd_barrier_complete(bar, b.x, nloc, nx); b.st[0] = nloc; b.st[1] = nx; }
        const unsigned old = xb_add(&bar[XB_XSUB(b.x)], 1u);
        const unsigned gen = old / nloc;
        if (old + 1u == (gen + 1u) * nloc) {
            __builtin_amdgcn_fence(__ATOMIC_RELEASE, "agent");
            asm volatile("s_waitcnt vmcnt(0)" ::: "memory");
            const unsigned og = xb_add(&bar[XB_TOP], 1u);
            const unsigned tg = og / nx;
            if (og + 1u == (tg + 1u) * nx) xb_add(&bar[XB_TOPGEN], 1u);
            else XB_SPIN(xb_ld(&bar[XB_TOPGEN]) == tg, bar);
            __builtin_amdgcn_fence(__ATOMIC_ACQUIRE, "agent");
            xb_add(&bar[XB_XGEN(b.x)], 1u);
            asm volatile("s_waitcnt vmcnt(0)" ::: "memory");
        } else {
            XB_SPIN(xb_ld(&bar[XB_XGEN(b.x)]) == gen, bar);
            __builtin_amdgcn_fence(__ATOMIC_ACQUIRE, "agent");
            asm volatile("s_waitcnt vmcnt(0)" ::: "memory");
        }
    }
    __syncthreads();
}

namespace pg8 {
constexpr int BM = 256, BK = 64, HALF = 128, HTB = HALF * BK * 2, NXCD = 8, WGM = 8;
__host__ __device__ __forceinline__ int lds_byte(int r, int c) { const int st = (r >> 4) * 2 + (c >> 5), rr = r & 15, cc = c & 31, ob = rr * 64 + cc * 2; return st * 1024 + (ob ^ (((ob >> 9) & 1) << 5)); }
__host__ __device__ __forceinline__ void stage_rc(int b, int& R, int& C) { const int st = b / 1024, sb = b % 1024, swz = sb ^ (((sb >> 9) & 1) << 5); R = (st >> 1) * 16 + swz / 64; C = (st & 1) * 32 + (swz % 64) / 2; }
__host__ __device__ __forceinline__ int perm32(int rho) { const int n = rho >> 4, i = rho & 15; return 8 * (i >> 2) + 4 * n + (i & 3); }

struct Unit { int pm, pn; const char* A; const char* B; int ui, aux; };

struct StaticOrder {
    static constexpr bool GATHER = false;
    int nM, nN, nwg, G, c, reps; const char* A; const char* Bt; size_t tstep;
    __device__ void init(const void* A_, const void* Bt_, int M, int N, int K, int G_, int c_, int reps_ = 1) { A = (const char*)A_; Bt = (const char*)Bt_; nM = M / BM; nN = N / BM; nwg = nM * nN; G = G_; c = c_; reps = reps_; tstep = (size_t)BM * K * 2; }
    __device__ bool next(int i, Unit& u) const {
        const long L0 = (long)i * G + c; if (L0 >= (long)nwg * reps) return false;
        const long L = L0 % nwg; u.aux = (int)(L0 / nwg);
        int wgid = (int)L; { const int q = nwg / NXCD, r = nwg % NXCD, xcd = wgid % NXCD, off = wgid / NXCD; wgid = (xcd < r ? xcd * (q + 1) : r * (q + 1) + (xcd - r) * q) + off; }
        const int nig = WGM * nN, gid = wgid / nig, fm = gid * WGM, gsz = (nM - fm) < WGM ? (nM - fm) : WGM;
        u.pm = fm + ((wgid % nig) % gsz); u.pn = (wgid % nig) / gsz; u.A = A + (size_t)u.pm * tstep; u.B = Bt + (size_t)u.pn * tstep; u.ui = i; return true;
    }
    __device__ __forceinline__ unsigned row_off(const Unit&, int) const { return 0u; }
};

template <class F> struct EpiRow8 {
    F f;
    __device__ __forceinline__ void operator()(const f32x4 (&acc)[2][2][4][2], const Unit& u, int wr, int wc, int fr, int fq) const {
        asm volatile("" : "+v"(fr), "+v"(fq));
#pragma unroll
        for (int ai = 0; ai < 2; ++ai) {
            typename F::Pre P[4][2];
#pragma unroll
            for (int m = 0; m < 4; ++m)
#pragma unroll
                for (int bj = 0; bj < 2; ++bj) P[m][bj] = f.pre(u, ai * HALF + wr * 64 + m * 16 + fr, bj * HALF + wc * 32 + 8 * fq);
#pragma unroll
            for (int m = 0; m < 4; ++m) { const int r = ai * HALF + wr * 64 + m * 16 + fr;
#pragma unroll
                for (int bj = 0; bj < 2; ++bj) { const f32x4 a = acc[ai][bj][m][0], b = acc[ai][bj][m][1]; const float v[8] = {a[0], a[1], a[2], a[3], b[0], b[1], b[2], b[3]};
                    f(u, r, bj * HALF + wc * 32 + 8 * fq, v, P[m][bj]); } }
            asm volatile("" ::: "memory"); }
    }
};
template <class F> struct EpiPair8 {
    F f;
    __device__ __forceinline__ void operator()(const f32x4 (&acc)[2][2][4][2], const Unit& u, int wr, int wc, int fr, int fq) const {
        asm volatile("" : "+v"(fr), "+v"(fq));
#pragma unroll
        for (int ai = 0; ai < 2; ++ai)
#pragma unroll
            for (int m = 0; m < 4; ++m) { const int r = ai * HALF + wr * 64 + m * 16 + fr;
                const f32x4 a = acc[ai][0][m][0], b = acc[ai][0][m][1], c = acc[ai][1][m][0], d = acc[ai][1][m][1];
                const float g[8] = {a[0], a[1], a[2], a[3], b[0], b[1], b[2], b[3]}, up[8] = {c[0], c[1], c[2], c[3], d[0], d[1], d[2], d[3]};
                f(u, r, wc * 32 + 8 * fq, g, up); asm volatile("" ::: "memory"); }
    }
};

template <class Epi, class Sched>
__device__ __forceinline__ void gemm_phase(LAS unsigned char* lds, const int K, const Sched& S, const Epi& E) {
    const int tid = threadIdx.x, wid = __builtin_amdgcn_readfirstlane(tid >> 6), lane = tid & 63, wr = wid >> 2, wc = wid & 3, fr = lane & 15, fq = lane >> 4;
    const int nt = K / BK;
    unsigned voffA[2], voffB[2]; int Rr[2], Cb[2];
#pragma unroll
    for (int i = 0; i < 2; ++i) { int R, C; stage_rc(tid * 16 + i * 8192, R, C); const int Rb = (R & ~31) + perm32(R & 31);
        voffA[i] = (unsigned)(R * K + C) * 2u; voffB[i] = (unsigned)(Rb * K + C) * 2u; Rr[i] = R; Cb[i] = C * 2; }
    const size_t kstep = (size_t)(BK * 2);
    const size_t hstep = (size_t)HALF * K * 2;
    const unsigned ldsw = (unsigned)wid * 1024u;
    const int aoff = lds_byte(wr * 64 + fr, fq * 8), boff = lds_byte(wc * 32 + fr, fq * 8);
#define PG8_SA(b, h) (((b) * 2 + (h)) * HTB)
#define PG8_SB(b, h) ((4 + (b) * 2 + (h)) * HTB)
#define PG8_STAGE_B(bufoff, gbase) do { _Pragma("unroll") for (int _i = 0; _i < 2; ++_i) \
        __builtin_amdgcn_global_load_lds((const unsigned*)((const char*)(gbase) + voffB[_i]), (LAS unsigned*)(lds + (bufoff) + ldsw + _i * 8192), 16, 0, 0); } while (0)
#define PG8_STAGE_A(bufoff, gbase, h) do { _Pragma("unroll") for (int _i = 0; _i < 2; ++_i) { \
        const char* _p; if constexpr (Sched::GATHER) _p = (const char*)(gbase) + ao[h][_i]; else _p = (const char*)(gbase) + (h) * hstep + voffA[_i]; \
        __builtin_amdgcn_global_load_lds((const unsigned*)_p, (LAS unsigned*)(lds + (bufoff) + ldsw + _i * 8192), 16, 0, 0); } } while (0)
#define PG8_LDA(dst, b, h) do { _Pragma("unroll") for (int m = 0; m < 4; ++m) _Pragma("unroll") for (int k = 0; k < 2; ++k) dst[m][k] = *(const LAS bf16x8*)(lds + PG8_SA(b, h) + aoff + m * 2048 + k * 1024); } while (0)
#define PG8_LDB(dst, b, h) do { _Pragma("unroll") for (int n = 0; n < 2; ++n) _Pragma("unroll") for (int k = 0; k < 2; ++k) dst[n][k] = *(const LAS bf16x8*)(lds + PG8_SB(b, h) + boff + n * 2048 + k * 1024); } while (0)
#define PG8_MMA(ai, bj, At, Bt) do { __builtin_amdgcn_s_setprio(1); _Pragma("unroll") for (int m = 0; m < 4; ++m) _Pragma("unroll") for (int n = 0; n < 2; ++n) _Pragma("unroll") for (int k = 0; k < 2; ++k) \
        acc[ai][bj][m][n] = __builtin_amdgcn_mfma_f32_16x16x32_bf16(Bt[n][k], At[m][k], acc[ai][bj][m][n], 0, 0, 0); __builtin_amdgcn_s_setprio(0); } while (0)
#define PG8_WAIT_V(n) asm volatile("s_waitcnt vmcnt(" #n ")" ::: "memory")
#define PG8_WAIT_L(n) asm volatile("s_waitcnt lgkmcnt(" #n ")" ::: "memory")
#define PG8_BAR __builtin_amdgcn_s_barrier()
#define PG8_SCHED __builtin_amdgcn_sched_barrier(0)
    Unit cur, nxt; int ui = 0;
    if (!S.next(0, cur)) return;
    f32x4 acc[2][2][4][2];
#pragma unroll
    for (int a = 0; a < 2; ++a)
#pragma unroll
        for (int b = 0; b < 2; ++b)
#pragma unroll
            for (int m = 0; m < 4; ++m)
#pragma unroll
                for (int n = 0; n < 2; ++n) acc[a][b][m][n] = (f32x4){0.f, 0.f, 0.f, 0.f};
    bf16x8 At[4][2], B0[2][2], B1[2][2];
    const char* cA = cur.A; const char* cB = cur.B;
    unsigned ao[2][2] = {{0u, 0u}, {0u, 0u}};
    if constexpr (Sched::GATHER) {
#pragma unroll
        for (int h = 0; h < 2; ++h)
#pragma unroll
            for (int i = 0; i < 2; ++i) ao[h][i] = S.row_off(cur, h * HALF + Rr[i]) + (unsigned)Cb[i];
    }
    PG8_STAGE_B(PG8_SB(0, 0), cB); PG8_STAGE_B(PG8_SB(0, 1), cB + hstep); PG8_STAGE_A(PG8_SA(0, 0), cA, 0); PG8_STAGE_A(PG8_SA(0, 1), cA, 1);
    if (wr == 1) PG8_BAR;
    PG8_WAIT_V(2); PG8_BAR;
    PG8_STAGE_B(PG8_SB(1, 0), cB + kstep); PG8_STAGE_A(PG8_SA(1, 0), cA + kstep, 0); PG8_STAGE_B(PG8_SB(1, 1), cB + hstep + kstep);
    PG8_WAIT_V(6); PG8_BAR;
    for (;;) {
        const bool has_next = S.next(ui + 1, nxt);
        const char* nA = has_next ? nxt.A : cA; const char* nB = has_next ? nxt.B : cB;
#pragma unroll 1
        for (int t = 0; t < nt; t += 2) {
            const bool last = (t == nt - 2);
            const char* a1 = cA + (size_t)(t + 1) * kstep;
            const char* a2 = last ? nA : cA + (size_t)(t + 2) * kstep; const char* b2 = last ? nB : cB + (size_t)(t + 2) * kstep;
            const char* a3 = a2 + kstep; const char* b3 = b2 + kstep;
            PG8_LDB(B0, 0, 0); PG8_LDB(B1, 0, 1); PG8_SCHED; PG8_LDA(At, 0, 0); PG8_STAGE_A(PG8_SA(1, 1), a1, 1);
            if constexpr (Sched::GATHER) { if (last && has_next) {
#pragma unroll
                for (int h = 0; h < 2; ++h)
#pragma unroll
                    for (int i = 0; i < 2; ++i) ao[h][i] = S.row_off(nxt, h * HALF + Rr[i]) + (unsigned)Cb[i]; } }
            PG8_WAIT_V(8); PG8_WAIT_L(0); PG8_BAR; PG8_MMA(0, 0, At, B0); PG8_MMA(0, 1, At, B1); PG8_BAR; PG8_SCHED;
            PG8_LDA(At, 0, 1); PG8_STAGE_B(PG8_SB(0, 0), b2); PG8_STAGE_B(PG8_SB(0, 1), b2 + hstep); PG8_STAGE_A(PG8_SA(0, 0), a2, 0);
            PG8_WAIT_V(8); PG8_WAIT_L(0); PG8_BAR; PG8_MMA(1, 0, At, B0); PG8_MMA(1, 1, At, B1); PG8_BAR; PG8_SCHED;
            PG8_LDB(B0, 1, 0); PG8_LDB(B1, 1, 1); PG8_SCHED; PG8_LDA(At, 1, 0); PG8_STAGE_A(PG8_SA(0, 1), a2, 1);
            PG8_WAIT_V(8); PG8_WAIT_L(0); PG8_BAR; PG8_MMA(0, 0, At, B0); PG8_MMA(0, 1, At, B1); PG8_BAR; PG8_SCHED;
            PG8_LDA(At, 1, 1); PG8_STAGE_B(PG8_SB(1, 0), b3); PG8_STAGE_B(PG8_SB(1, 1), b3 + hstep); PG8_STAGE_A(PG8_SA(1, 0), a3, 0);
            PG8_WAIT_V(8); PG8_WAIT_L(0); PG8_BAR; PG8_MMA(1, 0, At, B0); PG8_MMA(1, 1, At, B1); PG8_BAR; PG8_SCHED;
        }
        if (wr == 0) PG8_BAR;
        E(acc, cur, wr, wc, fr, fq);
        if (!has_next) break;
#pragma unroll
        for (int a = 0; a < 2; ++a)
#pragma unroll
            for (int b = 0; b < 2; ++b)
#pragma unroll
                for (int m = 0; m < 4; ++m)
#pragma unroll
                    for (int n = 0; n < 2; ++n) acc[a][b][m][n] = (f32x4){0.f, 0.f, 0.f, 0.f};
        cur = nxt; cA = nA; cB = nB; ++ui;
        if (wr == 1) PG8_BAR;
    }
    PG8_WAIT_V(0);
    PG8_BAR;
#undef PG8_SA
#undef PG8_SB
#undef PG8_STAGE_A
#undef PG8_STAGE_B
#undef PG8_LDA
#undef PG8_LDB
#undef PG8_MMA
#undef PG8_WAIT_V
#undef PG8_WAIT_L
#undef PG8_BAR
#undef PG8_SCHED
}

template <bool PAIR, class F, class Sched>
__device__ __forceinline__ void gemm_naive(const int K, const Sched& S, const F& f) {
    Unit u;
    for (int i = 0; S.next(i, u); ++i) {
        const int ncg = PAIR ? 16 : 32;
        for (int it = threadIdx.x; it < 256 * ncg; it += 512) {
            const int r = it & 255, c = (it >> 8) * 8;
            const char* ap = u.A + (Sched::GATHER ? (size_t)S.row_off(u, r) : (size_t)r * K * 2);
            float s0[8], s1[8];
#pragma unroll
            for (int j = 0; j < 8; ++j) { s0[j] = 0.f; s1[j] = 0.f; }
            for (int k = 0; k < K; k += 8) {
                float a[8]; unpack8(*(const u32x4*)(ap + (size_t)k * 2), a);
#pragma unroll
                for (int j = 0; j < 8; ++j) { float b[8]; unpack8(*(const u32x4*)(u.B + ((size_t)(c + j) * K + k) * 2), b);
#pragma unroll
                    for (int e = 0; e < 8; ++e) s0[j] += a[e] * b[e];
                    if constexpr (PAIR) { unpack8(*(const u32x4*)(u.B + ((size_t)(c + 128 + j) * K + k) * 2), b);
#pragma unroll
                        for (int e = 0; e < 8; ++e) s1[j] += a[e] * b[e]; } }
            }
            if constexpr (PAIR) f(u, r, c, s0, s1); else f(u, r, c, s0, f.pre(u, r, c));
        }
    }
}
}

struct Args { const float* in[28]; float* out; unsigned char* ws; int ph_lo, ph_hi; };
enum { I_X = 0, I_N1G, I_WIN, I_QNG, I_KNG, I_RELB, I_WATT, I_MU, I_W0, I_WUP, I_A0, I_AUP, I_GUP, I_KK, I_KA, I_RK, I_LNW, I_LNB, I_WRWKV, I_WOUT, I_N2G, I_WGR, I_BGR, I_WER, I_BER, I_WEG, I_WEU, I_WED };

__device__ __forceinline__ void tr_item(bf16_t* WT, int Kd, int n0, int k0, const float* src, int ld, int ks0, int cs0, int kvalid, LAS float* scr, int lane) {
    float v[32];
#pragma unroll
    for (int i = 0; i < 32; ++i) { const int kk = 2 * i + (lane >> 5); v[i] = 0.f; if (src != nullptr && kk < kvalid) v[i] = src[(size_t)(ks0 + kk) * ld + cs0 + (lane & 31)]; }
#pragma unroll
    for (int i = 0; i < 32; ++i) { const int kk = 2 * i + (lane >> 5); scr[kk * 33 + (lane & 31)] = v[i]; }
    LDS_WAIT();
    const int c = lane & 7;
#pragma unroll
    for (int j = 0; j < 4; ++j) { const int n = (lane >> 3) + 8 * j; const LAS float* s = scr + (8 * c) * 33 + n;
        u32x4 o; o.x = cvt_pk_bf16(s[0 * 33], s[1 * 33]); o.y = cvt_pk_bf16(s[2 * 33], s[3 * 33]); o.z = cvt_pk_bf16(s[4 * 33], s[5 * 33]); o.w = cvt_pk_bf16(s[6 * 33], s[7 * 33]);
        *(u32x4*)(WT + (size_t)(n0 + n) * Kd + k0 + 8 * c) = o; }
    LDS_WAIT();
}

__device__ __forceinline__ void p0_prologue(const Args& a, LAS unsigned char* lds, int wg, int G) {
    const int tid = threadIdx.x, lane = tid & 63, wave = tid >> 6;
    LAS float* scr = (LAS float*)(lds + wave * 16384);
    const int gw = wg * 8 + wave, NGW = G * 8;
    unsigned char* ws = a.ws;
    constexpr int I_IN = 193 * 16, I_ATT = 32 * 4, I_RWK = 32 * 8, I_OUT = 32 * 16, I_LORA = 48 * 6;
    for (int it = gw; it < I_IN + I_ATT + I_RWK + I_OUT + I_LORA; it += NGW) {
        int r = it;
        if (r < I_IN) { const int nb = r / 16, kb = r % 16, n0 = nb * 32; int cs0 = n0;
            if (n0 >= 6144) cs0 = 4096; else if (n0 >= 4096) cs0 = n0 + 32;
            tr_item((bf16_t*)(ws + WS_WIN), D, n0, kb * 64, a.in[I_WIN], 6176, kb * 64, cs0, 64, scr, lane); continue; } r -= I_IN;
        if (r < I_ATT) { const int nb = r / 4, kb = r % 4; tr_item((bf16_t*)(ws + WS_WATT), 256, nb * 32, kb * 64, a.in[I_WATT], D, kb * 64, nb * 32, 64, scr, lane); continue; } r -= I_ATT;
        if (r < I_RWK) { const int nb = r / 8, kb = r % 8; tr_item((bf16_t*)(ws + WS_WRWKV), 512, nb * 32, kb * 64, a.in[I_WRWKV], D, kb * 64, nb * 32, 64, scr, lane); continue; } r -= I_RWK;
        if (r < I_OUT) { const int nb = r / 16, kb = r % 16; tr_item((bf16_t*)(ws + WS_WOUT), D, nb * 32, kb * 64, a.in[I_WOUT], D, kb * 64, nb * 32, 64, scr, lane); continue; } r -= I_OUT;
        { const int nb = r / 6, kb = r % 6, n0 = nb * 32; const float* src = nullptr; int ks0 = 0, cs0 = 0, kv = 64;
            if (nb < 16) { if (kb == 0) { src = a.in[I_WUP]; cs0 = n0; } }
            else if (nb < 32) { if (kb == 1) { src = a.in[I_AUP]; cs0 = n0 - 512; } }
            else { if (kb >= 2 && kb <= 4) { src = a.in[I_GUP]; cs0 = n0 - 1024; ks0 = (kb - 2) * 64; kv = (kb == 4) ? 32 : 64; } }
            tr_item((bf16_t*)(ws + WS_WLORA), LK, n0, kb * 64, src, CR, ks0, cs0, kv, scr, lane); }
    }
    {
        bf16_t* WR = (bf16_t*)(ws + WS_WR); const float* g2 = a.in[I_N2G];
        for (int it = wg * 512 + tid; it < 48 * D; it += G * 512) { const int j = it >> 10, c = it & 1023; float w = 0.f;
            if (j < 4) w = g2[c] * a.in[I_WGR][(size_t)c * 4 + j]; else if (j < 36) w = g2[c] * a.in[I_WER][(size_t)c * 32 + (j - 4)];
            const unsigned hi = cvt_pk_bf16(w, 0.f) & 0xffffu; const float lo = w - bf_lo(hi);
            WR[it] = (bf16_t)hi; WR[48 * D + it] = (bf16_t)(cvt_pk_bf16(lo, 0.f) & 0xffffu); }
    }
    const float* x = a.in[I_X]; const float* gn = a.in[I_N1G]; bf16_t* H = (bf16_t*)(ws + WS_H);
    f32x4 g4[4];
#pragma unroll
    for (int j = 0; j < 4; ++j) g4[j] = *(const f32x4*)(gn + 4 * lane + 256 * j);
    for (int m = gw; m < T; m += NGW) {
        const f32x4* xr = (const f32x4*)(x + (size_t)m * D) + lane; f32x4 v[4]; float sq = 0.f;
#pragma unroll
        for (int j = 0; j < 4; ++j) { v[j] = xr[64 * j]; sq += (v[j].x * v[j].x + v[j].y * v[j].y) + (v[j].z * v[j].z + v[j].w * v[j].w); }
        const float rstd = rsqrtf(wave_sum(sq) * (1.f / D) + 1e-6f);
        u32x2* o8 = (u32x2*)(H + (size_t)m * D) + lane;
#pragma unroll
        for (int j = 0; j < 4; ++j) { u32x2 o; o.x = cvt_pk_bf16(v[j].x * rstd * g4[j].x, v[j].y * rstd * g4[j].y); o.y = cvt_pk_bf16(v[j].z * rstd * g4[j].z, v[j].w * rstd * g4[j].w); o8[64 * j] = o; }
    }
}
__device__ __forceinline__ void p0b_extra_cols(const Args& a, int wg, int G) {
    const int tid = threadIdx.x, lane = tid & 63, wave = tid >> 6, tk = lane & 15, kg = lane >> 4; const int gw = wg * 8 + wave, NGW = G * 8;
    const bf16_t* H = (const bf16_t*)(a.ws + WS_H); bf16_t* PRo = (bf16_t*)(a.ws + WS_PR); const bf16_t* Wx = (const bf16_t*)(a.ws + WS_WIN) + (size_t)6144 * D;
    for (int tile = gw; tile < T / 16; tile += NGW) {
        const int m0 = tile * 16; f32x4 acc0 = (f32x4){0.f, 0.f, 0.f, 0.f}, acc1 = acc0;
        const bf16_t* h1 = H + (size_t)(m0 + tk) * D + 8 * kg;
#pragma unroll 8
        for (int kk = 0; kk < 32; ++kk) {
            const bf16x8 a1 = *(const bf16x8*)(h1 + 32 * kk);
            const bf16x8 b0 = *(const bf16x8*)(Wx + (size_t)tk * D + 32 * kk + 8 * kg), b1 = *(const bf16x8*)(Wx + (size_t)(16 + tk) * D + 32 * kk + 8 * kg);
            acc0 = __builtin_amdgcn_mfma_f32_16x16x32_bf16(a1, b0, acc0, 0, 0, 0); acc1 = __builtin_amdgcn_mfma_f32_16x16x32_bf16(a1, b1, acc1, 0, 0, 0);
        }
#pragma unroll
        for (int e = 0; e < 4; ++e) {
            bf16_t* o = PRo + (size_t)(m0 + 4 * kg + e) * RW + 1792 + tk;
            o[0] = (bf16_t)(cvt_pk_bf16(acc0[e], 0.f) & 0xffffu); o[16] = (bf16_t)(cvt_pk_bf16(acc1[e], 0.f) & 0xffffu); }
    }
}

struct FIn {
    bf16_t *Q, *PR, *GATE;
    struct Pre {}; __device__ __forceinline__ Pre pre(const pg8::Unit&, int, int) const { return Pre{}; }
    __device__ __forceinline__ void operator()(const pg8::Unit& u, int r, int c, const float (&v)[8], const Pre&) const {
        const size_t row = (size_t)u.pm * 256 + r; const int pn = u.pn;
        if (pn < 9) { bf16_t* base = Q + (size_t)(pn / 3) * ((size_t)T * AW); *(u32x4*)(base + row * AW + (pn % 3) * 256 + c) = pack8(v); }
        else if (pn < 16) { const int j = (pn - 9) * 256 + c; *(u32x4*)(PR + row * RW + j) = pack8(v); }
        else { const int j = (pn - 16) * 256 + c; float s[8];
#pragma unroll
            for (int e = 0; e < 8; ++e) s[e] = sigmoidf_(v[e]);
            *(u32x4*)(GATE + row * 2048 + j) = pack8(s); }
    }
};
struct FLora {
    bf16_t* LAG; const float* w0; const float* a0;
    struct Pre {}; __device__ __forceinline__ Pre pre(const pg8::Unit&, int, int) const { return Pre{}; }
    __device__ __forceinline__ void operator()(const pg8::Unit& u, int r, int c, const float (&v)[8], const Pre&) const {
        const size_t row = (size_t)u.pm * 256 + r; const int col = u.pn * 256 + c, which = u.pn >> 1, cc = col & 511; float o[8];
        if (which == 2) {
#pragma unroll
            for (int e = 0; e < 8; ++e) o[e] = v[e];
        } else {
            const float* bias = which == 0 ? w0 : a0;
            const f32x4 b0 = *(const f32x4*)(bias + cc), b1 = *(const f32x4*)(bias + cc + 4);
            const float bv[8] = {b0[0], b0[1], b0[2], b0[3], b1[0], b1[1], b1[2], b1[3]};
            if (which == 1) {
#pragma unroll
                for (int e = 0; e < 8; ++e) o[e] = 1.f / (1.f + __expf(-(bv[e] + v[e])));
            } else {
#pragma unroll
                for (int e = 0; e < 8; ++e) { const float z = bv[e] + v[e];
                    const float sp = fmaxf(-z, 0.f) + __logf(1.f + __expf(-fabsf(z)));
                    o[e] = -__expf(-sp - 0.5f); }
            }
        }
        *(u32x4*)(LAG + row * 1536 + col) = pack8(o);
    }
};
struct FMix1 {
    bf16_t* MIXED; const bf16_t* GATE;
    struct Pre { u32x4 g; };
    __device__ __forceinline__ Pre pre(const pg8::Unit& u, int r, int c) const { Pre p; p.g = *(const u32x4*)(GATE + ((size_t)u.pm * 256 + r) * 2048 + u.pn * 256 + c); return p; }
    __device__ __forceinline__ void operator()(const pg8::Unit& u, int r, int c, const float (&v)[8], const Pre& pp) const {
        const size_t row = (size_t)u.pm * 256 + r; const int col = u.pn * 256 + c; float g[8], o[8]; unpack8(pp.g, g);
#pragma unroll
        for (int e = 0; e < 8; ++e) o[e] = g[e] * v[e];
        *(u32x4*)(MIXED + row * D + col) = pack8(o);
    }
};
struct FMix2 {
    bf16_t* MIXED; const bf16_t* GATE;
    struct Pre { u32x4 g, m; };
    __device__ __forceinline__ Pre pre(const pg8::Unit& u, int r, int c) const { const size_t row = (size_t)u.pm * 256 + r; const int col = u.pn * 256 + c; Pre p; p.g = *(const u32x4*)(GATE + row * 2048 + 1024 + col); p.m = *(const u32x4*)(MIXED + row * D + col); return p; }
    __device__ __forceinline__ void operator()(const pg8::Unit& u, int r, int c, const float (&v)[8], const Pre& pp) const {
        const size_t row = (size_t)u.pm * 256 + r; const int col = u.pn * 256 + c; float g[8], m[8], o[8]; unpack8(pp.g, g);
        unpack8(pp.m, m);
#pragma unroll
        for (int e = 0; e < 8; ++e) o[e] = m[e] + g[e] * v[e];
        if (u.aux == 0) *(u32x4*)(MIXED + row * D + col) = pack8(o);
    }
};
struct FOut {
    const float* x; float* out;
    struct Pre { f32x4 x0, x1; };
    __device__ __forceinline__ Pre pre(const pg8::Unit& u, int r, int c) const { const size_t off = ((size_t)u.pm * 256 + r) * D + u.pn * 256 + c; Pre p; p.x0 = *(const f32x4*)(x + off); p.x1 = *(const f32x4*)(x + off + 4); return p; }
    __device__ __forceinline__ void operator()(const pg8::Unit& u, int r, int c, const float (&v)[8], const Pre& pp) const {
        const size_t off = ((size_t)u.pm * 256 + r) * D + u.pn * 256 + c; const f32x4 x0 = pp.x0, x1 = pp.x1;
        *(f32x4*)(out + off) = (f32x4){x0[0] + v[0], x0[1] + v[1], x0[2] + v[2], x0[3] + v[3]}; *(f32x4*)(out + off + 4) = (f32x4){x1[0] + v[4], x1[1] + v[5], x1[2] + v[6], x1[3] + v[7]};
    }
};

struct MoeOrder {
    static constexpr bool GATHER = true;
    LAS int* tab; int K; const char* Abase; const char* Wbase; size_t wexp; int gatherA;
    __device__ bool next(int i, pg8::Unit& u) const {
        if (i >= 8) return false; const LAS int* d = tab + 160 + 4 * i; if (d[3] == 0) return false;
        const int l = d[0], rt = d[1], pn = d[2]; u.pm = rt; u.pn = pn; u.ui = i; u.aux = l;
        u.A = gatherA ? Abase : Abase + (size_t)(tab[l] + rt) * 256 * (size_t)K * 2;
        u.B = Wbase + (size_t)(l & 31) * wexp + (size_t)pn * 256 * (size_t)K * 2; return true;
    }
    __device__ __forceinline__ unsigned row_off(const pg8::Unit& u, int r) const {
        if (gatherA) { int tok = tab[256 + u.ui * 256 + r]; tok = tok < 0 ? 0 : tok; return (unsigned)tok * (unsigned)(K * 2); }
        return (unsigned)r * (unsigned)(K * 2);
    }
};
__device__ __forceinline__ void moe_tables(LAS int* tab, const unsigned* cnt, const int* lists, int l_lo, int l_hi, int wg, int G) {
    const int tid = threadIdx.x;
    __syncthreads();
    if (tid < 64) tab[80 + tid] = (int)cnt[tid];
    __syncthreads();
    if (tid == 0) { int s = 0; for (int l = 0; l < 64; ++l) { tab[l] = s; s += (tab[80 + l] + 255) >> 8; } tab[64] = s; }
    __syncthreads();
    const int t_lo = tab[l_lo], t_hi = tab[l_hi];
    if (tid < 8) { const int L = tid * G + wg, tile = t_lo + (L >> 2); LAS int* d = tab + 160 + 4 * tid;
        if (tile < t_hi) { int l = l_lo; while (tab[l + 1] <= tile) ++l; d[0] = l; d[1] = tile - tab[l]; d[2] = L & 3; d[3] = 1; } else { d[0] = 0; d[1] = 0; d[2] = 0; d[3] = 0; } }
    __syncthreads();
    for (int i = 0; i < 8; ++i) { const LAS int* d = tab + 160 + 4 * i; if (d[3] == 0) break; const int l = d[0], rt = d[1];
        if (tid < 256) { const int pos = rt * 256 + tid; tab[256 + i * 256 + tid] = pos < tab[80 + l] ? lists[(size_t)l * T + pos] : -1; } }
    __syncthreads();
}
struct FGU {
    bf16_t* HID; const LAS int* tab; const float* rstd;
    __device__ __forceinline__ void operator()(const pg8::Unit& u, int r, int c, const float (&g)[8], const float (&up)[8]) const {
        const size_t hrow = (size_t)(tab[u.aux] + u.pm) * 256 + r; float o[8]; int tok = tab[256 + u.ui * 256 + r]; tok = tok < 0 ? 0 : tok; const float rs = rstd[tok];
#pragma unroll
        for (int e = 0; e < 8; ++e) { const float gg = g[e] * rs; o[e] = gg * sigmoidf_(gg) * (up[e] * rs); }
        *(u32x4*)(HID + hrow * DE + u.pn * 128 + c) = pack8(o);
    }
};
struct FDown {
    float* out; const float* tokg; const LAS int* tab; int k; int dry;
    struct Pre { f32x4 x0, x1; float g; };
    __device__ __forceinline__ Pre pre(const pg8::Unit& u, int r, int c) const { Pre p; int tok = tab[256 + u.ui * 256 + r]; tok = tok < 0 ? 0 : tok;
        const float* q = out + (size_t)tok * D + u.pn * 256 + c; p.x0 = *(const f32x4*)q; p.x1 = *(const f32x4*)(q + 4); p.g = tokg[tok * 2 + k]; return p; }
    __device__ __forceinline__ void operator()(const pg8::Unit& u, int r, int c, const float (&v)[8], const Pre& pp) const {
        const int tok = tab[256 + u.ui * 256 + r]; if (tok < 0 || dry) return;
        const float g = pp.g; float* p = out + (size_t)tok * D + u.pn * 256 + c; const f32x4 x0 = pp.x0, x1 = pp.x1;
        *(f32x4*)p = (f32x4){x0[0] + g * v[0], x0[1] + g * v[1], x0[2] + g * v[2], x0[3] + g * v[3]}; *(f32x4*)(p + 4) = (f32x4){x1[0] + g * v[4], x1[1] + g * v[5], x1[2] + g * v[6], x1[3] + g * v[7]};
    }
};

template <int WHICH> __device__ __forceinline__ void lora_cols(const Args& a, const bf16x8 (&af)[10], LAS float* xs, int m0, int lane) {
    constexpr int K0 = WHICH == 0 ? 0 : (WHICH == 1 ? 2 : 4), NK = WHICH == 2 ? 6 : 2;
    const int tk = lane & 15, kg = lane >> 4; const bf16_t* WL = (const bf16_t*)(a.ws + WS_WLORA); bf16_t* LAG = (bf16_t*)(a.ws + WS_LAG);
    bf16x8 bq[2][8];
#define LORA_LDB(buf, cbase, kstep) do { _Pragma("unroll") for (int _n = 0; _n < 8; ++_n) bq[buf][_n] = *(const bf16x8*)(WL + ((unsigned)((cbase) + _n * 16 + tk) * (unsigned)LK + 8u * (unsigned)kg + 32u * (unsigned)(kstep))); } while (0)
    LORA_LDB(0, (WHICH * 4) * 128, K0);
#pragma unroll 1
    for (int cgi = 0; cgi < 4; ++cgi) { const int c0 = (WHICH * 4 + cgi) * 128;
        f32x4 acc[8];
#pragma unroll
        for (int nt = 0; nt < 8; ++nt) acc[nt] = (f32x4){0.f, 0.f, 0.f, 0.f};
#pragma unroll
        for (int ks = 0; ks < NK; ++ks) { constexpr int dummy_ = 0; (void)dummy_; const int cb = ks & 1;
            if (ks + 1 < NK) { if (cb) LORA_LDB(0, c0, K0 + ks + 1); else LORA_LDB(1, c0, K0 + ks + 1); }
            else if (cgi < 3) { if (cb) LORA_LDB(0, c0 + 128, K0); else LORA_LDB(1, c0 + 128, K0); }
            __builtin_amdgcn_sched_barrier(0x7);
            if (cb) {
#pragma unroll
                for (int nt = 0; nt < 8; ++nt) acc[nt] = __builtin_amdgcn_mfma_f32_16x16x32_bf16(af[K0 + ks], bq[1][nt], acc[nt], 0, 0, 0);
            } else {
#pragma unroll
                for (int nt = 0; nt < 8; ++nt) acc[nt] = __builtin_amdgcn_mfma_f32_16x16x32_bf16(af[K0 + ks], bq[0][nt], acc[nt], 0, 0, 0);
            } }
#pragma unroll
        for (int nt = 0; nt < 8; ++nt)
#pragma unroll
            for (int e = 0; e < 4; ++e) xs[(4 * kg + e) * 132 + nt * 16 + tk] = acc[nt][e];
        LDS_WAIT();
#pragma unroll
        for (int q = 0; q < 4; ++q) { const int it = q * 64 + lane, tq = it >> 4, c8 = (it & 15) * 8, cc = (c0 & 511) + c8; float o[8];
            const f32x4 v0 = *(const LAS f32x4*)(xs + tq * 132 + c8), v1 = *(const LAS f32x4*)(xs + tq * 132 + c8 + 4); const float v[8] = {v0[0], v0[1], v0[2], v0[3], v1[0], v1[1], v1[2], v1[3]};
            if constexpr (WHICH == 2) {
#pragma unroll
                for (int e = 0; e < 8; ++e) o[e] = v[e];
            } else { const float* bias = WHICH == 0 ? a.in[I_W0] : a.in[I_A0]; const f32x4 b0 = *(const f32x4*)(bias + cc), b1 = *(const f32x4*)(bias + cc + 4);
                const float bv[8] = {b0[0], b0[1], b0[2], b0[3], b1[0], b1[1], b1[2], b1[3]};
#pragma unroll
                for (int e = 0; e < 8; ++e) { const float z = bv[e] + v[e];
                    if constexpr (WHICH == 1) o[e] = 1.f / (1.f + __expf(-z));
                    else { const float sp = fmaxf(-z, 0.f) + __logf(1.f + __expf(-fabsf(z))); o[e] = -__expf(-sp - 0.5f); } } }
            *(u32x4*)(LAG + ((unsigned)(m0 + tq) * 1536u + (unsigned)(c0 + c8))) = pack8(o); }
        LDS_WAIT();
    }
}
__device__ __forceinline__ void p2_lora(const Args& a, LAS unsigned char* lds, int wg, int G) {
    const int tid = threadIdx.x, lane = tid & 63, wave = tid >> 6; const int gw = wg * 8 + wave, NGW = G * 8;
    const bf16_t* PR = (const bf16_t*)(a.ws + WS_PR); const float* mu = a.in[I_MU];
    LAS float* xs = (LAS float*)(lds + wave * 8448);
    const int lane_o = lane;
    for (int tile = gw; tile < T / 16; tile += NGW) {
        int lane = lane_o; asm volatile("" : "+v"(lane));
        const int tk = lane & 15, kg = lane >> 4;
        const int m0 = tile * 16, t = m0 + tk; const bool hp = (t & (SEQ - 1)) != 0;
        bf16x8 af[10];
        auto build = [&](const int kk) {
            const int j = 32 * kk + 8 * kg; float p[8], q[8], o[8];
            const unsigned po = (unsigned)t * (unsigned)RW + 1536u + (unsigned)j;
            unpack8(*(const u32x4*)(PR + po), p);
            if (hp) unpack8(*(const u32x4*)(PR + (po - (unsigned)RW)), q); else {
#pragma unroll
                for (int e = 0; e < 8; ++e) q[e] = 0.f; }
            const f32x4 m0v = *(const f32x4*)(mu + 1536 + j), m1v = *(const f32x4*)(mu + 1536 + j + 4); const float mv[8] = {m0v[0], m0v[1], m0v[2], m0v[3], m1v[0], m1v[1], m1v[2], m1v[3]};
#pragma unroll
            for (int e = 0; e < 8; ++e) { const float pm = p[e] + (q[e] - p[e]) * mv[e];
                if (kk < 2) { const float ex = __expf(2.f * pm); o[e] = 1.f - 2.f / (ex + 1.f); }
                else if (kk < 4) o[e] = pm; else o[e] = sigmoidf_(pm); }
            return __builtin_bit_cast(bf16x8, pack8(o)); };
        af[0] = build(0); af[1] = build(1);
        lora_cols<0>(a, af, xs, m0, lane);
        af[2] = build(2); af[3] = build(3);
        lora_cols<1>(a, af, xs, m0, lane);
#pragma unroll
        for (int kk = 4; kk < 9; ++kk) af[kk] = build(kk);
        af[9] = (bf16x8){0, 0, 0, 0, 0, 0, 0, 0};
        lora_cols<2>(a, af, xs, m0, lane);
#undef LORA_LDB
    }
}

namespace cs {
constexpr int AB = 0, RB = 2176, BT = 4352, KT = 6656, BHT = 8960, KHT = 11520, VT = 14080, AAK = 16640, ARBK = 17152, TA = 18176, PC = 18688, MB = 18944, CHB = 19968;
constexpr int LDB = 4 * CHB;
}
__device__ __forceinline__ bf16x8 frag8(const LAS unsigned char* p0, const LAS unsigned char* p1) { const u32x2 a = *(const LAS u32x2*)p0, b = *(const LAS u32x2*)p1; u32x4 w; w.x = a.x; w.y = a.y; w.z = b.x; w.w = b.y; return __builtin_bit_cast(bf16x8, w); }
__device__ __forceinline__ bf16x8 frag4z(const LAS unsigned char* p0) { const u32x2 a = *(const LAS u32x2*)p0; u32x4 w; w.x = a.x; w.y = a.y; w.z = 0u; w.w = 0u; return __builtin_bit_cast(bf16x8, w); }
__device__ __forceinline__ void scan_unit(const Args& a, LAS unsigned char* lds, int b, int hd, const int skip = 0) {
    using namespace cs;
    const int tid = threadIdx.x, w = tid >> 6, lane = tid & 63, x = lane & 15, kg = lane >> 4;
    const int tok = tid >> 3, d8 = (tid & 7) * 8, ch0 = hd * 64 + d8, ci = tok >> 4, tl = tok & 15;
    const bf16_t* PR = (const bf16_t*)(a.ws + WS_PR); const bf16_t* LAG = (const bf16_t*)(a.ws + WS_LAG); bf16_t* ORW = (bf16_t*)(a.ws + WS_ORW);
    f32x4 sT[4];
#pragma unroll
    for (int kt = 0; kt < 4; ++kt) sT[kt] = (f32x4){0.f, 0.f, 0.f, 0.f};
    u32x4 pr_r, pr_k, pr_v, pp_r, pp_k, pp_v, p_ld, p_a, p_g;
    auto prefetch = [&](int ms) {
        const int sq = ms * 64 + tok; const unsigned t = (unsigned)(b * SEQ + sq); const unsigned o1 = t * (unsigned)RW + (unsigned)ch0, o2 = t * 1536u + (unsigned)ch0;
        pr_r = *(const u32x4*)(PR + o1); pr_k = *(const u32x4*)(PR + o1 + 512u); pr_v = *(const u32x4*)(PR + o1 + 1024u);
        if (sq > 0) { pp_r = *(const u32x4*)(PR + (o1 - (unsigned)RW)); pp_k = *(const u32x4*)(PR + (o1 - (unsigned)RW + 512u)); pp_v = *(const u32x4*)(PR + (o1 - (unsigned)RW + 1024u)); }
        else { pp_r = (u32x4){0u, 0u, 0u, 0u}; pp_k = pp_r; pp_v = pp_r; }
        p_ld = *(const u32x4*)(LAG + o2); p_a = *(const u32x4*)(LAG + o2 + 512u); p_g = *(const u32x4*)(LAG + o2 + 1024u);
    };
    prefetch(0);
    LAS float* ldb = (LAS float*)(lds + LDB);
    const int x_o = x, kg_o = kg, tok_o = tok, d8_o = d8;
    for (int ms = 0; ms < SEQ / 64; ++ms) {
        float r[8], k[8], v[8], g[8], kk[8], bb[8], ld[8]; float bonus;
        int x = x_o, kg = kg_o, tok = tok_o, d8 = d8_o; asm volatile("" : "+v"(x), "+v"(kg), "+v"(tok), "+v"(d8));
        const int ci = tok >> 4, tl = tok & 15; int cho = hd * 64 + d8;
        {
            const f32x4* q; f32x4 t0, t1; float pm[8], mu[8], aa[8], kkp[8], kap[8], rkp[8];
#define LD8(dst, ptr) q = (const f32x4*)(ptr); t0 = q[0]; t1 = q[1]; dst[0] = t0[0]; dst[1] = t0[1]; dst[2] = t0[2]; dst[3] = t0[3]; dst[4] = t1[0]; dst[5] = t1[1]; dst[6] = t1[2]; dst[7] = t1[3];
            unpack8(pr_r, r); unpack8(pp_r, pm); LD8(mu, a.in[I_MU] + cho)
#pragma unroll
            for (int e = 0; e < 8; ++e) r[e] = r[e] + (pm[e] - r[e]) * mu[e];
            asm volatile("" ::: "memory");
            unpack8(pr_v, v); unpack8(pp_v, pm); LD8(mu, a.in[I_MU] + 1024 + cho) unpack8(p_g, g); unpack8(p_ld, ld);
#pragma unroll
            for (int e = 0; e < 8; ++e) v[e] = v[e] + (pm[e] - v[e]) * mu[e];
#pragma unroll
            for (int e = 0; e < 8; ++e) ld[e] = __expf(ld[e]);
            *(LAS f32x4*)(ldb + tok * 64 + d8) = (f32x4){ld[0], ld[1], ld[2], ld[3]}; *(LAS f32x4*)(ldb + tok * 64 + d8 + 4) = (f32x4){ld[4], ld[5], ld[6], ld[7]};
            asm volatile("" ::: "memory");
            unpack8(pr_k, k); unpack8(pp_k, pm); LD8(mu, a.in[I_MU] + 512 + cho) LD8(kkp, a.in[I_KK] + cho) LD8(kap, a.in[I_KA] + cho) LD8(rkp, a.in[I_RK] + cho) unpack8(p_a, aa);
            float ssq = 0.f, bsum = 0.f;
#pragma unroll
            for (int e = 0; e < 8; ++e) { k[e] = k[e] + (pm[e] - k[e]) * mu[e];
                kk[e] = k[e] * kkp[e]; ssq += kk[e] * kk[e]; k[e] = k[e] * (1.f + (aa[e] - 1.f) * kap[e]); bsum += r[e] * k[e] * rkp[e]; }
            ssq = red8(ssq); bonus = red8(bsum);
            const float inv = 1.f / fmaxf(sqrtf(ssq), 1e-12f);
#pragma unroll
            for (int e = 0; e < 8; ++e) { kk[e] *= inv; bb[e] = kk[e] * aa[e]; }
        }
        if (ms + 1 < SEQ / 64) prefetch(ms + 1);
        __syncthreads();
        if (tid < 256 && !(skip & 2)) {
            const int c2 = tid >> 6, kch = tid & 63; LAS float* q = ldb + (c2 * 16) * 64 + kch; float run = 1.f, wv[16];
#pragma unroll
            for (int t = 0; t < 16; ++t) wv[t] = q[t * 64];
#pragma unroll
            for (int t = 0; t < 16; ++t) { run *= wv[t]; q[t * 64] = run; }
            *(LAS float*)(lds + c2 * CHB + PC + kch * 4) = run;
        }
        __syncthreads();
        if (!(skip & 4)) {
            LAS unsigned char* cb = lds + ci * CHB;
            const f32x4 l0 = *(const LAS f32x4*)(ldb + tok * 64 + d8), l1 = *(const LAS f32x4*)(ldb + tok * 64 + d8 + 4);
            const f32x4 e0 = *(const LAS f32x4*)(ldb + (ci * 16 + 15) * 64 + d8), e1 = *(const LAS f32x4*)(ldb + (ci * 16 + 15) * 64 + d8 + 4);
            f32x4 m0 = (f32x4){1.f, 1.f, 1.f, 1.f}, m1 = m0;
            if (tl > 0) { m0 = *(const LAS f32x4*)(ldb + (tok - 1) * 64 + d8); m1 = *(const LAS f32x4*)(ldb + (tok - 1) * 64 + d8 + 4); }
            const float Lt[8] = {l0[0], l0[1], l0[2], l0[3], l1[0], l1[1], l1[2], l1[3]}, Le[8] = {e0[0], e0[1], e0[2], e0[3], e1[0], e1[1], e1[2], e1[3]}, Lm[8] = {m0[0], m0[1], m0[2], m0[3], m1[0], m1[1], m1[2], m1[3]};
            float ab[8], rb[8], bt[8], kt[8], bh[8], kh[8];
#pragma unroll
            for (int e = 0; e < 8; ++e) { const float pm = Lm[e], pt = Lt[e], ip = __builtin_amdgcn_rcpf(Lt[e]), pe = Le[e] * ip;
                ab[e] = -kk[e] * pm; rb[e] = r[e] * pt; bt[e] = bb[e] * ip; kt[e] = k[e] * ip; bh[e] = bb[e] * pe; kh[e] = k[e] * pe; }
            const u32x4 wab = pack8(ab), wrb = pack8(rb);
            *(LAS u32x2*)(cb + AB + tl * 136 + d8 * 2) = (u32x2){wab.x, wab.y}; *(LAS u32x2*)(cb + AB + tl * 136 + d8 * 2 + 8) = (u32x2){wab.z, wab.w};
            *(LAS u32x2*)(cb + RB + tl * 136 + d8 * 2) = (u32x2){wrb.x, wrb.y}; *(LAS u32x2*)(cb + RB + tl * 136 + d8 * 2 + 8) = (u32x2){wrb.z, wrb.w};
            *(LAS u32x4*)(cb + BT + tl * 144 + d8 * 2) = pack8(bt); *(LAS u32x4*)(cb + KT + tl * 144 + d8 * 2) = pack8(kt);
            const u32x4 wbh = pack8(bh), wkh = pack8(kh), wv = pack8(v);
            const unsigned hb[4] = {wbh.x, wbh.y, wbh.z, wbh.w}, hk[4] = {wkh.x, wkh.y, wkh.z, wkh.w}, hv[4] = {wv.x, wv.y, wv.z, wv.w};
#pragma unroll
            for (int e = 0; e < 8; ++e) { const int sh = (e & 1) * 16; const int ro = (d8 + e) * 40 + tl * 2;
                *(LAS bf16_t*)(cb + BHT + ro) = (bf16_t)(hb[e >> 1] >> sh); *(LAS bf16_t*)(cb + KHT + ro) = (bf16_t)(hk[e >> 1] >> sh); *(LAS bf16_t*)(cb + VT + ro) = (bf16_t)(hv[e >> 1] >> sh); }
        }
        __syncthreads();
        if (!(skip & 8)) {
            LAS unsigned char* cb = lds + (w & 3) * CHB;
            const LAS unsigned char* pa = cb + AB + x * 136 + kg * 16; const LAS unsigned char* prb = cb + RB + x * 136 + kg * 16;
            const LAS unsigned char* pb = cb + BT + x * 144 + kg * 16; const LAS unsigned char* pk = cb + KT + x * 144 + kg * 16;
            const f32x4 z4 = (f32x4){0.f, 0.f, 0.f, 0.f};
            if (w < 4) {
                const bf16x8 a0 = frag8(pa, pa + 8), a1 = frag8(pa + 64, pa + 72), b0 = frag8(pb, pb + 8), b1 = frag8(pb + 64, pb + 72), k0 = frag8(pk, pk + 8), k1 = frag8(pk + 64, pk + 72);
                f32x4 mab = __builtin_amdgcn_mfma_f32_16x16x32_bf16(a0, b0, z4, 0, 0, 0); mab = __builtin_amdgcn_mfma_f32_16x16x32_bf16(a1, b1, mab, 0, 0, 0);
                f32x4 akt = __builtin_amdgcn_mfma_f32_16x16x32_bf16(k0, a0, z4, 0, 0, 0); akt = __builtin_amdgcn_mfma_f32_16x16x32_bf16(k1, a1, akt, 0, 0, 0);
                float ak[4];
#pragma unroll
                for (int e = 0; e < 4; ++e) { const int t = 4 * kg + e; *(LAS float*)(cb + MB + (t * 16 + x) * 4) = (x < t) ? mab[e] : 0.f; ak[e] = (4 * kg + e < x) ? akt[e] : 0.f; }
                *(LAS u32x2*)(cb + AAK + (x * 4 + kg) * 8) = (u32x2){cvt_pk_bf16(ak[0], ak[1]), cvt_pk_bf16(ak[2], ak[3])};
            } else {
                const bf16x8 r0 = frag8(prb, prb + 8), r1 = frag8(prb + 64, prb + 72), b0 = frag8(pb, pb + 8), b1 = frag8(pb + 64, pb + 72), k0 = frag8(pk, pk + 8), k1 = frag8(pk + 64, pk + 72);
                f32x4 rbt = __builtin_amdgcn_mfma_f32_16x16x32_bf16(b0, r0, z4, 0, 0, 0); rbt = __builtin_amdgcn_mfma_f32_16x16x32_bf16(b1, r1, rbt, 0, 0, 0);
                f32x4 rkt = __builtin_amdgcn_mfma_f32_16x16x32_bf16(k0, r0, z4, 0, 0, 0); rkt = __builtin_amdgcn_mfma_f32_16x16x32_bf16(k1, r1, rkt, 0, 0, 0);
                float ab4[4], ak4[4];
#pragma unroll
                for (int e = 0; e < 4; ++e) { const bool ok = (4 * kg + e <= x); ab4[e] = ok ? rbt[e] : 0.f; ak4[e] = ok ? rkt[e] : 0.f; }
                *(LAS u32x4*)(cb + ARBK + (x * 4 + kg) * 16) = (u32x4){cvt_pk_bf16(ab4[0], ab4[1]), cvt_pk_bf16(ab4[2], ab4[3]), cvt_pk_bf16(ak4[0], ak4[1]), cvt_pk_bf16(ak4[2], ak4[3])};
            }
        }
        __syncthreads();
        if (w == 0 && !(skip & 16)) {
            LAS unsigned char* cb = lds + kg * CHB; const LAS float* M = (const LAS float*)(cb + MB); float Tr[16];
#pragma unroll
            for (int i = 0; i < 16; ++i) Tr[i] = (i == x) ? 1.f : 0.f;
#pragma unroll
            for (int i = 15; i >= 1; --i) {
                const f32x4 r0 = *(const LAS f32x4*)(M + i * 16), r1 = *(const LAS f32x4*)(M + i * 16 + 4), r2 = *(const LAS f32x4*)(M + i * 16 + 8), r3 = *(const LAS f32x4*)(M + i * 16 + 12);
                const float mr[16] = {r0[0], r0[1], r0[2], r0[3], r1[0], r1[1], r1[2], r1[3], r2[0], r2[1], r2[2], r2[3], r3[0], r3[1], r3[2], r3[3]};
#pragma unroll
                for (int j = 0; j < i; ++j) Tr[j] += Tr[i] * mr[j];
            }
#pragma unroll
            for (int q = 0; q < 4; ++q) *(LAS u32x2*)(cb + TA + (x * 4 + q) * 8) = (u32x2){cvt_pk_bf16(Tr[4 * q], Tr[4 * q + 1]), cvt_pk_bf16(Tr[4 * q + 2], Tr[4 * q + 3])};
        }
        __syncthreads();
        if (w < 4 && !(skip & 32)) {
            for (int c = 0; c < 4; ++c) {
                const LAS unsigned char* cb = lds + c * CHB;
                const LAS unsigned char* pa = cb + AB + x * 136 + kg * 8; const LAS unsigned char* prb = cb + RB + x * 136 + kg * 8;
                const bf16x8 af0 = frag8(pa, pa + 32), af1 = frag8(pa + 64, pa + 96), rf0 = frag8(prb, prb + 32), rf1 = frag8(prb + 64, prb + 96);
                const u32x2 vt2 = *(const LAS u32x2*)(cb + VT + (16 * w + x) * 40 + kg * 8);
                const bf16x8 aakf = frag4z(cb + AAK + (x * 4 + kg) * 8), taf = frag4z(cb + TA + (x * 4 + kg) * 8), arbkf = *(const LAS bf16x8*)(cb + ARBK + (x * 4 + kg) * 16);
                bf16x8 bkf[4]; f32x4 pcv[4];
#pragma unroll
                for (int kt = 0; kt < 4; ++kt) { bkf[kt] = frag8(cb + BHT + (16 * kt + x) * 40 + kg * 8, cb + KHT + (16 * kt + x) * 40 + kg * 8); pcv[kt] = *(const LAS f32x4*)(cb + PC + (16 * kt + 4 * kg) * 4); }
                __builtin_amdgcn_sched_barrier(0x7);
                bf16x8 hi[2], lo[2];
#pragma unroll
                for (int u = 0; u < 2; ++u) { const float sv[8] = {sT[2 * u][0], sT[2 * u][1], sT[2 * u][2], sT[2 * u][3], sT[2 * u + 1][0], sT[2 * u + 1][1], sT[2 * u + 1][2], sT[2 * u + 1][3]};
                    const u32x4 hw = pack8(sv); float hf[8], lf[8]; unpack8(hw, hf);
#pragma unroll
                    for (int e = 0; e < 8; ++e) lf[e] = sv[e] - hf[e];
                    hi[u] = __builtin_bit_cast(bf16x8, hw); lo[u] = __builtin_bit_cast(bf16x8, pack8(lf)); }
                f32x4 acc = (f32x4){0.f, 0.f, 0.f, 0.f};
                acc = __builtin_amdgcn_mfma_f32_16x16x32_bf16(af0, hi[0], acc, 0, 0, 0); acc = __builtin_amdgcn_mfma_f32_16x16x32_bf16(af0, lo[0], acc, 0, 0, 0);
                acc = __builtin_amdgcn_mfma_f32_16x16x32_bf16(af1, hi[1], acc, 0, 0, 0); acc = __builtin_amdgcn_mfma_f32_16x16x32_bf16(af1, lo[1], acc, 0, 0, 0);
                { u32x4 vw; vw.x = vt2.x; vw.y = vt2.y; vw.z = 0u; vw.w = 0u;
                  acc = __builtin_amdgcn_mfma_f32_16x16x32_bf16(aakf, __builtin_bit_cast(bf16x8, vw), acc, 0, 0, 0); }
                u32x4 rw; rw.x = cvt_pk_bf16(acc[0], acc[1]); rw.y = cvt_pk_bf16(acc[2], acc[3]); rw.z = 0u; rw.w = 0u;
                const f32x4 U = __builtin_amdgcn_mfma_f32_16x16x32_bf16(taf, __builtin_bit_cast(bf16x8, rw), (f32x4){0.f, 0.f, 0.f, 0.f}, 0, 0, 0);
                u32x4 uvw; uvw.x = cvt_pk_bf16(U[0], U[1]); uvw.y = cvt_pk_bf16(U[2], U[3]); uvw.z = vt2.x; uvw.w = vt2.y;
                const bf16x8 UV = __builtin_bit_cast(bf16x8, uvw);
                f32x4 oacc = (f32x4){0.f, 0.f, 0.f, 0.f};
                oacc = __builtin_amdgcn_mfma_f32_16x16x32_bf16(rf0, hi[0], oacc, 0, 0, 0); oacc = __builtin_amdgcn_mfma_f32_16x16x32_bf16(rf0, lo[0], oacc, 0, 0, 0);
                oacc = __builtin_amdgcn_mfma_f32_16x16x32_bf16(rf1, hi[1], oacc, 0, 0, 0); oacc = __builtin_amdgcn_mfma_f32_16x16x32_bf16(rf1, lo[1], oacc, 0, 0, 0);
                oacc = __builtin_amdgcn_mfma_f32_16x16x32_bf16(arbkf, UV, oacc, 0, 0, 0);
#pragma unroll
                for (int e = 0; e < 4; ++e) ldb[(c * 16 + 4 * kg + e) * 64 + 16 * w + x] = oacc[e];
#pragma unroll
                for (int kt = 0; kt < 4; ++kt) { const f32x4 pc4 = pcv[kt];
                    const f32x4 cin = (f32x4){sT[kt][0] * pc4[0], sT[kt][1] * pc4[1], sT[kt][2] * pc4[2], sT[kt][3] * pc4[3]};
                    sT[kt] = __builtin_amdgcn_mfma_f32_16x16x32_bf16(bkf[kt], UV, cin, 0, 0, 0); }
            }
        }
        __syncthreads();
        {
            const f32x4 o0 = *(const LAS f32x4*)(ldb + tok * 64 + d8), o1 = *(const LAS f32x4*)(ldb + tok * 64 + d8 + 4);
            const float o[8] = {o0[0], o0[1], o0[2], o0[3], o1[0], o1[1], o1[2], o1[3]};
            float sm = 0.f;
#pragma unroll
            for (int e = 0; e < 8; ++e) sm += o[e];
            const float mean = red8(sm) * (1.f / 64.f); float dv[8], q = 0.f;
#pragma unroll
            for (int e = 0; e < 8; ++e) { dv[e] = o[e] - mean; q += dv[e] * dv[e]; }
            const float rs = rsqrtf(red8(q) * (1.f / 64.f) + 64e-5f); float y[8], lnw[8], lnb[8];
            { const f32x4* q; f32x4 t0, t1; LD8(lnw, a.in[I_LNW] + cho) LD8(lnb, a.in[I_LNB] + cho) }
#undef LD8
#pragma unroll
            for (int e = 0; e < 8; ++e) y[e] = (dv[e] * rs * lnw[e] + lnb[e] + bonus * v[e]) * g[e];
            const unsigned t = (unsigned)(b * SEQ + ms * 64 + tok);
            if (skip) *(u32x4*)((bf16_t*)(a.ws + WS_END) + ((t * (unsigned)CR + (unsigned)ch0) & 0x3fffffu)) = pack8(y); else *(u32x4*)(ORW + (t * (unsigned)CR + (unsigned)ch0)) = pack8(y);
        }
        __syncthreads();
    }
}

__device__ __forceinline__ int t5_bucket(int dist) {
    if (dist < 16) return dist;
    const float d = (float)dist; int large = 16 + (int)(logf(d / 16.f) / 4.852030263919617f * 16.f); return large < 31 ? large : 31;
}
struct AttnDesc { int g, dil, b, r, hd, n; };
__device__ __forceinline__ AttnDesc attn_decode(int unit) {
    AttnDesc d; d.g = unit >> 10; const int rem = unit & 1023; d.b = rem >> 6;
    if (d.g == 0) { d.dil = 1; d.r = 0; d.hd = (rem >> 4) & 3; d.n = rem & 15; }
    else if (d.g == 1) { d.dil = 4; d.r = (rem >> 4) & 3; d.hd = (rem >> 2) & 3; d.n = rem & 3; }
    else { d.dil = 16; d.r = (rem >> 2) & 15; d.hd = rem & 3; d.n = 0; }
    return d;
}
__device__ __forceinline__ void attn_load(const Args& a, const AttnDesc& d, u32x4 (&kq)[4], u32x4 (&vq)[4]) {
    const int tid = threadIdx.x, kgp = tid >> 3, dgp = tid & 7, colq = (4 * d.g + d.hd) * 64 + 8 * dgp;
    const bf16_t* Kb = (const bf16_t*)(a.ws + WS_QKV) + (size_t)T * AW; const bf16_t* Vb = Kb + (size_t)T * AW;
#pragma unroll
    for (int j = 0; j < 4; ++j) { const int lk = 128 * (d.n - 1) + 4 * kgp + j;
        if (lk >= 0) { const unsigned off = (unsigned)(d.b * SEQ + lk * d.dil + d.r) * (unsigned)AW + (unsigned)colq; kq[j] = *(const u32x4*)(Kb + off); vq[j] = *(const u32x4*)(Vb + off); }
        else { kq[j] = (u32x4){0u, 0u, 0u, 0u}; vq[j] = kq[j]; } }
}
__device__ __forceinline__ void attn_stage(const Args& a, const AttnDesc& d, const u32x4 (&kq)[4], const u32x4 (&vq)[4], LAS unsigned char* lds) {
    LAS bf16_t* Ks = (LAS bf16_t*)lds; LAS bf16_t* VT = (LAS bf16_t*)(lds + 36864); LAS float* bias = (LAS float*)(lds + 36864 + 33792);
    const int tid = threadIdx.x, kgp = tid >> 3, dgp = tid & 7;
    const float* kgn = a.in[I_KNG] + d.g * 64 + 8 * dgp; const f32x4 g0 = *(const f32x4*)kgn, g1 = *(const f32x4*)(kgn + 4);
    const float kg8[8] = {g0[0], g0[1], g0[2], g0[3], g1[0], g1[1], g1[2], g1[3]};
#pragma unroll
    for (int j = 0; j < 4; ++j) { float kv[8]; unpack8(kq[j], kv); float ssq = 0.f;
#pragma unroll
        for (int e = 0; e < 8; ++e) ssq += kv[e] * kv[e];
        const float rstd = rsqrtf(red8(ssq) * (1.f / 64.f) + 1e-6f);
#pragma unroll
        for (int e = 0; e < 8; ++e) kv[e] *= rstd * kg8[e];
        *(LAS u32x4*)(Ks + (4 * kgp + j) * 72 + 8 * dgp) = pack8(kv); }
#pragma unroll
    for (int e = 0; e < 8; ++e) { const int sh = (e & 1) * 16, q = e >> 1;
        const unsigned v0 = (vq[0][q] >> sh) & 0xffffu, v1 = (vq[1][q] >> sh) & 0xffffu, v2 = (vq[2][q] >> sh) & 0xffffu, v3 = (vq[3][q] >> sh) & 0xffffu;
        *(LAS u32x2*)(VT + (8 * dgp + e) * 264 + 4 * kgp) = (u32x2){v0 | (v1 << 16), v2 | (v3 << 16)}; }
    if (tid < 129) bias[tid] = a.in[I_RELB][t5_bucket(tid * d.dil) * 12 + 4 * d.g + d.hd];
}
__device__ __forceinline__ void attn_compute(const Args& a, const AttnDesc& d, LAS unsigned char* lds) {
    const int g = d.g, dil = d.dil, b = d.b, r = d.r, hd = d.hd, n = d.n;
    const int head = 4 * g + hd, colq = head * 64;
    const bf16_t* Q = (const bf16_t*)(a.ws + WS_QKV);
    LAS bf16_t* Ks = (LAS bf16_t*)lds;
    LAS bf16_t* VT = (LAS bf16_t*)(lds + 36864);
    LAS float* bias = (LAS float*)(lds + 36864 + 33792);
    const int tid = threadIdx.x, lane = tid & 63, w = tid >> 6;
    const int iq = lane & 15, rg = lane >> 4, qi = 16 * w + iq;
    const size_t tq = (size_t)b * SEQ + (size_t)(128 * n + qi) * dil + r;
    bf16x8 qf[2];
    {
        float q0[8], q1[8]; unpack8(*(const u32x4*)(Q + tq * AW + colq + 8 * rg), q0); unpack8(*(const u32x4*)(Q + tq * AW + colq + 32 + 8 * rg), q1);
        float ssq = 0.f;
#pragma unroll
        for (int e = 0; e < 8; ++e) ssq += q0[e] * q0[e] + q1[e] * q1[e];
        ssq += __shfl_xor(ssq, 16); ssq += __shfl_xor(ssq, 32);
        const float rstd = rsqrtf(ssq * (1.f / 64.f) + 1e-6f) * 0.125f; const float* qg = a.in[I_QNG] + g * 64;
#pragma unroll
        for (int e = 0; e < 8; ++e) { q0[e] *= rstd * qg[8 * rg + e]; q1[e] *= rstd * qg[32 + 8 * rg + e]; }
        qf[0] = __builtin_bit_cast(bf16x8, pack8(q0)); qf[1] = __builtin_bit_cast(bf16x8, pack8(q1));
    }
    const int u0 = w >> 1;
    f32x4 s[10];
#pragma unroll
    for (int j = 0; j < 10; ++j) { const int kt = 2 * u0 + j;
        const bf16x8 k0 = *(const LAS bf16x8*)(Ks + (16 * kt + iq) * 72 + 8 * rg), k1 = *(const LAS bf16x8*)(Ks + (16 * kt + iq) * 72 + 32 + 8 * rg);
        f32x4 z = (f32x4){0.f, 0.f, 0.f, 0.f};
        z = __builtin_amdgcn_mfma_f32_16x16x32_bf16(k0, qf[0], z, 0, 0, 0); s[j] = __builtin_amdgcn_mfma_f32_16x16x32_bf16(k1, qf[1], z, 0, 0, 0); }
    float mx = -1e30f;
#pragma unroll
    for (int j = 0; j < 10; ++j)
#pragma unroll
        for (int e = 0; e < 4; ++e) { const int kj = 16 * (2 * u0 + j) + 4 * rg + e, rel = qi + 128 - kj; const bool ok = (rel >= 0) && (rel <= 128) && (n > 0 || kj >= 128);
            const int rc = rel < 0 ? 0 : (rel > 128 ? 128 : rel); const float sc = ok ? s[j][e] + bias[rc] : -1e30f; s[j][e] = sc; mx = fmaxf(mx, sc); }
    mx = fmaxf(mx, __shfl_xor(mx, 16)); mx = fmaxf(mx, __shfl_xor(mx, 32));
    float l = 0.f;
#pragma unroll
    for (int j = 0; j < 10; ++j)
#pragma unroll
        for (int e = 0; e < 4; ++e) { const float p = __expf(s[j][e] - mx); s[j][e] = p; l += p; }
    l += __shfl_xor(l, 16); l += __shfl_xor(l, 32);
    f32x4 oacc[4];
#pragma unroll
    for (int dt = 0; dt < 4; ++dt) oacc[dt] = (f32x4){0.f, 0.f, 0.f, 0.f};
#pragma unroll
    for (int ub = 0; ub < 5; ++ub) {
        u32x4 pw; pw.x = cvt_pk_bf16(s[2 * ub][0], s[2 * ub][1]); pw.y = cvt_pk_bf16(s[2 * ub][2], s[2 * ub][3]); pw.z = cvt_pk_bf16(s[2 * ub + 1][0], s[2 * ub + 1][1]); pw.w = cvt_pk_bf16(s[2 * ub + 1][2], s[2 * ub + 1][3]);
        const bf16x8 pf = __builtin_bit_cast(bf16x8, pw); const int kb = 32 * (u0 + ub) + 4 * rg;
#pragma unroll
        for (int dt = 0; dt < 4; ++dt) { const LAS bf16_t* vp = VT + (16 * dt + iq) * 264 + kb; const u32x2 lo = *(const LAS u32x2*)vp, hi = *(const LAS u32x2*)(vp + 16);
            u32x4 vw; vw.x = lo.x; vw.y = lo.y; vw.z = hi.x; vw.w = hi.y;
            oacc[dt] = __builtin_amdgcn_mfma_f32_16x16x32_bf16(__builtin_bit_cast(bf16x8, vw), pf, oacc[dt], 0, 0, 0); }
    }
    const float il = 1.f / l;
    bf16_t* OG = (bf16_t*)(a.ws + WS_OG) + (size_t)g * T * 256; float* LSE = (float*)(a.ws + WS_LSE) + (size_t)g * T * 4;
#pragma unroll
    for (int dt = 0; dt < 4; ++dt) { u32x2 o; o.x = cvt_pk_bf16(oacc[dt][0] * il, oacc[dt][1] * il); o.y = cvt_pk_bf16(oacc[dt][2] * il, oacc[dt][3] * il);
        *(u32x2*)(OG + tq * 256 + hd * 64 + 16 * dt + 4 * rg) = o; }
    if (rg == 0) LSE[tq * 4 + hd] = mx + logf(l);
}

__device__ __forceinline__ void p5_combine(const Args& a, int wg, int G) {
    const bf16_t* OG = (const bf16_t*)(a.ws + WS_OG); const float* LSE = (const float*)(a.ws + WS_LSE); bf16_t* ATT = (bf16_t*)(a.ws + WS_ATT);
    for (int it = wg * 512 + threadIdx.x; it < T * 32; it += G * 512) {
        const int t = it >> 5, hs = (it >> 3) & 3, d8 = (it & 7) * 8;
        const float l0 = LSE[(size_t)t * 4 + hs], l1 = LSE[(size_t)T * 4 + (size_t)t * 4 + hs], l2 = LSE[(size_t)2 * T * 4 + (size_t)t * 4 + hs];
        const float m = fmaxf(l0, fmaxf(l1, l2)); float w0 = __expf(l0 - m), w1 = __expf(l1 - m), w2 = __expf(l2 - m); const float iz = 1.f / (w0 + w1 + w2); w0 *= iz; w1 *= iz; w2 *= iz;
        float o0[8], o1[8], o2[8], o[8]; const size_t off = (size_t)t * 256 + hs * 64 + d8;
        unpack8(*(const u32x4*)(OG + off), o0); unpack8(*(const u32x4*)(OG + (size_t)T * 256 + off), o1); unpack8(*(const u32x4*)(OG + (size_t)2 * T * 256 + off), o2);
#pragma unroll
        for (int e = 0; e < 8; ++e) o[e] = w0 * o0[e] + w1 * o1[e] + w2 * o2[e];
        *(u32x4*)(ATT + off) = pack8(o);
    }
}

__device__ __forceinline__ void p8_router(const Args& a, LAS unsigned char* lds, int wg, int G, int dry) {
    const int tid = threadIdx.x, lane = tid & 63, wave = tid >> 6; const int gw = wg * 8 + wave, NGW = G * 8;
    unsigned char* ws = a.ws;
    {
        LAS float* scr = (LAS float*)(lds + wave * 16384);
        constexpr int I_GU = 32 * 32 * 16, I_DN = 32 * 32 * 8;
        for (int it = gw; it < I_GU + I_DN; it += NGW) {
            if (it < I_GU) { const int e = it >> 9, r = it & 511, nb = r >> 4, kb = r & 15, n0 = nb * 32, pn = n0 >> 8, j = n0 & 255;
                const float* src = (j < 128 ? a.in[I_WEG] : a.in[I_WEU]) + (size_t)e * D * DE;
                tr_item((bf16_t*)(ws + WS_WGU) + (size_t)e * 1024 * 1024, D, n0, kb * 64, src, DE, kb * 64, 128 * pn + (j & 127), 64, scr, lane); }
            else { const int r0 = it - I_GU, e = r0 >> 8, r = r0 & 255, nb = r >> 3, kb = r & 7;
                tr_item((bf16_t*)(ws + WS_WD) + (size_t)e * 1024 * 512, DE, nb * 32, kb * 64, a.in[I_WED] + (size_t)e * DE * D, D, kb * 64, nb * 32, 64, scr, lane); }
        }
    }
    const float* x2 = a.out; const float* gn = a.in[I_N2G]; bf16_t* H2 = (bf16_t*)(ws + WS_H);
    const float* bg = a.in[I_BGR]; const float* be = a.in[I_BER];
    unsigned* cnt = (unsigned*)(ws + WS_CTL) + CW_CNT; int* lists = (int*)(ws + WS_LIST); float* tokg = (float*)(ws + WS_TOKG);
    const bf16_t* Whi = (const bf16_t*)(ws + WS_WR); const bf16_t* Wlo = Whi + 48 * D;
    LAS float* lgt = (LAS float*)(lds + wave * 16384);
    const int tk = lane & 15, kg = lane >> 4;
    for (int tile = gw; tile < T / 16; tile += NGW) {
        const int m0 = tile * 16; const float* xr = x2 + (size_t)(m0 + tk) * D + 8 * kg;
        f32x4 acc[3]; acc[0] = (f32x4){0.f, 0.f, 0.f, 0.f}; acc[1] = acc[0]; acc[2] = acc[0]; float ssq = 0.f;
        bf16_t* hr = H2 + (size_t)(m0 + tk) * D + 8 * kg;
#pragma unroll 4
        for (int kk = 0; kk < 32; ++kk) {
            const f32x4 x0 = *(const f32x4*)(xr + 32 * kk), x1 = *(const f32x4*)(xr + 32 * kk + 4);
            const f32x4 g0 = *(const f32x4*)(gn + 32 * kk + 8 * kg), g1 = *(const f32x4*)(gn + 32 * kk + 8 * kg + 4);
            const float xv[8] = {x0[0], x0[1], x0[2], x0[3], x1[0], x1[1], x1[2], x1[3]}; float hv[8], lv[8];
            { const float hg[8] = {x0[0] * g0[0], x0[1] * g0[1], x0[2] * g0[2], x0[3] * g0[3], x1[0] * g1[0], x1[1] * g1[1], x1[2] * g1[2], x1[3] * g1[3]}; *(u32x4*)(hr + 32 * kk) = pack8(hg); }
#pragma unroll
            for (int e = 0; e < 8; ++e) ssq += xv[e] * xv[e];
            const u32x4 hw = pack8(xv); unpack8(hw, hv);
#pragma unroll
            for (int e = 0; e < 8; ++e) lv[e] = xv[e] - hv[e];
            const bf16x8 ahi = __builtin_bit_cast(bf16x8, hw), alo = __builtin_bit_cast(bf16x8, pack8(lv));
#pragma unroll
            for (int nt = 0; nt < 3; ++nt) { const size_t wo = (size_t)(16 * nt + tk) * D + 32 * kk + 8 * kg;
                const bf16x8 bh = *(const bf16x8*)(Whi + wo), bl = *(const bf16x8*)(Wlo + wo);
                acc[nt] = __builtin_amdgcn_mfma_f32_16x16x32_bf16(ahi, bh, acc[nt], 0, 0, 0);
                acc[nt] = __builtin_amdgcn_mfma_f32_16x16x32_bf16(alo, bh, acc[nt], 0, 0, 0);
                acc[nt] = __builtin_amdgcn_mfma_f32_16x16x32_bf16(ahi, bl, acc[nt], 0, 0, 0); }
        }
        ssq += __shfl_xor(ssq, 16); ssq += __shfl_xor(ssq, 32);
        const float rstd = rsqrtf(ssq * (1.f / D) + 1e-6f);
#pragma unroll
        for (int nt = 0; nt < 3; ++nt)
#pragma unroll
            for (int e = 0; e < 4; ++e) lgt[(4 * kg + e) * 49 + 16 * nt + tk] = acc[nt][e];
        LDS_WAIT();
        if (lane < 16) {
            const LAS float* L = lgt + lane * 49; float lg[4], le[32];
#pragma unroll
            for (int e = 0; e < 4; ++e) lg[e] = L[e] * rstd + bg[e];
#pragma unroll
            for (int e = 0; e < 32; ++e) le[e] = L[4 + e] * rstd + be[e];
            int grp = 0; float gm = lg[0];
#pragma unroll
            for (int e = 1; e < 4; ++e) if (lg[e] > gm) { gm = lg[e]; grp = e; }
            float gz = 0.f;
#pragma unroll
            for (int e = 0; e < 4; ++e) gz += __expf(lg[e] - gm);
            const float grp_p = 1.f / gz;
            float sel[8];
#pragma unroll
            for (int e = 0; e < 8; ++e) sel[e] = grp == 0 ? le[e] : (grp == 1 ? le[8 + e] : (grp == 2 ? le[16 + e] : le[24 + e]));
            int i1 = 0; float m1 = sel[0];
#pragma unroll
            for (int e = 1; e < 8; ++e) if (sel[e] > m1) { m1 = sel[e]; i1 = e; }
            int i2 = 0; float m2 = -3.0e38f;
#pragma unroll
            for (int e = 0; e < 8; ++e) if (e != i1 && sel[e] > m2) { m2 = sel[e]; i2 = e; }
            const float e2 = __expf(m2 - m1), gate1 = grp_p / (1.f + e2), gate2 = grp_p * e2 / (1.f + e2);
            const int m = m0 + lane;
            if (!dry) { const int l1 = grp * 8 + i1, l2 = 32 + grp * 8 + i2;
                const unsigned p1 = atomicAdd(cnt + l1, 1u), p2 = atomicAdd(cnt + l2, 1u);
                lists[(size_t)l1 * T + p1] = m; lists[(size_t)l2 * T + p2] = m; }
            tokg[(size_t)m * 2] = gate1; tokg[(size_t)m * 2 + 1] = gate2; tokg[(size_t)2 * T + m] = rstd;
        }
        LDS_WAIT();
    }
}

__global__ void __launch_bounds__(512, 2) hybrid_fwd(Args args) {
    extern __shared__ __attribute__((aligned(16))) unsigned char lds_raw[];
    LAS unsigned char* lds = (LAS unsigned char*)lds_raw;
    const int tid = threadIdx.x, wg = blockIdx.x, G = gridDim.x;
    unsigned char* ws = args.ws;
    volatile LAS unsigned* MISC = (volatile LAS unsigned*)(lds + LDS_MISC);
    if (tid < 16) MISC[tid] = 0u;
    __syncthreads();
    XcdBarrier bar; bar.bar = (unsigned*)(ws + WS_CTL) + CW_BAR; bar.x = 0; bar.st = nullptr;
    if (MK_N_LAUNCHES == 1) bar = xcd_barrier_post((unsigned*)(ws + WS_CTL) + CW_BAR, MISC);
    const int lo = args.ph_lo, hi = args.ph_hi;
#ifndef PHASE_MASK
#define PHASE_MASK 0xFFF
#endif
#define IN(k) (((PHASE_MASK >> (k)) & 1) && lo <= (k) && (k) < hi)
#define SEAM(k) do { if (IN(k) && IN((k) + 1)) xcd_barrier(bar); } while (0)
#define NAIVE(k) ((NAIVE_GEMM_MASK >> (k)) & 1)

#ifndef REPEAT_MASK
#define REPEAT_MASK 0
#endif
#define REPS(k) _Pragma("unroll 1") for (int rep = 0; rep < 1 + ((REPEAT_MASK >> (k)) & 1); ++rep)
#define REPBAR() do { if (rep) xcd_barrier(bar); } while (0)
    if (IN(0)) REPS(0) { REPBAR(); p0_prologue(args, lds, wg, G); }
    SEAM(0);
    if (IN(1)) REPS(1) {
        REPBAR();
        pg8::StaticOrder S; S.init(ws + WS_H, ws + WS_WIN, T, NIN, D, G, wg);
        FIn f{(bf16_t*)(ws + WS_QKV), (bf16_t*)(ws + WS_PR), (bf16_t*)args.out};
        if (NAIVE(1)) pg8::gemm_naive<false>(D, S, f); else { pg8::EpiRow8<FIn> E{f}; pg8::gemm_phase(lds, D, S, E); }
        p0b_extra_cols(args, wg, G);
    }
    SEAM(1);
    if (IN(2)) REPS(2) { REPBAR(); p2_lora(args, lds, wg, G); }
    SEAM(3);
    if (IN(4)) REPS(4) {
        REPBAR();
        const int nscan = G / 2;
#ifdef PROBE_SKIP_SCAN_REP
        if (wg < nscan && !rep)
#else
        if (wg < nscan)
#endif
            {
#ifndef SCAN_REPS
#define SCAN_REPS 1
#endif
#ifndef ATTN_REPS
#define ATTN_REPS 1
#endif
#ifndef SCAN_SKIP
#define SCAN_SKIP 0
#endif
              _Pragma("unroll 1") for (int rr = 0; rr < SCAN_REPS; ++rr)
                for (int u = wg; u < BATCH * 8; u += nscan) scan_unit(args, lds, u >> 3, u & 7, rr ? (SCAN_SKIP | 1) : 0); }
#ifdef PROBE_SKIP_ATTN_REP
        if (!rep)
#endif
        {
            unsigned* qhead = (unsigned*)(ws + WS_CTL) + CW_QH + 64 * rep; volatile LAS int* slot = (volatile LAS int*)(lds + LDS_MISC + 32);
            __syncthreads();
            if (tid == 0) slot[0] = (int)atomicAdd(qhead, 1u);
            __syncthreads();
            int cur = slot[0];
            constexpr int NAU = 3072 * ATTN_REPS;
            if (cur < NAU) {
                u32x4 kq[4], vq[4]; AttnDesc dc = attn_decode(cur % 3072); attn_load(args, dc, kq, vq);
                for (;;) {
                    __syncthreads();
                    if (tid == 0) slot[0] = (int)atomicAdd(qhead, 1u);
                    attn_stage(args, dc, kq, vq, lds);
                    __syncthreads();
                    const int nxt = slot[0]; AttnDesc dn = attn_decode(nxt < NAU ? nxt % 3072 : 0);
                    if (nxt < NAU) attn_load(args, dn, kq, vq);
                    attn_compute(args, dc, lds);
                    if (nxt >= NAU) break;
                    dc = dn; cur = nxt;
                }
            }
            __syncthreads();
        }
    }
    SEAM(4);
    if (IN(5)) REPS(5) { REPBAR(); p5_combine(args, wg, G); }
    SEAM(5);
    if (IN(6)) REPS(6) {
        REPBAR();
#ifndef P6A_REPS
#define P6A_REPS 1
#endif
#ifndef P6B_REPS
#define P6B_REPS 1
#endif
        { pg8::StaticOrder S; S.init(ws + WS_ATT, ws + WS_WATT, T, D, 256, G, wg, P6A_REPS);
          FMix1 f{(bf16_t*)(ws + WS_H), (const bf16_t*)args.out};
          if (NAIVE(6)) pg8::gemm_naive<false>(256, S, f); else { pg8::EpiRow8<FMix1> E{f}; pg8::gemm_phase(lds, 256, S, E); } }
        VM_WAIT(); __syncthreads();
        { pg8::StaticOrder S; S.init(ws + WS_ORW, ws + WS_WRWKV, T, D, CR, G, wg, P6B_REPS);
          FMix2 f{(bf16_t*)(ws + WS_H), (const bf16_t*)args.out};
          if (NAIVE(6)) pg8::gemm_naive<false>(CR, S, f); else { pg8::EpiRow8<FMix2> E{f}; pg8::gemm_phase(lds, CR, S, E); } }
    }
    SEAM(6);
    if (IN(7)) REPS(7) {
        REPBAR();
        pg8::StaticOrder S; S.init(ws + WS_H, ws + WS_WOUT, T, D, D, G, wg);
        FOut f{args.in[I_X], args.out};
        if (NAIVE(7)) pg8::gemm_naive<false>(D, S, f); else { pg8::EpiRow8<FOut> E{f}; pg8::gemm_phase(lds, D, S, E); }
    }
    SEAM(7);
    if (IN(8)) REPS(8) { REPBAR(); p8_router(args, lds, wg, G, rep); }
    SEAM(8);
    LAS int* tab = (LAS int*)(lds + LDS_TAB);
    const unsigned* cnt = (const unsigned*)(ws + WS_CTL) + CW_CNT; const int* lists = (const int*)(ws + WS_LIST);
    if (IN(9)) REPS(9) {
        REPBAR();
        moe_tables(tab, cnt, lists, 0, 64, wg, G);
        MoeOrder S{tab, D, (const char*)(ws + WS_H), (const char*)(ws + WS_WGU), (size_t)1024 * 1024 * 2, 1};
        FGU f{(bf16_t*)(ws + WS_HID), tab, (const float*)(ws + WS_TOKG) + (size_t)2 * T};
        if (NAIVE(9)) pg8::gemm_naive<true>(D, S, f); else { pg8::EpiPair8<FGU> E{f}; pg8::gemm_phase(lds, D, S, E); }
    }
    SEAM(9);
    if (IN(10)) REPS(10) {
        REPBAR();
        moe_tables(tab, cnt, lists, 0, 32, wg, G);
        MoeOrder S{tab, DE, (const char*)(ws + WS_HID), (const char*)(ws + WS_WD), (size_t)1024 * 512 * 2, 0};
        FDown f{args.out, (const float*)(ws + WS_TOKG), tab, 0, rep};
        if (NAIVE(10)) pg8::gemm_naive<false>(DE, S, f); else { pg8::EpiRow8<FDown> E{f}; pg8::gemm_phase(lds, DE, S, E); }
    }
    SEAM(10);
    if (IN(11)) REPS(11) {
        REPBAR();
        moe_tables(tab, cnt, lists, 32, 64, wg, G);
        MoeOrder S{tab, DE, (const char*)(ws + WS_HID), (const char*)(ws + WS_WD), (size_t)1024 * 512 * 2, 0};
        FDown f{args.out, (const float*)(ws + WS_TOKG), tab, 1, rep};
        if (NAIVE(11)) pg8::gemm_naive<false>(DE, S, f); else { pg8::EpiRow8<FDown> E{f}; pg8::gemm_phase(lds, DE, S, E); }
    }
#undef IN
#undef SEAM
#undef NAIVE
}

extern "C" void kernel_launch(void* const* d_in, const int* in_sizes, int n_in, void* d_out, int out_size, void* d_ws, size_t ws_size, hipStream_t stream) {
    static int grid = 0;
    if (grid == 0) {
        if (n_in != 28 || out_size != T * D || ws_size < WS_END) { fprintf(stderr, "kernel_launch: unexpected problem (n_in %d, out %d, ws %zu)\n", n_in, out_size, ws_size); grid = -1; return; }
        int dev = 0, cus = 0;
        if (hipGetDevice(&dev) != hipSuccess || hipDeviceGetAttribute(&cus, hipDeviceAttributeMultiprocessorCount, dev) != hipSuccess) { grid = -1; return; }
        if (hipFuncSetAttribute((const void*)hybrid_fwd, hipFuncAttributeMaxDynamicSharedMemorySize, LDS_BYTES) != hipSuccess) { fprintf(stderr, "kernel_launch: hipFuncSetAttribute failed\n"); grid = -1; return; }
        int per_cu = 0;
        if (hipOccupancyMaxActiveBlocksPerMultiprocessor(&per_cu, (const void*)hybrid_fwd, 512, LDS_BYTES) != hipSuccess || per_cu < 1) fprintf(stderr, "kernel_launch: occupancy query reports %d\n", per_cu);
        (void)hipGetLastError();
        grid = cus;
    }
    if (grid < 0) return;
    (void)hipMemsetAsync((char*)d_ws + WS_CTL, 0, CTL_ZERO_BYTES, stream);
    Args a{};
    for (int i = 0; i < 28; ++i) a.in[i] = (const float*)d_in[i];
    a.out = (float*)d_out; a.ws = (unsigned char*)d_ws;
    if (MK_N_LAUNCHES == 1) { a.ph_lo = 0; a.ph_hi = NPH; hipLaunchKernelGGL(hybrid_fwd, dim3(grid), dim3(512), LDS_BYTES, stream, a); }
    else { for (int p = 0; p < NPH; ++p) { a.ph_lo = p; a.ph_hi = p + 1; hipLaunchKernelGGL(hybrid_fwd, dim3(grid), dim3(512), LDS_BYTES, stream, a); } }
}
```

```cpp
#include <hip/hip_runtime.h>
#include <cstdio>
#include <cstdint>

#ifndef MK_N_LAUNCHES
#define MK_N_LAUNCHES 1
#endif
#ifndef NAIVE_GEMM_MASK
#define NAIVE_GEMM_MASK 0
#endif

#define LAS __attribute__((address_space(3)))
#define GAS __attribute__((address_space(1)))
typedef unsigned short bf16_t;
typedef short bf16x8 __attribute__((ext_vector_type(8)));
typedef short bf16x4 __attribute__((ext_vector_type(4)));
typedef float f32x4 __attribute__((ext_vector_type(4)));
typedef float f32x2 __attribute__((ext_vector_type(2)));
typedef unsigned u32x4 __attribute__((ext_vector_type(4)));
typedef unsigned u32x2 __attribute__((ext_vector_type(2)));

constexpr int D = 1024, BATCH = 16, SEQ = 2048, T = BATCH * SEQ;
constexpr int AW = 768;
constexpr int RW = 1824;
constexpr int NIN = 6144;
constexpr int CR = 512;
constexpr int LK = 384;
constexpr int NEXP = 32, DE = 512;
constexpr int NLIST = 64;
constexpr int NPH = 12;

constexpr size_t MiB = 1u << 20;
#if defined(PROBE_SKEW_PHASE) || defined(PROBE_TIME_PHASE)
constexpr size_t WS_CTL = 0, CTL_ZERO_BYTES = 1 * MiB;
#else
constexpr size_t WS_CTL = 0, CTL_ZERO_BYTES = 128 * 1024;
#endif
constexpr size_t WS_LIST = 1 * MiB;
constexpr size_t WS_TOKG = 9 * MiB;
constexpr size_t WS_WIN = 10 * MiB;
constexpr size_t WS_WATT = 23 * MiB;
constexpr size_t WS_WRWKV = 24 * MiB;
constexpr size_t WS_WOUT = 25 * MiB;
constexpr size_t WS_WLORA = 27 * MiB;
constexpr size_t WS_WR = 29 * MiB;
constexpr size_t WS_H = 30 * MiB;
constexpr size_t WS_OG = WS_H;
constexpr size_t WS_LSE = WS_H + 48 * MiB;
constexpr size_t WS_QKV = 94 * MiB;
constexpr size_t WS_WGU = WS_QKV;
constexpr size_t WS_WD = WS_QKV + 64 * MiB;
constexpr size_t WS_PR = 238 * MiB;
constexpr size_t WS_HID = WS_PR;
constexpr size_t WS_LAG = 352 * MiB;
constexpr size_t WS_Y0 = WS_LAG;
constexpr size_t WS_ATT = 448 * MiB;
constexpr size_t WS_AP = WS_ATT;
constexpr size_t WS_ORW = 464 * MiB;
constexpr size_t WS_END = 496 * MiB;

constexpr int CW_TMO = 0;
constexpr int CW_BAR = 4096;
constexpr int CW_CNT = 16384;
constexpr int CW_QH = 20480;

constexpr int LDS_BYTES = 147456;
constexpr int LDS_TAB = 138112;
constexpr int LDS_MISC = 147456 - 64;

#define RLX_AGENT __ATOMIC_RELAXED, __HIP_MEMORY_SCOPE_AGENT
#define LDS_WAIT() asm volatile("s_waitcnt lgkmcnt(0)" ::: "memory")
#define VM_WAIT() asm volatile("s_waitcnt vmcnt(0)" ::: "memory")

typedef __bf16 bf16x2_t __attribute__((ext_vector_type(2)));
__device__ __forceinline__ unsigned cvt_pk_bf16(float lo, float hi) { const f32x2 v = {lo, hi}; const bf16x2_t b = __builtin_convertvector(v, bf16x2_t); return __builtin_bit_cast(unsigned, b); }
__device__ __forceinline__ float bf_lo(unsigned u) { return __uint_as_float(u << 16); }
__device__ __forceinline__ float bf_hi(unsigned u) { return __uint_as_float(u & 0xffff0000u); }
__device__ __forceinline__ u32x4 pack8(const float (&v)[8]) { u32x4 w; w.x = cvt_pk_bf16(v[0], v[1]); w.y = cvt_pk_bf16(v[2], v[3]); w.z = cvt_pk_bf16(v[4], v[5]); w.w = cvt_pk_bf16(v[6], v[7]); return w; }
__device__ __forceinline__ void unpack8(u32x4 w, float (&v)[8]) { v[0] = bf_lo(w.x); v[1] = bf_hi(w.x); v[2] = bf_lo(w.y); v[3] = bf_hi(w.y); v[4] = bf_lo(w.z); v[5] = bf_hi(w.z); v[6] = bf_lo(w.w); v[7] = bf_hi(w.w); }
__device__ __forceinline__ void unpack4(u32x2 w, float (&v)[4]) { v[0] = bf_lo(w.x); v[1] = bf_hi(w.x); v[2] = bf_lo(w.y); v[3] = bf_hi(w.y); }
__device__ __forceinline__ float rcp_(float x) { return __builtin_amdgcn_rcpf(x); }
__device__ __forceinline__ float sigmoidf_(float x) { return rcp_(1.f + __expf(-x)); }
template <int CTRL> __device__ __forceinline__ float dpp_f(float x) { return __builtin_bit_cast(float, __builtin_amdgcn_mov_dpp(__builtin_bit_cast(int, x), CTRL, 0xf, 0xf, true)); }
__device__ __forceinline__ float red16(float x) { x += dpp_f<0xB1>(x); x += dpp_f<0x4E>(x); x += dpp_f<0x141>(x); x += dpp_f<0x128>(x); return x; }

__device__ __forceinline__ float x16_sum(float x) { const unsigned u = __float_as_uint(x); const auto r = __builtin_amdgcn_permlane16_swap(u, u, false, false); return __uint_as_float(r[0]) + __uint_as_float(r[1]); }
__device__ __forceinline__ float x32_sum(float x) { const unsigned u = __float_as_uint(x); const auto r = __builtin_amdgcn_permlane32_swap(u, u, false, false); return __uint_as_float(r[0]) + __uint_as_float(r[1]); }
__device__ __forceinline__ float x16_max(float x) { const unsigned u = __float_as_uint(x); const auto r = __builtin_amdgcn_permlane16_swap(u, u, false, false); return fmaxf(__uint_as_float(r[0]), __uint_as_float(r[1])); }
__device__ __forceinline__ float x32_max(float x) { const unsigned u = __float_as_uint(x); const auto r = __builtin_amdgcn_permlane32_swap(u, u, false, false); return fmaxf(__uint_as_float(r[0]), __uint_as_float(r[1])); }
__device__ __forceinline__ float wave_sum(float v) { return x32_sum(x16_sum(red16(v))); }
__device__ __forceinline__ float red8(float x) { x += dpp_f<0xB1>(x); x += dpp_f<0x4E>(x); x += dpp_f<0x141>(x); return x; }
__device__ __forceinline__ void red8x2(float& x, float& y) {
    asm("s_nop 1\n\t"
        "v_add_f32_dpp %0, %0, %0 quad_perm:[1,0,3,2] row_mask:0xf bank_mask:0xf bound_ctrl:1\n\t"
        "v_add_f32_dpp %1, %1, %1 quad_perm:[1,0,3,2] row_mask:0xf bank_mask:0xf bound_ctrl:1\n\t"
        "s_nop 0\n\t"
        "v_add_f32_dpp %0, %0, %0 quad_perm:[2,3,0,1] row_mask:0xf bank_mask:0xf bound_ctrl:1\n\t"
        "v_add_f32_dpp %1, %1, %1 quad_perm:[2,3,0,1] row_mask:0xf bank_mask:0xf bound_ctrl:1\n\t"
        "s_nop 0\n\t"
        "v_add_f32_dpp %0, %0, %0 row_half_mirror row_mask:0xf bank_mask:0xf bound_ctrl:1\n\t"
        "v_add_f32_dpp %1, %1, %1 row_half_mirror row_mask:0xf bank_mask:0xf bound_ctrl:1"
        : "+v"(x), "+v"(y));
}
__device__ __forceinline__ float fma_s(float a, float b, float c) { float r; asm("v_fma_f32 %0, %1, %2, %3" : "=v"(r) : "v"(a), "v"(b), "v"(c)); return r; }
__device__ __forceinline__ float mul_s(float a, float b) { float r; asm("v_mul_f32_e32 %0, %1, %2" : "=v"(r) : "v"(a), "v"(b)); return r; }
__device__ __forceinline__ void lds_barrier() { asm volatile("s_waitcnt lgkmcnt(0)\n\ts_barrier" ::: "memory"); }
#define XB_TMO      128
#define XB_XCNT(j)  (256  + 64 * (j))
#define XB_XSUB(j)  (1280 + 64 * (j))
#define XB_XGEN(j)  (2304 + 64 * (j))
#define XB_TOP      3328
#define XB_TOPGEN   3392
#define XCD_BAR_WORDS 3456
#define XB_SPIN_CAP (1u << 18)
__device__ __forceinline__ unsigned xb_ld(unsigned* p)              { return __hip_atomic_load(p, __ATOMIC_RELAXED, __HIP_MEMORY_SCOPE_AGENT); }
__device__ __forceinline__ unsigned xb_add(unsigned* p, unsigned v) { return __hip_atomic_fetch_add(p, v, __ATOMIC_RELAXED, __HIP_MEMORY_SCOPE_AGENT); }
__device__ __forceinline__ unsigned xb_xcc_id() { return (unsigned)__builtin_amdgcn_s_getreg((3 << 11) | 20) & 0xFu; }
#define XB_SPIN(cond, bar) do { unsigned _sp = 0; while (cond) { __builtin_amdgcn_s_sleep(1); \
    if ((++_sp & 255u) == 0u) { if (xb_ld(&(bar)[XB_TMO])) break; if (_sp > XB_SPIN_CAP) { atomicAdd(&(bar)[XB_TMO], 1u); break; } } } } while (0)
struct XcdBarrier { unsigned* bar; unsigned x; volatile LAS unsigned* st; };
__device__ __forceinline__ XcdBarrier xcd_barrier_post(unsigned* bar, volatile LAS unsigned* st) {
    XcdBarrier b; b.bar = bar; b.x = xb_xcc_id(); b.st = st;
    if (threadIdx.x == 0) (void)xb_add(&bar[XB_XCNT(b.x)], 1u);
    return b;
}
__device__ __forceinline__ void xcd_barrier_complete(unsigned* bar, unsigned x, unsigned& nloc, unsigned& nx) {
    const unsigned G = gridDim.x * gridDim.y * gridDim.z;
    unsigned sum, cnt, mine, sp = 0u;
    for (;;) {
        sum = 0u; cnt = 0u; mine = 0u;
#pragma unroll
        for (unsigned j = 0; j < 16; ++j) { const unsigned c = xb_ld(&bar[XB_XCNT(j)]); sum += c; cnt += (c > 0u) ? 1u : 0u; mine = (j == x) ? c : mine; }
        if (sum == G) break;
        __builtin_amdgcn_s_sleep(1);
        if ((++sp & 255u) == 0u) { if (xb_ld(&bar[XB_TMO])) break; if (sp > XB_SPIN_CAP) { atomicAdd(&bar[XB_TMO], 1u); break; } }
    }
    nloc = mine > 0u ? mine : 1u; nx = cnt > 0u ? cnt : 1u;
}
__device__ __forceinline__ void xcd_barrier(const XcdBarrier& b) {
    asm volatile("s_waitcnt vmcnt(0)" ::: "memory");
    __syncthreads();
    if (threadIdx.x == 0) {
        unsigned* bar = b.bar;
        __builtin_amdgcn_s_waitcnt(0);
        unsigned nloc = b.st[0], nx = b.st[1];
        if (nloc == 0u) { xcd_barrier_complete(bar, b.x, nloc, nx); b.st[0] = nloc; b.st[1] = nx; }
        const unsigned old = xb_add(&bar[XB_XSUB(b.x)], 1u);
        const unsigned gen = old / nloc;
        if (old + 1u == (gen + 1u) * nloc) {
            __builtin_amdgcn_fence(__ATOMIC_RELEASE, "agent");
            asm volatile("s_waitcnt vmcnt(0)" ::: "memory");
            const unsigned og = xb_add(&bar[XB_TOP], 1u);
            const unsigned tg = og / nx;
            if (og + 1u == (tg + 1u) * nx) xb_add(&bar[XB_TOPGEN], 1u);
            else XB_SPIN(xb_ld(&bar[XB_TOPGEN]) == tg, bar);
            __builtin_amdgcn_fence(__ATOMIC_ACQUIRE, "agent");
            xb_add(&bar[XB_XGEN(b.x)], 1u);
            asm volatile("s_waitcnt vmcnt(0)" ::: "memory");
        } else {
            XB_SPIN(xb_ld(&bar[XB_XGEN(b.x)]) == gen, bar);
            __builtin_amdgcn_fence(__ATOMIC_ACQUIRE, "agent");
            asm volatile("s_waitcnt vmcnt(0)" ::: "memory");
        }
    }
    __syncthreads();
}

namespace pg8 {
constexpr int BM = 256, BK = 64, HALF = 128, HTB = HALF * BK * 2, NXCD = 8, WGM = 8;
__host__ __device__ __forceinline__ int lds_byte(int r, int c) { const int st = (r >> 4) * 2 + (c >> 5), rr = r & 15, cc = c & 31, ob = rr * 64 + cc * 2; return st * 1024 + (ob ^ (((ob >> 9) & 1) << 5)); }
__host__ __device__ __forceinline__ void stage_rc(int b, int& R, int& C) { const int st = b / 1024, sb = b % 1024, swz = sb ^ (((sb >> 9) & 1) << 5); R = (st >> 1) * 16 + swz / 64; C = (st & 1) * 32 + (swz % 64) / 2; }
__host__ __device__ __forceinline__ int perm32(int rho) { const int n = rho >> 4, i = rho & 15; return 8 * (i >> 2) + 4 * n + (i & 3); }

struct pg8_false { static constexpr bool value = false; }; struct pg8_true { static constexpr bool value = true; };
struct Unit { int pm, pn; const char* A; const char* B; int ui, aux, ng; };

struct StaticOrder {
    static constexpr bool GATHER = false; static constexpr bool MSKIP = false;
    int nM, nN, nwg, G, c, reps; const char* A; const char* Bt; size_t tstep;
    __device__ void init(const void* A_, const void* Bt_, int M, int N, int K, int G_, int c_, int reps_ = 1) { A = (const char*)A_; Bt = (const char*)Bt_; nM = M / BM; nN = N / BM; nwg = nM * nN; G = G_; c = c_; reps = reps_; tstep = (size_t)BM * K * 2; }
    __device__ bool next(int i, Unit& u) const {
        const long L0 = (long)i * G + c; if (L0 >= (long)nwg * reps) return false;
        const long L = L0 % nwg; u.aux = (int)(L0 / nwg);
        int wgid = (int)L; { const int q = nwg / NXCD, r = nwg % NXCD, xcd = wgid % NXCD, off = wgid / NXCD; wgid = (xcd < r ? xcd * (q + 1) : r * (q + 1) + (xcd - r) * q) + off; }
        const int nig = WGM * nN, gid = wgid / nig, fm = gid * WGM, gsz = (nM - fm) < WGM ? (nM - fm) : WGM;
        u.pm = fm + ((wgid % nig) % gsz); u.pn = (wgid % nig) / gsz; u.A = A + (size_t)u.pm * tstep; u.B = Bt + (size_t)u.pn * tstep; u.ui = i; u.ng = 16; return true;
    }
    __device__ __forceinline__ unsigned row_off(const Unit&, int) const { return 0u; }
};

template <class F> struct EpiRow8 {
    F f;
    __device__ __forceinline__ void operator()(const f32x4 (&acc)[2][2][4][2], const Unit& u, int wr, int wc, int fr, int fq) const {
        asm volatile("" : "+v"(fr), "+v"(fq));
        constexpr int MB = F::MB;
        if constexpr (MB == 8) {
            typename F::Pre P[2][4][2];
#pragma unroll
            for (int ai = 0; ai < 2; ++ai)
#pragma unroll
                for (int m = 0; m < 4; ++m)
#pragma unroll
                    for (int bj = 0; bj < 2; ++bj) P[ai][m][bj] = f.pre(u, ai * HALF + wr * 64 + m * 16 + fr, bj * HALF + wc * 32 + 8 * fq);
#pragma unroll
            for (int ai = 0; ai < 2; ++ai) {
#pragma unroll
                for (int m = 0; m < 4; ++m) { const int r = ai * HALF + wr * 64 + m * 16 + fr;
#pragma unroll
                    for (int bj = 0; bj < 2; ++bj) { const f32x4 a = acc[ai][bj][m][0], b = acc[ai][bj][m][1]; const float v[8] = {a[0], a[1], a[2], a[3], b[0], b[1], b[2], b[3]};
                        f(u, r, bj * HALF + wc * 32 + 8 * fq, v, P[ai][m][bj]); } }
                asm volatile("" ::: "memory"); }
        } else
#pragma unroll
        for (int ai = 0; ai < 2; ++ai)
#pragma unroll
            for (int mb = 0; mb < 4; mb += MB) {
                typename F::Pre P[MB][2];
#pragma unroll
                for (int m = 0; m < MB; ++m)
#pragma unroll
                    for (int bj = 0; bj < 2; ++bj) P[m][bj] = f.pre(u, ai * HALF + wr * 64 + (mb + m) * 16 + fr, bj * HALF + wc * 32 + 8 * fq);
#pragma unroll
                for (int m = 0; m < MB; ++m) { const int r = ai * HALF + wr * 64 + (mb + m) * 16 + fr;
#pragma unroll
                    for (int bj = 0; bj < 2; ++bj) { const f32x4 a = acc[ai][bj][mb + m][0], b = acc[ai][bj][mb + m][1]; const float v[8] = {a[0], a[1], a[2], a[3], b[0], b[1], b[2], b[3]};
                        f(u, r, bj * HALF + wc * 32 + 8 * fq, v, P[m][bj]); } }
                asm volatile("" ::: "memory"); }
    }
};
template <class F> struct EpiPair8 {
    F f;
    __device__ __forceinline__ void operator()(const f32x4 (&acc)[2][2][4][2], const Unit& u, int wr, int wc, int fr, int fq) const {
        asm volatile("" : "+v"(fr), "+v"(fq));
        float pv[2][4];
#pragma unroll
        for (int ai = 0; ai < 2; ++ai)
#pragma unroll
            for (int m = 0; m < 4; ++m) pv[ai][m] = f.pre(u, ai * HALF + wr * 64 + m * 16 + fr);
#pragma unroll
        for (int ai = 0; ai < 2; ++ai)
#pragma unroll
            for (int m = 0; m < 4; ++m) { const int r = ai * HALF + wr * 64 + m * 16 + fr;
                const f32x4 a = acc[ai][0][m][0], b = acc[ai][0][m][1], c = acc[ai][1][m][0], d = acc[ai][1][m][1];
                const float g[8] = {a[0], a[1], a[2], a[3], b[0], b[1], b[2], b[3]}, up[8] = {c[0], c[1], c[2], c[3], d[0], d[1], d[2], d[3]};
                f(u, r, wc * 32 + 8 * fq, g, up, pv[ai][m]); asm volatile("" ::: "memory"); }
    }
};

template <bool ALIGN_EPI = true, class Epi, class Sched>
__device__ __forceinline__ void gemm_phase(LAS unsigned char* lds, const int K, const Sched& S, const Epi& E, unsigned long long* acc_out = nullptr) {
    unsigned long long ep_acc = 0ull;
    const int tid = threadIdx.x, wid = __builtin_amdgcn_readfirstlane(tid >> 6), lane = tid & 63, wr = wid >> 2, wc = wid & 3, fr = lane & 15, fq = lane >> 4;
    const int nt = K / BK;
    unsigned voffA[2], voffB[2]; int Rr[2], Cb[2];
#pragma unroll
    for (int i = 0; i < 2; ++i) { int R, C; stage_rc(tid * 16 + i * 8192, R, C); const int Rb = (R & ~31) + perm32(R & 31);
        voffA[i] = (unsigned)(R * K + C) * 2u; voffB[i] = (unsigned)(Rb * K + C) * 2u; Rr[i] = R; Cb[i] = C * 2; }
    const size_t kstep = (size_t)(BK * 2);
    const size_t hstep = (size_t)HALF * K * 2;
    const unsigned ldsw = (unsigned)wid * 1024u;
    const int aoff = lds_byte(wr * 64 + fr, fq * 8), boff = lds_byte(wc * 32 + fr, fq * 8);
#define PG8_SA(b, h) (((b) * 2 + (h)) * HTB)
#define PG8_SB(b, h) ((4 + (b) * 2 + (h)) * HTB)
#define PG8_STAGE_B(bufoff, gbase) do { _Pragma("unroll") for (int _i = 0; _i < 2; ++_i) \
        __builtin_amdgcn_global_load_lds((const unsigned*)((const char*)(gbase) + voffB[_i]), (LAS unsigned*)(lds + (bufoff) + ldsw + _i * 8192), 16, 0, 0); } while (0)
#define PG8_STAGE_A(bufoff, gbase, h) do { _Pragma("unroll") for (int _i = 0; _i < 2; ++_i) { \
        const char* _p; if constexpr (Sched::GATHER) _p = (const char*)(gbase) + ao[h][_i]; else _p = (const char*)(gbase) + (h) * hstep + voffA[_i]; \
        __builtin_amdgcn_global_load_lds((const unsigned*)_p, (LAS unsigned*)(lds + (bufoff) + ldsw + _i * 8192), 16, 0, 0); } } while (0)
#define PG8_LDA(dst, b, h) do { _Pragma("unroll") for (int m = 0; m < 4; ++m) _Pragma("unroll") for (int k = 0; k < 2; ++k) dst[m][k] = *(const LAS bf16x8*)(lds + PG8_SA(b, h) + aoff + m * 2048 + k * 1024); } while (0)
#define PG8_LDB(dst, b, h) do { _Pragma("unroll") for (int n = 0; n < 2; ++n) _Pragma("unroll") for (int k = 0; k < 2; ++k) dst[n][k] = *(const LAS bf16x8*)(lds + PG8_SB(b, h) + boff + n * 2048 + k * 1024); } while (0)
#define PG8_MMA(ai, bj, At, Bt) do { __builtin_amdgcn_s_setprio(1); _Pragma("unroll") for (int m = 0; m < 4; ++m) { if (!SK || m < ((ai) ? nm1 : nm0)) { _Pragma("unroll") for (int n = 0; n < 2; ++n) _Pragma("unroll") for (int k = 0; k < 2; ++k) \
        acc[ai][bj][m][n] = __builtin_amdgcn_mfma_f32_16x16x32_bf16(Bt[n][k], At[m][k], acc[ai][bj][m][n], 0, 0, 0); } } __builtin_amdgcn_s_setprio(0); } while (0)
#define PG8_WAIT_V(n) asm volatile("s_waitcnt vmcnt(" #n ")" ::: "memory")
#define PG8_WAIT_L(n) asm volatile("s_waitcnt lgkmcnt(" #n ")" ::: "memory")
#define PG8_BAR __builtin_amdgcn_s_barrier()
#define PG8_SCHED __builtin_amdgcn_sched_barrier(0)
    Unit cur, nxt; int ui = 0;
    if (!S.next(0, cur)) return;
    int nm0 = 4, nm1 = 4;
#define PG8_SET_NM(u) do { if constexpr (Sched::MSKIP) { const int _ng = __builtin_amdgcn_readfirstlane((u).ng); nm0 = (_ng - 2 * wr + 3) >> 2; nm1 = (_ng - 2 * wr + 2) >> 2; } } while (0)
    PG8_SET_NM(cur);
    f32x4 acc[2][2][4][2];
#pragma unroll
    for (int a = 0; a < 2; ++a)
#pragma unroll
        for (int b = 0; b < 2; ++b)
#pragma unroll
            for (int m = 0; m < 4; ++m)
#pragma unroll
                for (int n = 0; n < 2; ++n) acc[a][b][m][n] = (f32x4){0.f, 0.f, 0.f, 0.f};
    bf16x8 At[4][2], B0[2][2], B1[2][2];
    const char* cA = cur.A; const char* cB = cur.B;
    unsigned ao[2][2] = {{0u, 0u}, {0u, 0u}};
    if constexpr (Sched::GATHER) {
#pragma unroll
        for (int h = 0; h < 2; ++h)
#pragma unroll
            for (int i = 0; i < 2; ++i) ao[h][i] = S.row_off(cur, h * HALF + Rr[i]) + (unsigned)Cb[i];
    }
    PG8_STAGE_B(PG8_SB(0, 0), cB); PG8_STAGE_B(PG8_SB(0, 1), cB + hstep); PG8_STAGE_A(PG8_SA(0, 0), cA, 0); PG8_STAGE_A(PG8_SA(0, 1), cA, 1);
    if (wr == 1) PG8_BAR;
    PG8_WAIT_V(2); PG8_BAR;
    PG8_STAGE_B(PG8_SB(1, 0), cB + kstep); PG8_STAGE_A(PG8_SA(1, 0), cA + kstep, 0); PG8_STAGE_B(PG8_SB(1, 1), cB + hstep + kstep);
    PG8_WAIT_V(6); PG8_BAR;
    for (;;) {
        const bool has_next = S.next(ui + 1, nxt);
        const char* nA = has_next ? nxt.A : cA; const char* nB = has_next ? nxt.B : cB;
        auto ktrips = [&](auto skc) __attribute__((always_inline)) { constexpr bool SK = decltype(skc)::value;
#pragma unroll 1
        for (int t = 0; t < nt; t += 2) {
            const bool last = (t == nt - 2);
            const char* a1 = cA + (size_t)(t + 1) * kstep;
            const char* a2 = last ? nA : cA + (size_t)(t + 2) * kstep; const char* b2 = last ? nB : cB + (size_t)(t + 2) * kstep;
            const char* a3 = a2 + kstep; const char* b3 = b2 + kstep;
            PG8_LDB(B0, 0, 0); PG8_LDB(B1, 0, 1); PG8_SCHED; PG8_LDA(At, 0, 0); PG8_STAGE_A(PG8_SA(1, 1), a1, 1);
            if constexpr (Sched::GATHER) { if (last && has_next) {
#pragma unroll
                for (int h = 0; h < 2; ++h)
#pragma unroll
                    for (int i = 0; i < 2; ++i) ao[h][i] = S.row_off(nxt, h * HALF + Rr[i]) + (unsigned)Cb[i]; } }
            PG8_WAIT_V(8); PG8_WAIT_L(0); PG8_BAR; PG8_MMA(0, 0, At, B0); PG8_MMA(0, 1, At, B1); PG8_BAR; PG8_SCHED;
            PG8_LDA(At, 0, 1); PG8_STAGE_B(PG8_SB(0, 0), b2); PG8_STAGE_B(PG8_SB(0, 1), b2 + hstep); PG8_STAGE_A(PG8_SA(0, 0), a2, 0);
            PG8_WAIT_V(8); PG8_WAIT_L(0); PG8_BAR; PG8_MMA(1, 0, At, B0); PG8_MMA(1, 1, At, B1); PG8_BAR; PG8_SCHED;
            PG8_LDB(B0, 1, 0); PG8_LDB(B1, 1, 1); PG8_SCHED; PG8_LDA(At, 1, 0); PG8_STAGE_A(PG8_SA(0, 1), a2, 1);
            PG8_WAIT_V(8); PG8_WAIT_L(0); PG8_BAR; PG8_MMA(0, 0, At, B0); PG8_MMA(0, 1, At, B1); PG8_BAR; PG8_SCHED;
            PG8_LDA(At, 1, 1); PG8_STAGE_B(PG8_SB(1, 0), b3); PG8_STAGE_B(PG8_SB(1, 1), b3 + hstep); PG8_STAGE_A(PG8_SA(1, 0), a3, 0);
            PG8_WAIT_V(8); PG8_WAIT_L(0); PG8_BAR; PG8_MMA(1, 0, At, B0); PG8_MMA(1, 1, At, B1); PG8_BAR; PG8_SCHED;
        } };
        if constexpr (Sched::MSKIP) { if (nm0 + nm1 == 8) ktrips(pg8_false{}); else ktrips(pg8_true{}); } else ktrips(pg8_false{});
        if constexpr (ALIGN_EPI) { if (wr == 0) PG8_BAR; }
        { const unsigned long long e0 = acc_out ? __builtin_amdgcn_s_memrealtime() : 0ull; E(acc, cur, wr, wc, fr, fq); if (acc_out) ep_acc += __builtin_amdgcn_s_memrealtime() - e0; }
        if (!has_next) break;
#pragma unroll
        for (int a = 0; a < 2; ++a)
#pragma unroll
            for (int b = 0; b < 2; ++b)
#pragma unroll
                for (int m = 0; m < 4; ++m)
#pragma unroll
                    for (int n = 0; n < 2; ++n) acc[a][b][m][n] = (f32x4){0.f, 0.f, 0.f, 0.f};
        cur = nxt; cA = nA; cB = nB; ++ui; PG8_SET_NM(cur);
        if constexpr (ALIGN_EPI) { if (wr == 1) PG8_BAR; }
    }
    PG8_WAIT_V(0);
    if constexpr (!ALIGN_EPI) { if (wr == 0) PG8_BAR; }
    PG8_BAR;
    if (acc_out && blockIdx.x == 0 && threadIdx.x == 0) *(volatile unsigned long long*)acc_out = ep_acc;
#undef PG8_SA
#undef PG8_SB
#undef PG8_STAGE_A
#undef PG8_STAGE_B
#undef PG8_LDA
#undef PG8_LDB
#undef PG8_MMA
#undef PG8_WAIT_V
#undef PG8_WAIT_L
#undef PG8_BAR
#undef PG8_SCHED
#undef PG8_SET_NM
}

template <bool PAIR, class F, class Sched>
__device__ __forceinline__ void gemm_naive(const int K, const Sched& S, const F& f) {
    Unit u;
    for (int i = 0; S.next(i, u); ++i) {
        const int ncg = PAIR ? 16 : 32;
        for (int it = threadIdx.x; it < 256 * ncg; it += 512) {
            const int r = it & 255, c = (it >> 8) * 8;
            const char* ap = u.A + (Sched::GATHER ? (size_t)S.row_off(u, r) : (size_t)r * K * 2);
            float s0[8], s1[8];
#pragma unroll
            for (int j = 0; j < 8; ++j) { s0[j] = 0.f; s1[j] = 0.f; }
            for (int k = 0; k < K; k += 8) {
                float a[8]; unpack8(*(const u32x4*)(ap + (size_t)k * 2), a);
#pragma unroll
                for (int j = 0; j < 8; ++j) { float b[8]; unpack8(*(const u32x4*)(u.B + ((size_t)(c + j) * K + k) * 2), b);
#pragma unroll
                    for (int e = 0; e < 8; ++e) s0[j] += a[e] * b[e];
                    if constexpr (PAIR) { unpack8(*(const u32x4*)(u.B + ((size_t)(c + 128 + j) * K + k) * 2), b);
#pragma unroll
                        for (int e = 0; e < 8; ++e) s1[j] += a[e] * b[e]; } }
            }
            if constexpr (PAIR) f(u, r, c, s0, s1, f.pre(u, r)); else f(u, r, c, s0, f.pre(u, r, c));
        }
    }
}
}

struct Args { const float* in[28]; float* out; unsigned char* ws; int ph_lo, ph_hi; };
enum { I_X = 0, I_N1G, I_WIN, I_QNG, I_KNG, I_RELB, I_WATT, I_MU, I_W0, I_WUP, I_A0, I_AUP, I_GUP, I_KK, I_KA, I_RK, I_LNW, I_LNB, I_WRWKV, I_WOUT, I_N2G, I_WGR, I_BGR, I_WER, I_BER, I_WEG, I_WEU, I_WED };

#ifndef NT_LMASK
#define NT_LMASK 0xE1
#endif
template <int PH> __device__ __forceinline__ u32x4 ld16(const void* p) { if ((NT_LMASK >> PH) & 1) return __builtin_nontemporal_load((const u32x4*)p); return *(const u32x4*)p; }
template <int PH> __device__ __forceinline__ f32x4 ld16f(const float* p) { if ((NT_LMASK >> PH) & 1) return __builtin_nontemporal_load((const f32x4*)p); return *(const f32x4*)p; }
#ifndef NT_WLOAD
#define NT_WLOAD 1
#endif
__device__ __forceinline__ float ldw(const float* p) { return NT_WLOAD ? __builtin_nontemporal_load(p) : *p; }
__device__ __forceinline__ void tr_item(bf16_t* WT, int Kd, int n0, int k0, const float* src, int ld, int ks0, int cs0, int kvalid, LAS float* scr, int lane) {
    float v[32];
#pragma unroll
    for (int i = 0; i < 32; ++i) { const int kk = 2 * i + (lane >> 5); v[i] = 0.f; if (src != nullptr && kk < kvalid) v[i] = ldw(src + (size_t)(ks0 + kk) * ld + cs0 + (lane & 31)); }
#pragma unroll
    for (int i = 0; i < 32; ++i) { const int kk = 2 * i + (lane >> 5); scr[kk * 33 + (lane & 31)] = v[i]; }
    LDS_WAIT();
    const int c = lane & 7;
#pragma unroll
    for (int j = 0; j < 4; ++j) { const int n = (lane >> 3) + 8 * j; const LAS float* s = scr + (8 * c) * 33 + n;
        u32x4 o; o.x = cvt_pk_bf16(s[0 * 33], s[1 * 33]); o.y = cvt_pk_bf16(s[2 * 33], s[3 * 33]); o.z = cvt_pk_bf16(s[4 * 33], s[5 * 33]); o.w = cvt_pk_bf16(s[6 * 33], s[7 * 33]);
        *(u32x4*)(WT + (size_t)(n0 + n) * Kd + k0 + 8 * c) = o; }
    LDS_WAIT();
}

__device__ __forceinline__ void p0_prologue(const Args& a, LAS unsigned char* lds, int wg, int G) {
    const int tid = threadIdx.x, lane = tid & 63, wave = tid >> 6;
    LAS float* scr = (LAS float*)(lds + wave * 16384);
    const int gw = wg * 8 + wave, NGW = G * 8;
    unsigned char* ws = a.ws;
    constexpr int I_IN = 193 * 16, I_ATT = 32 * 4, I_RWK = 32 * 8, I_OUT = 32 * 16, I_LORA = 48 * 6;
    for (int it = gw; it < I_IN + I_ATT + I_RWK + I_OUT + I_LORA; it += NGW) {
        int r = it;
        if (r < I_IN) { const int kb = r / 193, nb = r % 193, n0 = nb * 32; int cs0 = n0;
            if (n0 >= 6144) cs0 = 4096; else if (n0 >= 4096) cs0 = n0 + 32;
            tr_item((bf16_t*)(ws + WS_WIN), D, n0, kb * 64, a.in[I_WIN], 6176, kb * 64, cs0, 64, scr, lane); continue; } r -= I_IN;
        if (r < I_ATT) { const int kb = r / 32, nb = r % 32; tr_item((bf16_t*)(ws + WS_WATT), 256, nb * 32, kb * 64, a.in[I_WATT], D, kb * 64, nb * 32, 64, scr, lane); continue; } r -= I_ATT;
        if (r < I_RWK) { const int kb = r / 32, nb = r % 32; tr_item((bf16_t*)(ws + WS_WRWKV), 512, nb * 32, kb * 64, a.in[I_WRWKV], D, kb * 64, nb * 32, 64, scr, lane); continue; } r -= I_RWK;
        if (r < I_OUT) { const int kb = r / 32, nb = r % 32; tr_item((bf16_t*)(ws + WS_WOUT), D, nb * 32, kb * 64, a.in[I_WOUT], D, kb * 64, nb * 32, 64, scr, lane); continue; } r -= I_OUT;
        { const int nb = r / 6, kb = r % 6, n0 = nb * 32; const float* src = nullptr; int ks0 = 0, cs0 = 0, kv = 64;
            if (nb < 16) { if (kb == 0) { src = a.in[I_WUP]; cs0 = n0; } }
            else if (nb < 32) { if (kb == 1) { src = a.in[I_AUP]; cs0 = n0 - 512; } }
            else { if (kb >= 2 && kb <= 4) { src = a.in[I_GUP]; cs0 = n0 - 1024; ks0 = (kb - 2) * 64; kv = (kb == 4) ? 32 : 64; } }
            tr_item((bf16_t*)(ws + WS_WLORA), LK, n0, kb * 64, src, CR, ks0, cs0, kv, scr, lane); }
    }
#if defined(SPLIT_STAMP) && SPLIT_STAMP == 1
    if (wg == 0 && tid == 0) *(volatile unsigned long long*)(ws + WS_CTL + 900 * 1024) = __builtin_amdgcn_s_memrealtime();
#endif
    {
        bf16_t* WR = (bf16_t*)(ws + WS_WR); const float* g2 = a.in[I_N2G];
        for (int it = wg * 512 + tid; it < 48 * D; it += G * 512) { const int j = it >> 10, c = it & 1023; float w = 0.f;
            if (j < 4) w = g2[c] * a.in[I_WGR][(size_t)c * 4 + j]; else if (j < 36) w = g2[c] * a.in[I_WER][(size_t)c * 32 + (j - 4)];
            const unsigned hi = cvt_pk_bf16(w, 0.f) & 0xffffu; const float lo = w - bf_lo(hi);
            WR[it] = (bf16_t)hi; WR[48 * D + it] = (bf16_t)(cvt_pk_bf16(lo, 0.f) & 0xffffu); }
    }
#if defined(SPLIT_STAMP) && SPLIT_STAMP == 2
    if (wg == 0 && tid == 0) *(volatile unsigned long long*)(ws + WS_CTL + 900 * 1024) = __builtin_amdgcn_s_memrealtime();
#endif
    const float* x = a.in[I_X]; const float* gn = a.in[I_N1G]; bf16_t* H = (bf16_t*)(ws + WS_H);
    f32x4 g4[4];
#pragma unroll
    for (int j = 0; j < 4; ++j) g4[j] = *(const f32x4*)(gn + 4 * lane + 256 * j);
    for (int m = gw; m < T; m += 4 * NGW) {
        f32x4 v[4][4]; float sq[4];
#pragma unroll
        for (int q = 0; q < 4; ++q) { const int mq = m + q * NGW; const f32x4* xr = (const f32x4*)(x + (size_t)(mq < T ? mq : m) * D) + lane;
#pragma unroll
            for (int j = 0; j < 4; ++j) v[q][j] = ld16f<0>((const float*)(xr + 64 * j)); }
#pragma unroll
        for (int q = 0; q < 4; ++q) { sq[q] = 0.f;
#pragma unroll
            for (int j = 0; j < 4; ++j) sq[q] += (v[q][j].x * v[q][j].x + v[q][j].y * v[q][j].y) + (v[q][j].z * v[q][j].z + v[q][j].w * v[q][j].w); }
#pragma unroll
        for (int q = 0; q < 4; ++q) { const int mq = m + q * NGW; const float rstd = rsqrtf(wave_sum(sq[q]) * (1.f / D) + 1e-6f);
            if (mq < T) { u32x2* o8 = (u32x2*)(H + (size_t)mq * D) + lane;
#pragma unroll
                for (int j = 0; j < 4; ++j) { u32x2 o; o.x = cvt_pk_bf16(v[q][j].x * rstd * g4[j].x, v[q][j].y * rstd * g4[j].y); o.y = cvt_pk_bf16(v[q][j].z * rstd * g4[j].z, v[q][j].w * rstd * g4[j].w); o8[64 * j] = o; } } }
    }
}
__device__ __forceinline__ void p0b_extra_cols(const Args& a, int wg, int G) {
    const int tid = threadIdx.x, lane = tid & 63, wave = tid >> 6, tk = lane & 15, kg = lane >> 4; const int gw = wg * 8 + wave, NGW = G * 8;
    const bf16_t* H = (const bf16_t*)(a.ws + WS_H); bf16_t* PRo = (bf16_t*)(a.ws + WS_PR); const bf16_t* Wx = (const bf16_t*)(a.ws + WS_WIN) + (size_t)6144 * D;
    for (int tile = gw; tile < T / 16; tile += NGW) {
        const int m0 = tile * 16; f32x4 acc0 = (f32x4){0.f, 0.f, 0.f, 0.f}, acc1 = acc0;
        const bf16_t* h1 = H + (size_t)(m0 + tk) * D + 8 * kg;
#pragma unroll 8
        for (int kk = 0; kk < 32; ++kk) {
            const bf16x8 a1 = *(const bf16x8*)(h1 + 32 * kk);
            const bf16x8 b0 = *(const bf16x8*)(Wx + (size_t)tk * D + 32 * kk + 8 * kg), b1 = *(const bf16x8*)(Wx + (size_t)(16 + tk) * D + 32 * kk + 8 * kg);
            acc0 = __builtin_amdgcn_mfma_f32_16x16x32_bf16(a1, b0, acc0, 0, 0, 0); acc1 = __builtin_amdgcn_mfma_f32_16x16x32_bf16(a1, b1, acc1, 0, 0, 0);
        }
#pragma unroll
        for (int e = 0; e < 4; ++e) {
            bf16_t* o = PRo + (size_t)(m0 + 4 * kg + e) * RW + 1792 + tk;
            o[0] = (bf16_t)(cvt_pk_bf16(acc0[e], 0.f) & 0xffffu); o[16] = (bf16_t)(cvt_pk_bf16(acc1[e], 0.f) & 0xffffu); }
    }
}

#ifndef NT_MASK
#define NT_MASK 0x2
#endif
template <int PH> __device__ __forceinline__ void st16(void* p, u32x4 w) { if ((NT_MASK >> PH) & 1) __builtin_nontemporal_store(w, (u32x4*)p); else *(u32x4*)p = w; }
template <int PH> __device__ __forceinline__ void st16f(float* p, f32x4 w) { if ((NT_MASK >> PH) & 1) __builtin_nontemporal_store(w, (f32x4*)p); else *(f32x4*)p = w; }
struct FIn {
    static constexpr int MB = 4;
    bf16_t *Q, *PR, *GATE;
    struct Pre {}; __device__ __forceinline__ Pre pre(const pg8::Unit&, int, int) const { return Pre{}; }
    __device__ __forceinline__ void operator()(const pg8::Unit& u, int r, int c, const float (&v)[8], const Pre&) const {
        const size_t row = (size_t)u.pm * 256 + r; const int pn = u.pn;
        if (pn < 9) { bf16_t* base = Q + (size_t)(pn / 3) * ((size_t)T * AW); st16<1>(base + row * AW + (pn % 3) * 256 + c, pack8(v)); }
        else if (pn < 16) { const int j = (pn - 9) * 256 + c; st16<1>(PR + row * RW + j, pack8(v)); }
        else { const int j = (pn - 16) * 256 + c; float s[8];
#pragma unroll
            for (int e = 0; e < 8; ++e) s[e] = sigmoidf_(v[e]);
            st16<1>(GATE + row * 2048 + j, pack8(s)); }
    }
};
struct FLora {
    static constexpr int MB = 4;
    bf16_t* LAG; const float* w0; const float* a0;
    struct Pre {}; __device__ __forceinline__ Pre pre(const pg8::Unit&, int, int) const { return Pre{}; }
    __device__ __forceinline__ void operator()(const pg8::Unit& u, int r, int c, const float (&v)[8], const Pre&) const {
        const size_t row = (size_t)u.pm * 256 + r; const int col = u.pn * 256 + c, which = u.pn >> 1, cc = col & 511; float o[8];
        if (which == 2) {
#pragma unroll
            for (int e = 0; e < 8; ++e) o[e] = v[e];
        } else {
            const float* bias = which == 0 ? w0 : a0;
            const f32x4 b0 = *(const f32x4*)(bias + cc), b1 = *(const f32x4*)(bias + cc + 4);
            const float bv[8] = {b0[0], b0[1], b0[2], b0[3], b1[0], b1[1], b1[2], b1[3]};
            if (which == 1) {
#pragma unroll
                for (int e = 0; e < 8; ++e) o[e] = rcp_(1.f + __expf(-(bv[e] + v[e])));
            } else {
#pragma unroll
                for (int e = 0; e < 8; ++e) { const float z = bv[e] + v[e];
                    const float sp = fmaxf(-z, 0.f) + __logf(1.f + __expf(-fabsf(z)));
                    o[e] = -__expf(-sp - 0.5f); }
            }
        }
        *(u32x4*)(LAG + row * 1536 + col) = pack8(o);
    }
};
struct FMix1 {
    static constexpr int MB = 4;
    bf16_t* MIXED; const bf16_t* GATE;
    struct Pre { u32x4 g; };
    __device__ __forceinline__ Pre pre(const pg8::Unit& u, int r, int c) const { Pre p; p.g = ld16<6>(GATE + ((size_t)u.pm * 256 + r) * 2048 + u.pn * 256 + c); return p; }
    __device__ __forceinline__ void operator()(const pg8::Unit& u, int r, int c, const float (&v)[8], const Pre& pp) const {
        const size_t row = (size_t)u.pm * 256 + r; const int col = u.pn * 256 + c; float g[8], o[8]; unpack8(pp.g, g);
#pragma unroll
        for (int e = 0; e < 8; ++e) o[e] = g[e] * v[e];
        *(u32x4*)(MIXED + row * D + col) = pack8(o);
    }
};
struct FMix2 {
    static constexpr int MB = 4;
    bf16_t* MIXED; const bf16_t* GATE;
    struct Pre { u32x4 g, m; };
    __device__ __forceinline__ Pre pre(const pg8::Unit& u, int r, int c) const { const size_t row = (size_t)u.pm * 256 + r; const int col = u.pn * 256 + c; Pre p; p.g = ld16<6>(GATE + row * 2048 + 1024 + col); p.m = ld16<6>(MIXED + row * D + col); return p; }
    __device__ __forceinline__ void operator()(const pg8::Unit& u, int r, int c, const float (&v)[8], const Pre& pp) const {
        const size_t row = (size_t)u.pm * 256 + r; const int col = u.pn * 256 + c; float g[8], m[8], o[8]; unpack8(pp.g, g);
        unpack8(pp.m, m);
#pragma unroll
        for (int e = 0; e < 8; ++e) o[e] = m[e] + g[e] * v[e];
        if (u.aux == 0) st16<6>(MIXED + row * D + col, pack8(o));
    }
};
struct FOut {
    static constexpr int MB = 4;
    const float* x; float* out;
    struct Pre { f32x4 x0, x1; };
    __device__ __forceinline__ Pre pre(const pg8::Unit& u, int r, int c) const { const size_t off = ((size_t)u.pm * 256 + r) * D + u.pn * 256 + c; Pre p; p.x0 = ld16f<7>(x + off); p.x1 = ld16f<7>(x + off + 4); return p; }
    __device__ __forceinline__ void operator()(const pg8::Unit& u, int r, int c, const float (&v)[8], const Pre& pp) const {
        const size_t off = ((size_t)u.pm * 256 + r) * D + u.pn * 256 + c; const f32x4 x0 = pp.x0, x1 = pp.x1;
        st16f<7>(out + off, (f32x4){x0[0] + v[0], x0[1] + v[1], x0[2] + v[2], x0[3] + v[3]}); st16f<7>(out + off + 4, (f32x4){x1[0] + v[4], x1[1] + v[5], x1[2] + v[6], x1[3] + v[7]});
    }
};

struct MoeOrder {
#ifndef MOE_MSKIP
#define MOE_MSKIP 1
#endif
#ifndef MOE_DEAL
#define MOE_DEAL 0
#endif
    static constexpr bool GATHER = true; static constexpr bool MSKIP = MOE_MSKIP != 0;
    LAS int* tab; int K; const char* Abase; const char* Wbase; size_t wexp; int gatherA; int dry = 0;
    __device__ bool next(int i, pg8::Unit& u) const {
        if (i >= 8) return false; const LAS int* d = tab + 160 + 4 * i; if (d[3] == 0) return false;
        const int l = d[0], rt = d[1], pn = d[2]; u.pm = rt; u.pn = pn; u.ui = i; u.aux = l; u.ng = dry ? 0 : d[3];
        u.A = gatherA ? Abase : Abase + (size_t)(tab[l] + rt) * 256 * (size_t)K * 2;
        u.B = Wbase + (size_t)(l & 31) * wexp + (size_t)pn * 256 * (size_t)K * 2; return true;
    }
    __device__ __forceinline__ unsigned row_off(const pg8::Unit& u, int r) const {
        if (gatherA) { int tok = tab[256 + u.ui * 256 + r]; tok = tok < 0 ? 0 : tok; return (unsigned)tok * (unsigned)(K * 2); }
        return (unsigned)r * (unsigned)(K * 2);
    }
};
__device__ __forceinline__ void moe_tables(LAS int* tab, const unsigned* cnt, const int* lists, int l_lo, int l_hi, int wg, int G) {
    const int tid = threadIdx.x;
    __syncthreads();
    if (tid < 64) {
        const int c = (int)cnt[64 * tid], nt = (c + 255) >> 8; tab[80 + tid] = c; int s = nt, f = c >> 8;
#pragma unroll
        for (int d = 1; d < 64; d <<= 1) { const int t = __shfl_up(s, d, 64), t2 = __shfl_up(f, d, 64); if (tid >= d) { s += t; f += t2; } }
        tab[tid] = s - nt; if (tid == 63) { tab[64] = s; tab[65] = f; } }
    __syncthreads();
    if (tid < 8) { const int NT = tab[64], NF = tab[65], xq = wg & 7, yq = wg >> 3, per = G >> 5  , ngrp = per * 8, j = xq * per + (yq >> 2);
        int l = 0, rt = 0, ng = 0;
#if MOE_DEAL == 0
#ifndef MOE_LAST_SPREAD
#define MOE_LAST_SPREAD 1
#endif
        { const int rl = NT > 0 ? (NT - 1) / ngrp : 0, jl = (MOE_LAST_SPREAD && tid == rl) ? (yq >> 2) * 8 + xq : j; const int tile = tid * ngrp + jl; if (tile < NT && (yq >> 2) < per) { while (tab[l + 1] <= tile) ++l; rt = tile - tab[l]; const int v = tab[80 + l] - rt * 256; ng = v >= 256 ? 16 : (v + 15) >> 4; } }
        if (false) { const int rf = 0, R = 0;
#else
        if (NT > 0 && (yq >> 2) < per) { const int rf = (NT - 1) / ngrp, R = NT - ngrp * rf;
#endif
            if (tid < rf + (j < R ? 1 : 0)) { const int rank = j >= R ? tid * (ngrp - R) + (j - R) : rf * (ngrp - R) + tid * R + j;
                if (rank < NF) { int k = rank; for (int i = 0; i < 64; ++i) { const int ll = (i >> 1) + 32 * (i & 1), nfl = tab[80 + ll] >> 8; if (k < nfl) { l = ll; rt = k; ng = 16; break; } k -= nfl; } }
                else { int k = rank - NF; for (int i = 0; i < 64; ++i) { const int ll = (i >> 1) + 32 * (i & 1), c = tab[80 + ll]; if (c & 255) { if (k == 0) { l = ll; rt = c >> 8; ng = ((c & 255) + 15) >> 4; break; } --k; } } } } }
        LAS int* d = tab + 160 + 4 * tid; d[0] = l; d[1] = rt; d[2] = yq & 3; d[3] = ng; }
    __syncthreads();
    {
        int val[4];
#pragma unroll
        for (int k = 0; k < 4; ++k) { const int e = tid + 512 * k, i = e >> 8, r = e & 255; const LAS int* d = tab + 160 + 4 * i; const int l = d[0], rt = d[1];
            const int pos = rt * 256 + ((((r >> 4) & 3) * 4 + ((r >> 6) & 1) * 2 + (r >> 7)) << 4) + (r & 15);
            val[k] = (d[3] != 0 && pos < tab[80 + l]) ? lists[(size_t)l * T + pos] : -1; }
#pragma unroll
        for (int k = 0; k < 4; ++k) tab[256 + tid + 512 * k] = val[k]; }
    __syncthreads();
}
struct FGU {
    bf16_t* HID; const LAS int* tab; const float* rstd;
    __device__ __forceinline__ float pre(const pg8::Unit& u, int r) const { int tok = tab[256 + u.ui * 256 + r]; tok = tok < 0 ? 0 : tok; return rstd[tok]; }
    __device__ __forceinline__ void operator()(const pg8::Unit& u, int r, int c, const float (&g)[8], const float (&up)[8], const float rs) const {
        const size_t hrow = (size_t)(tab[u.aux] + u.pm) * 256 + r; float o[8];
#pragma unroll
        for (int e = 0; e < 8; ++e) { const float gg = g[e] * rs; o[e] = gg * sigmoidf_(gg) * (up[e] * rs); }
        st16<9>(HID + hrow * DE + u.pn * 128 + c, pack8(o));
    }
};
struct FDown0 {
    static constexpr int MB = 4; static constexpr bool PIPE = false;
    bf16_t* Y0; const float* tokg; const LAS int* tab;
    struct Pre {};
    __device__ __forceinline__ Pre pre(const pg8::Unit&, int, int) const { return Pre{}; }
    __device__ __forceinline__ void operator()(const pg8::Unit& u, int r, int c, const float (&v)[8], const Pre&) const {
        const int tok = tab[256 + u.ui * 256 + r]; if (tok < 0) return;
        st16<10>(Y0 + (size_t)(u.aux >> 5) * ((size_t)T * D) + (size_t)tok * D + u.pn * 256 + c, pack8(v));
    }
};
struct FDown {
    static constexpr int MB = 2;
    float* out; const float* tokg; const LAS int* tab; const bf16_t* Y0; int dry;
    struct Pre { f32x4 x0, x1; u32x4 y; float g; };
    __device__ __forceinline__ Pre pre(const pg8::Unit& u, int r, int c) const { Pre p; int tok = tab[256 + u.ui * 256 + r]; tok = tok < 0 ? 0 : tok;
        const size_t off = (size_t)tok * D + u.pn * 256 + c; const float* q = out + off; p.x0 = *(const f32x4*)q; p.x1 = *(const f32x4*)(q + 4); p.y = *(const u32x4*)(Y0 + off); p.g = tokg[tok * 2 + 1]; return p; }
    __device__ __forceinline__ void operator()(const pg8::Unit& u, int r, int c, const float (&v)[8], const Pre& pp) const {
        const int tok = tab[256 + u.ui * 256 + r]; if (tok < 0 || dry) return;
        const float g = pp.g; float* p = out + (size_t)tok * D + u.pn * 256 + c; float y[8]; unpack8(pp.y, y);
        *(f32x4*)p = (f32x4){pp.x0[0] + y[0] + g * v[0], pp.x0[1] + y[1] + g * v[1], pp.x0[2] + y[2] + g * v[2], pp.x0[3] + y[3] + g * v[3]};
        *(f32x4*)(p + 4) = (f32x4){pp.x1[0] + y[4] + g * v[4], pp.x1[1] + y[5] + g * v[5], pp.x1[2] + y[6] + g * v[6], pp.x1[3] + y[7] + g * v[7]};
    }
};

struct LoraW { u32x4 r[5]; };
__device__ __forceinline__ void lora_gload(const Args& a, int grp, LoraW& w) {
    const int which = grp >> 2, ppr = which == 2 ? 20 : 8, kb0 = which == 0 ? 0 : (which == 1 ? 128 : 256);
    const unsigned char* WL = a.ws + WS_WLORA + (size_t)grp * 128 * LK * 2 + kb0;
#pragma unroll
    for (int i = 0; i < 5; ++i) { const int pc = threadIdx.x + 512 * i; w.r[i] = (u32x4){0u, 0u, 0u, 0u};
        if (pc < 128 * ppr) { const int row = pc / ppr, c16 = pc - row * ppr; w.r[i] = *(const u32x4*)(WL + (size_t)row * (LK * 2) + c16 * 16); } }
}
__device__ __forceinline__ void lora_lstore(LAS unsigned char* lds, int grp, const LoraW& w) {
    const int which = grp >> 2, ppr = which == 2 ? 20 : 8, stride = which == 2 ? 336 : 144;
#pragma unroll
    for (int i = 0; i < 5; ++i) { const int pc = threadIdx.x + 512 * i;
        if (pc < 128 * ppr) { const int row = pc / ppr, c16 = pc - row * ppr; *(LAS u32x4*)(lds + row * stride + c16 * 16) = w.r[i]; } }
}
template <int WHICH> __device__ __forceinline__ void lora_group(const Args& a, LAS unsigned char* lds, int grp, const bf16x8 (&af)[10], LAS float* xs, int m0, int lane, const int skip) {
    constexpr int K0 = WHICH == 0 ? 0 : (WHICH == 1 ? 2 : 4), NK = WHICH == 2 ? 5 : 2, STRIDE = WHICH == 2 ? 336 : 144;
    const int tk = lane & 15, kg = lane >> 4, c0 = grp * 128; bf16_t* LAG = (bf16_t*)(a.ws + WS_LAG);
    f32x4 bq0[4], bq1[4];
    if constexpr (WHICH != 2) { const float* bias = WHICH == 0 ? a.in[I_W0] : a.in[I_A0];
#pragma unroll
        for (int q = 0; q < 4; ++q) { const int it = q * 64 + lane, cc = (c0 & 511) + (it & 15) * 8; bq0[q] = *(const f32x4*)(bias + cc); bq1[q] = *(const f32x4*)(bias + cc + 4); } }
    f32x4 acc[8];
#pragma unroll
    for (int nt = 0; nt < 8; ++nt) { acc[nt] = (f32x4){0.f, 0.f, 0.f, 0.f};
#pragma unroll
        for (int ks = 0; ks < NK; ++ks) acc[nt] = __builtin_amdgcn_mfma_f32_16x16x32_bf16(af[K0 + ks], *(const LAS bf16x8*)(lds + (nt * 16 + tk) * STRIDE + ks * 64 + kg * 16), acc[nt], 0, 0, 0); }
#pragma unroll
    for (int nt = 0; nt < 8; ++nt)
#pragma unroll
        for (int e = 0; e < 4; ++e) xs[(4 * kg + e) * 132 + nt * 16 + tk] = acc[nt][e];
    LDS_WAIT();
    if (!(skip & 1))
#pragma unroll
    for (int q = 0; q < 4; ++q) { const int it = q * 64 + lane, tq = it >> 4, c8 = (it & 15) * 8, cc = (c0 & 511) + c8; float o[8];
        const f32x4 v0 = *(const LAS f32x4*)(xs + tq * 132 + c8), v1 = *(const LAS f32x4*)(xs + tq * 132 + c8 + 4); const float v[8] = {v0[0], v0[1], v0[2], v0[3], v1[0], v1[1], v1[2], v1[3]};
        if constexpr (WHICH == 2) {
#pragma unroll
            for (int e = 0; e < 8; ++e) o[e] = v[e];
        } else { const f32x4 b0 = bq0[q], b1 = bq1[q]; (void)cc;
            const float bv[8] = {b0[0], b0[1], b0[2], b0[3], b1[0], b1[1], b1[2], b1[3]};
#pragma unroll
            for (int e = 0; e < 8; ++e) { const float z = bv[e] + v[e];
                const float sg = rcp_(1.f + __expf(-z));
                o[e] = WHICH == 1 ? sg : -0.60653065971f * sg; } }
        *(u32x4*)(LAG + ((unsigned)(m0 + tq) * 1536u + (unsigned)(c0 + c8))) = pack8(o); }
    LDS_WAIT();
}
__device__ __forceinline__ void p2_lora(const Args& a, LAS unsigned char* lds, int wg, int G, const int skip = 0) {
    const int tid = threadIdx.x, lane_o = tid & 63, wave = tid >> 6;
    const bf16_t* PR = (const bf16_t*)(a.ws + WS_PR); const float* mu = a.in[I_MU];
    LAS float* xs = (LAS float*)(lds + 53248 + wave * 8448);
    for (int tg = wg; tg < T / 128; tg += G) {
        int lane = lane_o; asm volatile("" : "+v"(lane));
        const int tk = lane & 15, kg = lane >> 4;
        const int m0 = tg * 128 + wave * 16, t = m0 + tk; const bool hp = (t & (SEQ - 1)) != 0;
        bf16x8 af[10];
        auto build = [&](const int kk) {
            if (skip & 4) return (bf16x8){0, 0, 0, 0, 0, 0, 0, 0};
            const int j = 32 * kk + 8 * kg; float p[8], q[8], o[8];
            const unsigned po = (unsigned)t * (unsigned)RW + 1536u + (unsigned)j;
            unpack8(*(const u32x4*)(PR + po), p);
            if (hp) unpack8(*(const u32x4*)(PR + (po - (unsigned)RW)), q); else {
#pragma unroll
                for (int e = 0; e < 8; ++e) q[e] = 0.f; }
            const f32x4 m0v = *(const f32x4*)(mu + 1536 + j), m1v = *(const f32x4*)(mu + 1536 + j + 4); const float mv[8] = {m0v[0], m0v[1], m0v[2], m0v[3], m1v[0], m1v[1], m1v[2], m1v[3]};
#pragma unroll
            for (int e = 0; e < 8; ++e) { const float pm = p[e] + (q[e] - p[e]) * mv[e];
                if (kk < 2) { const float ex = __expf(2.f * pm); o[e] = 1.f - 2.f * rcp_(ex + 1.f); }
                else if (kk < 4) o[e] = pm; else o[e] = sigmoidf_(pm); }
            return __builtin_bit_cast(bf16x8, pack8(o)); };
        LoraW wq; lora_gload(a, 0, wq);
#define LORA_STEP(WH, grp) do { __syncthreads(); lora_lstore(lds, grp, wq); __syncthreads(); if ((grp) + 1 < 12) lora_gload(a, (grp) + 1, wq); \
        if (!(skip & 2)) lora_group<WH>(a, lds, grp, af, xs, m0, lane, skip); } while (0)
        af[0] = build(0); af[1] = build(1);
        LORA_STEP(0, 0); LORA_STEP(0, 1); LORA_STEP(0, 2); LORA_STEP(0, 3);
        af[2] = build(2); af[3] = build(3);
        LORA_STEP(1, 4); LORA_STEP(1, 5); LORA_STEP(1, 6); LORA_STEP(1, 7);
#pragma unroll
        for (int kk = 4; kk < 9; ++kk) af[kk] = build(kk);
        af[9] = (bf16x8){0, 0, 0, 0, 0, 0, 0, 0};
        LORA_STEP(2, 8); LORA_STEP(2, 9); LORA_STEP(2, 10); LORA_STEP(2, 11);
#undef LORA_STEP
        __syncthreads();
    }
}

namespace cs {
constexpr int AB = 0, RB = 2176, BT = 4352, KT = 6656, BHT = 8960, KHT = 11520, VT = 14080, AAK = 16640, ARBK = 17152, TA = 18176, PC = 18688, MB = 18944, CHB = 19968;
constexpr int LDB = 4 * CHB;
}
__device__ __forceinline__ bf16x8 frag8(const LAS unsigned char* p0, const LAS unsigned char* p1) { const u32x2 a = *(const LAS u32x2*)p0, b = *(const LAS u32x2*)p1; u32x4 w; w.x = a.x; w.y = a.y; w.z = b.x; w.w = b.y; return __builtin_bit_cast(bf16x8, w); }
__device__ __forceinline__ bf16x8 frag4z(const LAS unsigned char* p0) { const u32x2 a = *(const LAS u32x2*)p0; u32x4 w; w.x = a.x; w.y = a.y; w.z = 0u; w.w = 0u; return __builtin_bit_cast(bf16x8, w); }
__device__ __forceinline__ void scan_unit(const Args& a, LAS unsigned char* lds, int b, int hd, const int skip = 0) {
    using namespace cs;
    const int tid = threadIdx.x, w = tid >> 6, lane = tid & 63, x = lane & 15, kg = lane >> 4;
    const int tok = tid >> 3, d8 = (tid & 7) * 8, ch0 = hd * 64 + d8, ci = tok >> 4, tl = tok & 15;
    const bf16_t* PR = (const bf16_t*)(a.ws + WS_PR); const bf16_t* LAG = (const bf16_t*)(a.ws + WS_LAG); bf16_t* ORW = (bf16_t*)(a.ws + WS_ORW);
    f32x4 sT[4];
#pragma unroll
    for (int kt = 0; kt < 4; ++kt) sT[kt] = (f32x4){0.f, 0.f, 0.f, 0.f};
    u32x4 pr_r, pr_k, pr_v, pp_r, pp_k, pp_v, p_ld, p_a, p_g;
    auto prefetch = [&](int ms) {
        const int sq = ms * 64 + tok; const unsigned t = (unsigned)(b * SEQ + sq); const unsigned o1 = t * (unsigned)RW + (unsigned)ch0, o2 = t * 1536u + (unsigned)ch0;
        pr_r = *(const u32x4*)(PR + o1); pr_k = *(const u32x4*)(PR + o1 + 512u); pr_v = *(const u32x4*)(PR + o1 + 1024u);
        if (sq > 0) { pp_r = *(const u32x4*)(PR + (o1 - (unsigned)RW)); pp_k = *(const u32x4*)(PR + (o1 - (unsigned)RW + 512u)); pp_v = *(const u32x4*)(PR + (o1 - (unsigned)RW + 1024u)); }
        else { pp_r = (u32x4){0u, 0u, 0u, 0u}; pp_k = pp_r; pp_v = pp_r; }
        p_ld = ld16<4>(LAG + o2); p_a = ld16<4>(LAG + o2 + 512u); p_g = ld16<4>(LAG + o2 + 1024u);
    };
    prefetch(0);
    LAS float* ldb = (LAS float*)(lds + LDB);
    LAS float* par = (LAS float*)(lds + LDB + 16384);
    { const float* src[8] = {a.in[I_MU], a.in[I_MU] + 512, a.in[I_MU] + 1024, a.in[I_KK], a.in[I_KA], a.in[I_RK], a.in[I_LNW], a.in[I_LNB]};
      lds_barrier();
      if (tid < 64) {
#pragma unroll
          for (int q = 0; q < 8; ++q) par[q * 64 + tid] = src[q][hd * 64 + tid]; }
      lds_barrier(); }
    const int x_o = x, kg_o = kg, tok_o = tok, d8_o = d8;
#ifdef SCAN_ACC
    unsigned long long tacc = 0ull, tq0 = 0ull;
#define SACC_BEGIN(id) do { if (SCAN_ACC == (id)) tq0 = __builtin_amdgcn_s_memrealtime(); } while (0)
#define SACC_END(id) do { if (SCAN_ACC == (id)) tacc += __builtin_amdgcn_s_memrealtime() - tq0; } while (0)
#else
#define SACC_BEGIN(id) do { } while (0)
#define SACC_END(id) do { } while (0)
#endif
    for (int ms = 0; ms < SEQ / 64; ++ms) {
        SACC_BEGIN(1); SACC_BEGIN(4);
        float r[8], k[8], v[8], g[8], kk[8], bb[8], ld[8]; float bonus;
        int x = x_o, kg = kg_o, tok = tok_o, d8 = d8_o; asm volatile("" : "+v"(x), "+v"(kg), "+v"(tok), "+v"(d8));
        const int ci = tok >> 4, tl = tok & 15; int cho = hd * 64 + d8;
        {
            float pm[8], mu[8], aa[8], kkp[8], kap[8], rkp[8];
#define LD8(dst, row) { const f32x4 t0 = *(const LAS f32x4*)(par + (row) * 64 + d8), t1 = *(const LAS f32x4*)(par + (row) * 64 + d8 + 4); dst[0] = t0[0]; dst[1] = t0[1]; dst[2] = t0[2]; dst[3] = t0[3]; dst[4] = t1[0]; dst[5] = t1[1]; dst[6] = t1[2]; dst[7] = t1[3]; }
            unpack8(pr_r, r); unpack8(pp_r, pm); LD8(mu, 0)
#pragma unroll
            for (int e = 0; e < 8; ++e) r[e] = r[e] + (pm[e] - r[e]) * mu[e];
            asm volatile("" ::: "memory");
            unpack8(pr_v, v); unpack8(pp_v, pm); LD8(mu, 2) unpack8(p_g, g); unpack8(p_ld, ld);
#pragma unroll
            for (int e = 0; e < 8; ++e) v[e] = v[e] + (pm[e] - v[e]) * mu[e];
#pragma unroll
            for (int e = 0; e < 8; ++e) ld[e] = __expf(ld[e]);
            *(LAS f32x4*)(ldb + tok * 64 + d8) = (f32x4){ld[0], ld[1], ld[2], ld[3]}; *(LAS f32x4*)(ldb + tok * 64 + d8 + 4) = (f32x4){ld[4], ld[5], ld[6], ld[7]};
            asm volatile("" ::: "memory");
            unpack8(pr_k, k); unpack8(pp_k, pm); LD8(mu, 1) LD8(kkp, 3) LD8(kap, 4) LD8(rkp, 5) unpack8(p_a, aa);
            float ssq = 0.f, bsum = 0.f;
#pragma unroll
            for (int e = 0; e < 8; ++e) { k[e] = k[e] + (pm[e] - k[e]) * mu[e];
                kk[e] = k[e] * kkp[e]; ssq += kk[e] * kk[e]; k[e] = k[e] * (1.f + (aa[e] - 1.f) * kap[e]); bsum += r[e] * k[e] * rkp[e]; }
            ssq = red8(ssq); bonus = red8(bsum);
            const float inv = fminf(__builtin_amdgcn_rsqf(ssq), 1e12f);
#pragma unroll
            for (int e = 0; e < 8; ++e) { kk[e] *= inv; bb[e] = kk[e] * aa[e]; }
        }
        if (ms + 1 < SEQ / 64) prefetch(ms + 1);
        lds_barrier();
        SACC_END(4); SACC_BEGIN(5);
        if (tid < 256 && !(skip & 2)) {
            const int c2 = tid >> 6, kch = tid & 63; LAS float* q = ldb + (c2 * 16) * 64 + kch; float run = 1.f, wv[16];
#pragma unroll
            for (int t = 0; t < 16; ++t) wv[t] = q[t * 64];
#pragma unroll
            for (int t = 0; t < 16; ++t) { run *= wv[t]; q[t * 64] = run; }
            *(LAS float*)(lds + c2 * CHB + PC + kch * 4) = run;
        }
        lds_barrier();
        if (!(skip & 4)) {
            LAS unsigned char* cb = lds + ci * CHB;
            const f32x4 l0 = *(const LAS f32x4*)(ldb + tok * 64 + d8), l1 = *(const LAS f32x4*)(ldb + tok * 64 + d8 + 4);
            const f32x4 e0 = *(const LAS f32x4*)(ldb + (ci * 16 + 15) * 64 + d8), e1 = *(const LAS f32x4*)(ldb + (ci * 16 + 15) * 64 + d8 + 4);
            f32x4 m0 = (f32x4){1.f, 1.f, 1.f, 1.f}, m1 = m0;
            if (tl > 0) { m0 = *(const LAS f32x4*)(ldb + (tok - 1) * 64 + d8); m1 = *(const LAS f32x4*)(ldb + (tok - 1) * 64 + d8 + 4); }
            const float Lt[8] = {l0[0], l0[1], l0[2], l0[3], l1[0], l1[1], l1[2], l1[3]}, Le[8] = {e0[0], e0[1], e0[2], e0[3], e1[0], e1[1], e1[2], e1[3]}, Lm[8] = {m0[0], m0[1], m0[2], m0[3], m1[0], m1[1], m1[2], m1[3]};
            float ab[8], rb[8], bt[8], kt[8], bh[8], kh[8];
#pragma unroll
            for (int e = 0; e < 8; ++e) { const float pm = Lm[e], pt = Lt[e], ip = __builtin_amdgcn_rcpf(Lt[e]), pe = Le[e] * ip;
                ab[e] = -kk[e] * pm; rb[e] = r[e] * pt; bt[e] = bb[e] * ip; kt[e] = k[e] * ip; bh[e] = bb[e] * pe; kh[e] = k[e] * pe; }
            const u32x4 wab = pack8(ab), wrb = pack8(rb);
            *(LAS u32x2*)(cb + AB + tl * 136 + d8 * 2) = (u32x2){wab.x, wab.y}; *(LAS u32x2*)(cb + AB + tl * 136 + d8 * 2 + 8) = (u32x2){wab.z, wab.w};
            *(LAS u32x2*)(cb + RB + tl * 136 + d8 * 2) = (u32x2){wrb.x, wrb.y}; *(LAS u32x2*)(cb + RB + tl * 136 + d8 * 2 + 8) = (u32x2){wrb.z, wrb.w};
            *(LAS u32x4*)(cb + BT + tl * 144 + d8 * 2) = pack8(bt); *(LAS u32x4*)(cb + KT + tl * 144 + d8 * 2) = pack8(kt);
            const u32x4 wbh = pack8(bh), wkh = pack8(kh), wv = pack8(v);
            const unsigned hb[4] = {wbh.x, wbh.y, wbh.z, wbh.w}, hk[4] = {wkh.x, wkh.y, wkh.z, wkh.w}, hv[4] = {wv.x, wv.y, wv.z, wv.w};
#pragma unroll
            for (int e = 0; e < 8; ++e) { const int sh = (e & 1) * 16; const int ro = (d8 + e) * 40 + tl * 2;
                *(LAS bf16_t*)(cb + BHT + ro) = (bf16_t)(hb[e >> 1] >> sh); *(LAS bf16_t*)(cb + KHT + ro) = (bf16_t)(hk[e >> 1] >> sh); *(LAS bf16_t*)(cb + VT + ro) = (bf16_t)(hv[e >> 1] >> sh); }
        }
        lds_barrier();
        SACC_END(5); SACC_BEGIN(6);
        if (!(skip & 8)) {
            LAS unsigned char* cb = lds + (w & 3) * CHB;
            const LAS unsigned char* pa = cb + AB + x * 136 + kg * 16; const LAS unsigned char* prb = cb + RB + x * 136 + kg * 16;
            const LAS unsigned char* pb = cb + BT + x * 144 + kg * 16; const LAS unsigned char* pk = cb + KT + x * 144 + kg * 16;
            const f32x4 z4 = (f32x4){0.f, 0.f, 0.f, 0.f};
            if (w < 4) {
                const bf16x8 a0 = frag8(pa, pa + 8), a1 = frag8(pa + 64, pa + 72), b0 = frag8(pb, pb + 8), b1 = frag8(pb + 64, pb + 72), k0 = frag8(pk, pk + 8), k1 = frag8(pk + 64, pk + 72);
                f32x4 mab = __builtin_amdgcn_mfma_f32_16x16x32_bf16(a0, b0, z4, 0, 0, 0); mab = __builtin_amdgcn_mfma_f32_16x16x32_bf16(a1, b1, mab, 0, 0, 0);
                f32x4 akt = __builtin_amdgcn_mfma_f32_16x16x32_bf16(k0, a0, z4, 0, 0, 0); akt = __builtin_amdgcn_mfma_f32_16x16x32_bf16(k1, a1, akt, 0, 0, 0);
                float ak[4];
#pragma unroll
                for (int e = 0; e < 4; ++e) { const int t = 4 * kg + e; *(LAS float*)(cb + MB + (t * 16 + x) * 4) = (x < t) ? mab[e] : 0.f; ak[e] = (4 * kg + e < x) ? akt[e] : 0.f; }
                *(LAS u32x2*)(cb + AAK + (x * 4 + kg) * 8) = (u32x2){cvt_pk_bf16(ak[0], ak[1]), cvt_pk_bf16(ak[2], ak[3])};
            } else {
                const bf16x8 r0 = frag8(prb, prb + 8), r1 = frag8(prb + 64, prb + 72), b0 = frag8(pb, pb + 8), b1 = frag8(pb + 64, pb + 72), k0 = frag8(pk, pk + 8), k1 = frag8(pk + 64, pk + 72);
                f32x4 rbt = __builtin_amdgcn_mfma_f32_16x16x32_bf16(b0, r0, z4, 0, 0, 0); rbt = __builtin_amdgcn_mfma_f32_16x16x32_bf16(b1, r1, rbt, 0, 0, 0);
                f32x4 rkt = __builtin_amdgcn_mfma_f32_16x16x32_bf16(k0, r0, z4, 0, 0, 0); rkt = __builtin_amdgcn_mfma_f32_16x16x32_bf16(k1, r1, rkt, 0, 0, 0);
                float ab4[4], ak4[4];
#pragma unroll
                for (int e = 0; e < 4; ++e) { const bool ok = (4 * kg + e <= x); ab4[e] = ok ? rbt[e] : 0.f; ak4[e] = ok ? rkt[e] : 0.f; }
                *(LAS u32x4*)(cb + ARBK + (x * 4 + kg) * 16) = (u32x4){cvt_pk_bf16(ab4[0], ab4[1]), cvt_pk_bf16(ab4[2], ab4[3]), cvt_pk_bf16(ak4[0], ak4[1]), cvt_pk_bf16(ak4[2], ak4[3])};
            }
        }
        lds_barrier();
        if (w < 4 && !(skip & 16)) {
            LAS unsigned char* cb = lds + w * CHB; const LAS float* M = (const LAS float*)(cb + MB); const int t = lane >> 2, q = lane & 3;
            f32x4 mrow[16];
#pragma unroll
            for (int i = 1; i < 16; ++i) mrow[i] = *(const LAS f32x4*)(M + i * 16 + 4 * q);
            f32x4 Tr = (f32x4){t == 4 * q ? 1.f : 0.f, t == 4 * q + 1 ? 1.f : 0.f, t == 4 * q + 2 ? 1.f : 0.f, t == 4 * q + 3 ? 1.f : 0.f};
#define T_STEP(i) { const float ti = dpp_f<((i) >> 2) * 0x55>(Tr[(i) & 3]); Tr[0] += ti * mrow[i][0]; Tr[1] += ti * mrow[i][1]; Tr[2] += ti * mrow[i][2]; Tr[3] += ti * mrow[i][3]; }
            T_STEP(15) T_STEP(14) T_STEP(13) T_STEP(12) T_STEP(11) T_STEP(10) T_STEP(9) T_STEP(8) T_STEP(7) T_STEP(6) T_STEP(5) T_STEP(4) T_STEP(3) T_STEP(2) T_STEP(1)
#undef T_STEP
            *(LAS u32x2*)(cb + TA + (t * 4 + q) * 8) = (u32x2){cvt_pk_bf16(Tr[0], Tr[1]), cvt_pk_bf16(Tr[2], Tr[3])};
        }
        lds_barrier();
        SACC_END(1); SACC_END(6); SACC_BEGIN(2);
        if (w < 4 && !(skip & 32)) {
            struct BOps { bf16x8 af0, af1, rf0, rf1, aakf, taf, arbkf; u32x2 vt2; bf16x8 bkf[4]; f32x4 pcv[4]; };
            auto ldops = [&](int c) __attribute__((always_inline)) { BOps o; const LAS unsigned char* cb = lds + c * CHB;
                const LAS unsigned char* pa = cb + AB + x * 136 + kg * 8; const LAS unsigned char* prb = cb + RB + x * 136 + kg * 8;
                o.af0 = frag8(pa, pa + 32); o.af1 = frag8(pa + 64, pa + 96); o.rf0 = frag8(prb, prb + 32); o.rf1 = frag8(prb + 64, prb + 96);
                o.vt2 = *(const LAS u32x2*)(cb + VT + (16 * w + x) * 40 + kg * 8);
                o.aakf = frag4z(cb + AAK + (x * 4 + kg) * 8); o.taf = frag4z(cb + TA + (x * 4 + kg) * 8); o.arbkf = *(const LAS bf16x8*)(cb + ARBK + (x * 4 + kg) * 16);
#pragma unroll
                for (int kt = 0; kt < 4; ++kt) { o.bkf[kt] = frag8(cb + BHT + (16 * kt + x) * 40 + kg * 8, cb + KHT + (16 * kt + x) * 40 + kg * 8); o.pcv[kt] = *(const LAS f32x4*)(cb + PC + (16 * kt + 4 * kg) * 4); }
                return o; };
            BOps oc = ldops(0);
#pragma unroll
            for (int c = 0; c < 4; ++c) {
                BOps on = oc; if (c < 3) on = ldops(c + 1);
                __builtin_amdgcn_sched_barrier(0x7);
                const bf16x8 af0 = oc.af0, af1 = oc.af1, rf0 = oc.rf0, rf1 = oc.rf1, aakf = oc.aakf, taf = oc.taf, arbkf = oc.arbkf; const u32x2 vt2 = oc.vt2;
                bf16x8 bkf[4]; f32x4 pcv[4];
#pragma unroll
                for (int kt = 0; kt < 4; ++kt) { bkf[kt] = oc.bkf[kt]; pcv[kt] = oc.pcv[kt]; }
#ifndef SCAN_S_LO
#define SCAN_S_LO 0
#endif
                bf16x8 hi[2], lo[2];
#pragma unroll
                for (int u = 0; u < 2; ++u) { const float sv[8] = {sT[2 * u][0], sT[2 * u][1], sT[2 * u][2], sT[2 * u][3], sT[2 * u + 1][0], sT[2 * u + 1][1], sT[2 * u + 1][2], sT[2 * u + 1][3]};
                    const u32x4 hw = pack8(sv); hi[u] = __builtin_bit_cast(bf16x8, hw);
                    if (SCAN_S_LO) { float hf[8], lf[8]; unpack8(hw, hf);
#pragma unroll
                        for (int e = 0; e < 8; ++e) lf[e] = sv[e] - hf[e];
                        lo[u] = __builtin_bit_cast(bf16x8, pack8(lf)); } else lo[u] = hi[u]; }
                f32x4 acc = (f32x4){0.f, 0.f, 0.f, 0.f};
                if (SCAN_S_LO) {
                acc = __builtin_amdgcn_mfma_f32_16x16x32_bf16(af0, hi[0], acc, 0, 0, 0); acc = __builtin_amdgcn_mfma_f32_16x16x32_bf16(af0, lo[0], acc, 0, 0, 0);
                acc = __builtin_amdgcn_mfma_f32_16x16x32_bf16(af1, hi[1], acc, 0, 0, 0); acc = __builtin_amdgcn_mfma_f32_16x16x32_bf16(af1, lo[1], acc, 0, 0, 0);
                { u32x4 vw; vw.x = vt2.x; vw.y = vt2.y; vw.z = 0u; vw.w = 0u;
                  acc = __builtin_amdgcn_mfma_f32_16x16x32_bf16(aakf, __builtin_bit_cast(bf16x8, vw), acc, 0, 0, 0); }
                } else {
                u32x4 vw; vw.x = vt2.x; vw.y = vt2.y; vw.z = 0u; vw.w = 0u;
                const f32x4 accv = __builtin_amdgcn_mfma_f32_16x16x32_bf16(aakf, __builtin_bit_cast(bf16x8, vw), acc, 0, 0, 0);
                const f32x4 acc0 = __builtin_amdgcn_mfma_f32_16x16x32_bf16(af0, hi[0], accv, 0, 0, 0), acc1 = __builtin_amdgcn_mfma_f32_16x16x32_bf16(af1, hi[1], acc, 0, 0, 0);
                acc = acc0 + acc1; }
                u32x4 rw; rw.x = cvt_pk_bf16(acc[0], acc[1]); rw.y = cvt_pk_bf16(acc[2], acc[3]); rw.z = 0u; rw.w = 0u;
                const f32x4 U = __builtin_amdgcn_mfma_f32_16x16x32_bf16(taf, __builtin_bit_cast(bf16x8, rw), (f32x4){0.f, 0.f, 0.f, 0.f}, 0, 0, 0);
                u32x4 uvw; uvw.x = cvt_pk_bf16(U[0], U[1]); uvw.y = cvt_pk_bf16(U[2], U[3]); uvw.z = vt2.x; uvw.w = vt2.y;
                const bf16x8 UV = __builtin_bit_cast(bf16x8, uvw);
                f32x4 oacc = (f32x4){0.f, 0.f, 0.f, 0.f};
                oacc = __builtin_amdgcn_mfma_f32_16x16x32_bf16(rf0, hi[0], oacc, 0, 0, 0); if (SCAN_S_LO) oacc = __builtin_amdgcn_mfma_f32_16x16x32_bf16(rf0, lo[0], oacc, 0, 0, 0);
                oacc = __builtin_amdgcn_mfma_f32_16x16x32_bf16(rf1, hi[1], oacc, 0, 0, 0); if (SCAN_S_LO) oacc = __builtin_amdgcn_mfma_f32_16x16x32_bf16(rf1, lo[1], oacc, 0, 0, 0);
                oacc = __builtin_amdgcn_mfma_f32_16x16x32_bf16(arbkf, UV, oacc, 0, 0, 0);
#pragma unroll
                for (int e = 0; e < 4; ++e) ldb[(c * 16 + 4 * kg + e) * 64 + 16 * w + x] = oacc[e];
#pragma unroll
                for (int kt = 0; kt < 4; ++kt) { const f32x4 pc4 = pcv[kt];
                    const f32x4 cin = (f32x4){sT[kt][0] * pc4[0], sT[kt][1] * pc4[1], sT[kt][2] * pc4[2], sT[kt][3] * pc4[3]};
                    sT[kt] = __builtin_amdgcn_mfma_f32_16x16x32_bf16(bkf[kt], UV, cin, 0, 0, 0); }
                oc = on;
            }
        }
        lds_barrier();
        SACC_END(2); SACC_BEGIN(3);
        {
            const f32x4 o0 = *(const LAS f32x4*)(ldb + tok * 64 + d8), o1 = *(const LAS f32x4*)(ldb + tok * 64 + d8 + 4);
            const float o[8] = {o0[0], o0[1], o0[2], o0[3], o1[0], o1[1], o1[2], o1[3]};
            float sm = 0.f;
#pragma unroll
            for (int e = 0; e < 8; ++e) sm += o[e];
            const float mean = red8(sm) * (1.f / 64.f); float dv[8], q = 0.f;
#pragma unroll
            for (int e = 0; e < 8; ++e) { dv[e] = o[e] - mean; q += dv[e] * dv[e]; }
            const float rs = rsqrtf(red8(q) * (1.f / 64.f) + 64e-5f); float y[8], lnw[8], lnb[8];
            LD8(lnw, 6) LD8(lnb, 7)
#undef LD8
#pragma unroll
            for (int e = 0; e < 8; ++e) y[e] = (dv[e] * rs * lnw[e] + lnb[e] + bonus * v[e]) * g[e];
            const unsigned t = (unsigned)(b * SEQ + ms * 64 + tok);
            if (skip) *(u32x4*)((bf16_t*)(a.ws + WS_END) + ((t * (unsigned)CR + (unsigned)ch0) & 0x3fffffu)) = pack8(y); else *(u32x4*)(ORW + (t * (unsigned)CR + (unsigned)ch0)) = pack8(y);
        }
        lds_barrier();
        SACC_END(3);
    }
#ifdef SCAN_ACC
    if (blockIdx.x == 0 && tid == 0) *(volatile unsigned long long*)(a.ws + WS_CTL + 900 * 1024) = tacc;
#endif
}

__device__ __forceinline__ int t5_bucket(int dist) {
    if (dist < 16) return dist;
    const float d = (float)dist; int large = 16 + (int)(logf(d / 16.f) / 4.852030263919617f * 16.f); return large < 31 ? large : 31;
}
struct AttnDesc { int g, dil, b, r, hd, n; };
__device__ __forceinline__ AttnDesc attn_decode(int unit) {
    AttnDesc d; d.g = unit >> 10; const int rem = unit & 1023; d.b = rem >> 6;
    if (d.g == 0) { d.dil = 1; d.r = 0; d.hd = (rem >> 4) & 3; d.n = rem & 15; }
    else if (d.g == 1) { d.dil = 4; d.r = (rem >> 4) & 3; d.hd = (rem >> 2) & 3; d.n = rem & 3; }
    else { d.dil = 16; d.r = (rem >> 2) & 15; d.hd = rem & 3; d.n = 0; }
    return d;
}
__device__ __forceinline__ void attn_load(const Args& a, const AttnDesc& d, u32x4 (&kq)[4], u32x4 (&vq)[4], u32x4 (&qq)[2]) {
    const int tid = threadIdx.x, kgp = tid >> 3, dgp = tid & 7, colq = (4 * d.g + d.hd) * 64 + 8 * dgp;
    { const int lane = tid & 63, w = tid >> 6, qi = 16 * w + (lane & 15), rg = lane >> 4;
      const unsigned qo = (unsigned)(d.b * SEQ + (128 * d.n + qi) * d.dil + d.r) * (unsigned)AW + (unsigned)((4 * d.g + d.hd) * 64 + 8 * rg);
      const bf16_t* Qb = (const bf16_t*)(a.ws + WS_QKV); qq[0] = *(const u32x4*)(Qb + qo); qq[1] = *(const u32x4*)(Qb + qo + 32); }
    const bf16_t* Kb = (const bf16_t*)(a.ws + WS_QKV) + (size_t)T * AW; const bf16_t* Vb = Kb + (size_t)T * AW;
#pragma unroll
    for (int j = 0; j < 4; ++j) { const int lk = 128 * (d.n - 1) + 4 * kgp + j;
        if (lk >= 0) { const unsigned off = (unsigned)(d.b * SEQ + lk * d.dil + d.r) * (unsigned)AW + (unsigned)colq; kq[j] = *(const u32x4*)(Kb + off); vq[j] = *(const u32x4*)(Vb + off); }
        else { kq[j] = (u32x4){0u, 0u, 0u, 0u}; vq[j] = kq[j]; } }
}
__device__ __forceinline__ LAS unsigned char* lds_gain(LAS unsigned char* lds) { return lds + 36864 + 33792 + 12 * 2720; }
__device__ __forceinline__ void attn_stage(const Args& a, const AttnDesc& d, const u32x4 (&kq)[4], const u32x4 (&vq)[4], LAS unsigned char* lds) {
    LAS bf16_t* Ks = (LAS bf16_t*)lds; LAS bf16_t* VT = (LAS bf16_t*)(lds + 36864); LAS float* bias = (LAS float*)(lds + 36864 + 33792);
    const int tid = threadIdx.x, kgp = tid >> 3, dgp = tid & 7;
    const LAS float* kgn = (const LAS float*)(lds_gain(lds)) + d.g * 64 + 8 * dgp; const f32x4 g0 = *(const LAS f32x4*)kgn, g1 = *(const LAS f32x4*)(kgn + 4);
    const float kg8[8] = {g0[0], g0[1], g0[2], g0[3], g1[0], g1[1], g1[2], g1[3]};
#pragma unroll
    for (int j = 0; j < 4; ++j) { float kv[8]; unpack8(kq[j], kv); float ssq = 0.f;
#pragma unroll
        for (int e = 0; e < 8; ++e) ssq += kv[e] * kv[e];
        const float rstd = rsqrtf(red8(ssq) * (1.f / 64.f) + 1e-6f);
#pragma unroll
        for (int e = 0; e < 8; ++e) kv[e] *= rstd * kg8[e];
        *(LAS u32x4*)(Ks + (4 * kgp + j) * 72 + 8 * dgp) = pack8(kv); }
#pragma unroll
    for (int e = 0; e < 8; ++e) { const int sh = (e & 1) * 16, q = e >> 1;
        const unsigned v0 = (vq[0][q] >> sh) & 0xffffu, v1 = (vq[1][q] >> sh) & 0xffffu, v2 = (vq[2][q] >> sh) & 0xffffu, v3 = (vq[3][q] >> sh) & 0xffffu;
        *(LAS u32x2*)(VT + (8 * dgp + e) * 264 + 4 * kgp) = (u32x2){v0 | (v1 << 16), v2 | (v3 << 16)}; }
    (void)bias;
}
__device__ __forceinline__ void attn_bias_tables(const Args& a, LAS unsigned char* lds) {
    LAS float* bias = (LAS float*)(lds + 36864 + 33792);
    for (int it = threadIdx.x; it < 12 * 129; it += 512) { const int head = it / 129, rel = it - head * 129, dil = 1 << (2 * (head >> 2));
        const float bv = a.in[I_RELB][t5_bucket(rel * dil) * 12 + head]; LAS float* bt = bias + head * 680; bt[rel] = bv;
#pragma unroll
        for (int sft = 0; sft < 4; ++sft) bt[136 + sft * 136 + (128 - rel) + sft] = bv; }
    if (threadIdx.x < 192) { LAS float* gl = (LAS float*)lds_gain(lds); gl[threadIdx.x] = a.in[I_KNG][threadIdx.x]; gl[192 + threadIdx.x] = a.in[I_QNG][threadIdx.x]; }
}
__device__ __forceinline__ void attn_compute(const Args& a, const AttnDesc& d, LAS unsigned char* lds, const u32x4 (&qq)[2]) {
    const int g = d.g, dil = d.dil, b = d.b, r = d.r, hd = d.hd, n = d.n;
    const int head = 4 * g + hd, colq = head * 64;
    const bf16_t* Q = (const bf16_t*)(a.ws + WS_QKV);
    LAS bf16_t* Ks = (LAS bf16_t*)lds;
    LAS bf16_t* VT = (LAS bf16_t*)(lds + 36864);
    LAS float* bias = (LAS float*)(lds + 36864 + 33792) + (4 * d.g + d.hd) * 680;
    const int tid = threadIdx.x, lane = tid & 63, w = tid >> 6;
    const int iq = lane & 15, rg = lane >> 4, qi = 16 * w + iq;
    const size_t tq = (size_t)b * SEQ + (size_t)(128 * n + qi) * dil + r;
    bf16x8 qf[2];
    {
        float q0[8], q1[8]; unpack8(qq[0], q0); unpack8(qq[1], q1);
        float ssq = 0.f;
#pragma unroll
        for (int e = 0; e < 8; ++e) ssq += q0[e] * q0[e] + q1[e] * q1[e];
        ssq = x32_sum(x16_sum(ssq));
        const float rstd = rsqrtf(ssq * (1.f / 64.f) + 1e-6f) * 0.125f; const LAS float* qg = (const LAS float*)lds_gain(lds) + 192 + g * 64;
#pragma unroll
        for (int e = 0; e < 8; ++e) { q0[e] *= rstd * qg[8 * rg + e]; q1[e] *= rstd * qg[32 + 8 * rg + e]; }
        qf[0] = __builtin_bit_cast(bf16x8, pack8(q0)); qf[1] = __builtin_bit_cast(bf16x8, pack8(q1));
    }
    const int u0 = w >> 1;
    f32x4 s[10]; float mx = -1e30f;
    const LAS float* brs = bias + 136 + (iq & 3) * 136 + (iq & 3);
#pragma unroll
    for (int j = 0; j < 10; ++j) { const int kt = 2 * u0 + j, dk = kt - w;
        if (dk < 0 || dk > 8 || (n == 0 && kt < 8)) { s[j] = (f32x4){-1e30f, -1e30f, -1e30f, -1e30f}; continue; }
        const bf16x8 k0 = *(const LAS bf16x8*)(Ks + (16 * kt + iq) * 72 + 8 * rg), k1 = *(const LAS bf16x8*)(Ks + (16 * kt + iq) * 72 + 32 + 8 * rg);
        f32x4 z = (f32x4){0.f, 0.f, 0.f, 0.f};
        z = __builtin_amdgcn_mfma_f32_16x16x32_bf16(k0, qf[0], z, 0, 0, 0); z = __builtin_amdgcn_mfma_f32_16x16x32_bf16(k1, qf[1], z, 0, 0, 0);
        if (dk > 0 && dk < 8) { const f32x4 b4 = *(const LAS f32x4*)(brs + (16 * dk + 4 * rg - iq));
            z = z + b4; mx = fmaxf(mx, fmaxf(fmaxf(z[0], z[1]), fmaxf(z[2], z[3]))); }
        else {
#pragma unroll
            for (int e = 0; e < 4; ++e) { const int kj = 16 * kt + 4 * rg + e, rel = qi + 128 - kj; const bool ok = (rel >= 0) && (rel <= 128);
                const int rc = rel < 0 ? 0 : (rel > 128 ? 128 : rel); const float sc = ok ? z[e] + bias[rc] : -1e30f; z[e] = sc; mx = fmaxf(mx, sc); } }
        s[j] = z; }
    mx = x32_max(x16_max(mx));
    float l = 0.f;
#pragma unroll
    for (int j = 0; j < 10; ++j)
#pragma unroll
        for (int e = 0; e < 4; ++e) { const float p = __expf(s[j][e] - mx); s[j][e] = p; l += p; }
    l = x32_sum(x16_sum(l));
    f32x4 oacc[4];
#pragma unroll
    for (int dt = 0; dt < 4; ++dt) oacc[dt] = (f32x4){0.f, 0.f, 0.f, 0.f};
#pragma unroll
    for (int ub = 0; ub < 5; ++ub) {
        u32x4 pw; pw.x = cvt_pk_bf16(s[2 * ub][0], s[2 * ub][1]); pw.y = cvt_pk_bf16(s[2 * ub][2], s[2 * ub][3]); pw.z = cvt_pk_bf16(s[2 * ub + 1][0], s[2 * ub + 1][1]); pw.w = cvt_pk_bf16(s[2 * ub + 1][2], s[2 * ub + 1][3]);
        const bf16x8 pf = __builtin_bit_cast(bf16x8, pw); const int kb = 32 * (u0 + ub) + 4 * rg;
#pragma unroll
        for (int dt = 0; dt < 4; ++dt) { const LAS bf16_t* vp = VT + (16 * dt + iq) * 264 + kb; const u32x2 lo = *(const LAS u32x2*)vp, hi = *(const LAS u32x2*)(vp + 16);
            u32x4 vw; vw.x = lo.x; vw.y = lo.y; vw.z = hi.x; vw.w = hi.y;
            oacc[dt] = __builtin_amdgcn_mfma_f32_16x16x32_bf16(__builtin_bit_cast(bf16x8, vw), pf, oacc[dt], 0, 0, 0); }
    }
    const float il = rcp_(l);
    bf16_t* OG = (bf16_t*)(a.ws + WS_OG) + (size_t)g * T * 256; float* LSE = (float*)(a.ws + WS_LSE) + (size_t)g * T * 4;
#pragma unroll
    for (int dt = 0; dt < 4; ++dt) { u32x2 o; o.x = cvt_pk_bf16(oacc[dt][0] * il, oacc[dt][1] * il); o.y = cvt_pk_bf16(oacc[dt][2] * il, oacc[dt][3] * il);
        *(u32x2*)(OG + tq * 256 + hd * 64 + 16 * dt + 4 * rg) = o; }
    if (rg == 0) LSE[tq * 4 + hd] = mx + logf(l);
}

__device__ __forceinline__ void p5_combine(const Args& a, int wg, int G) {
    const bf16_t* OG = (const bf16_t*)(a.ws + WS_OG); const float* LSE = (const float*)(a.ws + WS_LSE); bf16_t* ATT = (bf16_t*)(a.ws + WS_ATT);
    const int step = G * 512;
    for (int it0 = wg * 512 + threadIdx.x; it0 < T * 32; it0 += 4 * step) {
        float lv[4][3]; u32x4 ov[4][3];
#pragma unroll
        for (int q = 0; q < 4; ++q) { const int it = it0 + q * step < T * 32 ? it0 + q * step : it0; const int t = it >> 5, hs = (it >> 3) & 3, d8 = (it & 7) * 8; const size_t off = (size_t)t * 256 + hs * 64 + d8;
#pragma unroll
            for (int g = 0; g < 3; ++g) { lv[q][g] = LSE[(size_t)g * T * 4 + (size_t)t * 4 + hs]; ov[q][g] = ld16<5>(OG + (size_t)g * T * 256 + off); } }
#pragma unroll
        for (int q = 0; q < 4; ++q) { const int it = it0 + q * step; if (it >= T * 32) break; const int t = it >> 5, hs = (it >> 3) & 3, d8 = (it & 7) * 8; const size_t off = (size_t)t * 256 + hs * 64 + d8;
            const float l0 = lv[q][0], l1 = lv[q][1], l2 = lv[q][2];
            const float m = fmaxf(l0, fmaxf(l1, l2)); float w0 = __expf(l0 - m), w1 = __expf(l1 - m), w2 = __expf(l2 - m); const float iz = rcp_(w0 + w1 + w2); w0 *= iz; w1 *= iz; w2 *= iz;
            float o0[8], o1[8], o2[8], o[8]; unpack8(ov[q][0], o0); unpack8(ov[q][1], o1); unpack8(ov[q][2], o2);
#pragma unroll
            for (int e = 0; e < 8; ++e) o[e] = w0 * o0[e] + w1 * o1[e] + w2 * o2[e];
            *(u32x4*)(ATT + off) = pack8(o); }
    }
}

__device__ __forceinline__ void conv_expert_items(const Args& a, LAS float* scr, int it, int it2, bool two, int lane) {
    constexpr int I_GU = 32 * 32 * 16;
    unsigned char* ws = a.ws;
    auto item = [&](int it, bf16_t*& WT, int& Kd, int& n0, int& k0, const float*& src, int& ld, int& cs0) {
        if (it < I_GU) { const int e = it >> 9, r = it & 511, kb = r >> 5, nb = r & 31; n0 = nb * 32; const int pn = n0 >> 8, j = n0 & 255;
            src = (j < 128 ? a.in[I_WEG] : a.in[I_WEU]) + (size_t)e * D * DE; WT = (bf16_t*)(ws + WS_WGU) + (size_t)e * 1024 * 1024; Kd = D; k0 = kb * 64; ld = DE; cs0 = 128 * pn + (j & 127); }
        else { const int r0 = it - I_GU, e = r0 >> 8, r = r0 & 255, kb = r >> 5, nb = r & 31; n0 = nb * 32;
            src = a.in[I_WED] + (size_t)e * DE * D; WT = (bf16_t*)(ws + WS_WD) + (size_t)e * 1024 * 512; Kd = DE; k0 = kb * 64; ld = D; cs0 = nb * 32; } };
    bf16_t *WTa, *WTb; int Kda, n0a, k0a, lda, csa, Kdb, n0b, k0b, ldb_, csb; const float *sa, *sb;
    item(it, WTa, Kda, n0a, k0a, sa, lda, csa); item(two ? it2 : it, WTb, Kdb, n0b, k0b, sb, ldb_, csb);
    float va[32], vb[32];
#pragma unroll
    for (int i = 0; i < 32; ++i) { const int kk = 2 * i + (lane >> 5); va[i] = ldw(sa + (size_t)(k0a + kk) * lda + csa + (lane & 31)); vb[i] = ldw(sb + (size_t)(k0b + kk) * ldb_ + csb + (lane & 31)); }
    LAS float* scb = scr + 64 * 33;
#pragma unroll
    for (int i = 0; i < 32; ++i) { const int kk = 2 * i + (lane >> 5); scr[kk * 33 + (lane & 31)] = va[i]; scb[kk * 33 + (lane & 31)] = vb[i]; }
    LDS_WAIT();
    const int c = lane & 7;
#pragma unroll
    for (int j = 0; j < 4; ++j) { const int n = (lane >> 3) + 8 * j; const LAS float* q = scr + (8 * c) * 33 + n; const LAS float* q2 = scb + (8 * c) * 33 + n;
        u32x4 o; o.x = cvt_pk_bf16(q[0 * 33], q[1 * 33]); o.y = cvt_pk_bf16(q[2 * 33], q[3 * 33]); o.z = cvt_pk_bf16(q[4 * 33], q[5 * 33]); o.w = cvt_pk_bf16(q[6 * 33], q[7 * 33]);
        *(u32x4*)(WTa + (size_t)(n0a + n) * Kda + k0a + 8 * c) = o;
        if (two) { u32x4 o2; o2.x = cvt_pk_bf16(q2[0 * 33], q2[1 * 33]); o2.y = cvt_pk_bf16(q2[2 * 33], q2[3 * 33]); o2.z = cvt_pk_bf16(q2[4 * 33], q2[5 * 33]); o2.w = cvt_pk_bf16(q2[6 * 33], q2[7 * 33]);
            *(u32x4*)(WTb + (size_t)(n0b + n) * Kdb + k0b + 8 * c) = o2; } }
    LDS_WAIT();
}
__device__ __forceinline__ void p8_router(const Args& a, LAS unsigned char* lds, int wg, int G, int dry) {
    const int tid = threadIdx.x, lane = tid & 63, wave = tid >> 6; const int gw = wg * 8 + wave, NGW = G * 8;
    unsigned char* ws = a.ws;
    {
        LAS float* scr = (LAS float*)(lds + wave * 17408);
        constexpr int I_GU = 32 * 32 * 16;
#ifndef P8_CONV_REPS
#define P8_CONV_REPS 1
#endif
        _Pragma("unroll 1") for (int rr = 0; rr < P8_CONV_REPS; ++rr)
        for (int it = gw; it < I_GU; it += 2 * NGW) { const int it2 = it + NGW; conv_expert_items(a, scr, it, it2, it2 < I_GU, lane); }
    }
    const float* x2 = a.out; const float* gn = a.in[I_N2G]; bf16_t* H2 = (bf16_t*)(ws + WS_H);
    const float* bg = a.in[I_BGR]; const float* be = a.in[I_BER];
    unsigned* cnt = (unsigned*)(ws + WS_CTL) + CW_CNT; int* lists = (int*)(ws + WS_LIST); float* tokg = (float*)(ws + WS_TOKG);
    const bf16_t* Whi = (const bf16_t*)(ws + WS_WR); const bf16_t* Wlo = Whi + 48 * D;
#if defined(SPLIT_STAMP) && SPLIT_STAMP == 8
    VM_WAIT(); __syncthreads(); if (wg == 0 && tid == 0) *(volatile unsigned long long*)(ws + WS_CTL + 900 * 1024) = __builtin_amdgcn_s_memrealtime();
#endif
    __syncthreads();
    LAS float* lgt = (LAS float*)(lds + 53248 + wave * 3200);
    LAS float* gl = (LAS float*)(lds + 81920);
    if (tid < D / 4) *(LAS f32x4*)(gl + 4 * tid) = *(const f32x4*)(gn + 4 * tid);
    const int tk = lane & 15, kg = lane >> 4;
    auto wload = [&](int ch, u32x4 (&r)[6]) {
#pragma unroll
        for (int i = 0; i < 6; ++i) { const int pc = tid + 512 * i, half = pc / 1536, rem = pc - half * 1536, row = rem >> 5, c16 = rem & 31;
            r[i] = *(const u32x4*)(Whi + (size_t)half * 48 * D + (size_t)row * D + ch * 256 + c16 * 8); } };
    auto wstore = [&](const u32x4 (&r)[6]) {
#pragma unroll
        for (int i = 0; i < 6; ++i) { const int pc = tid + 512 * i, half = pc / 1536, rem = pc - half * 1536, row = rem >> 5, c16 = rem & 31;
            *(LAS u32x4*)(lds + half * 25344 + row * 528 + c16 * 16) = r[i]; } };
#ifndef P8_ROUTER_REPS
#define P8_ROUTER_REPS 1
#endif
    _Pragma("unroll 1") for (int rr = 0; rr < P8_ROUTER_REPS; ++rr, dry = 1)
    for (int tg = wg; tg < T / 128; tg += G) {
        const int m0 = tg * 128 + wave * 16; const float* xr = x2 + (size_t)(m0 + tk) * D + 8 * kg;
        f32x4 acc[3]; acc[0] = (f32x4){0.f, 0.f, 0.f, 0.f}; acc[1] = acc[0]; acc[2] = acc[0]; float ssq = 0.f;
        bf16_t* hr = H2 + (size_t)(m0 + tk) * D + 8 * kg;
        u32x4 wq[6]; wload(0, wq);
        f32x4 xa[16], xb[16];
        auto xload = [&](int ch, f32x4 (&x)[16]) {
#pragma unroll
            for (int k8 = 0; k8 < 8; ++k8) { x[2 * k8] = *(const f32x4*)(xr + 32 * (ch * 8 + k8)); x[2 * k8 + 1] = *(const f32x4*)(xr + 32 * (ch * 8 + k8) + 4); } };
        xload(0, xa);
#pragma unroll
        for (int ch = 0; ch < 4; ++ch) {
            __syncthreads(); wstore(wq); __syncthreads();
            if (ch < 3) { wload(ch + 1, wq); if (ch & 1) xload(ch + 1, xa); else xload(ch + 1, xb); }
#pragma unroll
            for (int k8 = 0; k8 < 8; ++k8) { const int kk = ch * 8 + k8;
                const f32x4 x0 = (ch & 1) ? xb[2 * k8] : xa[2 * k8], x1 = (ch & 1) ? xb[2 * k8 + 1] : xa[2 * k8 + 1];
                const f32x4 g0 = *(const LAS f32x4*)(gl + 32 * kk + 8 * kg), g1 = *(const LAS f32x4*)(gl + 32 * kk + 8 * kg + 4);
                const float xv[8] = {x0[0], x0[1], x0[2], x0[3], x1[0], x1[1], x1[2], x1[3]}; float hv[8], lv[8];
                { const float hg[8] = {x0[0] * g0[0], x0[1] * g0[1], x0[2] * g0[2], x0[3] * g0[3], x1[0] * g1[0], x1[1] * g1[1], x1[2] * g1[2], x1[3] * g1[3]}; *(u32x4*)(hr + 32 * kk) = pack8(hg); }
#pragma unroll
                for (int e = 0; e < 8; ++e) ssq += xv[e] * xv[e];
                const u32x4 hw = pack8(xv); unpack8(hw, hv);
#pragma unroll
                for (int e = 0; e < 8; ++e) lv[e] = xv[e] - hv[e];
                const bf16x8 ahi = __builtin_bit_cast(bf16x8, hw), alo = __builtin_bit_cast(bf16x8, pack8(lv));
#pragma unroll
                for (int nt = 0; nt < 3; ++nt) { const LAS unsigned char* wp = lds + (16 * nt + tk) * 528 + k8 * 64 + kg * 16;
                    const bf16x8 bh = *(const LAS bf16x8*)wp, bl = *(const LAS bf16x8*)(wp + 25344);
                    acc[nt] = __builtin_amdgcn_mfma_f32_16x16x32_bf16(ahi, bh, acc[nt], 0, 0, 0);
                    acc[nt] = __builtin_amdgcn_mfma_f32_16x16x32_bf16(alo, bh, acc[nt], 0, 0, 0);
                    acc[nt] = __builtin_amdgcn_mfma_f32_16x16x32_bf16(ahi, bl, acc[nt], 0, 0, 0); }
            }
        }
        ssq = x32_sum(x16_sum(ssq));
        const float rstd = rsqrtf(ssq * (1.f / D) + 1e-6f);
#pragma unroll
        for (int nt = 0; nt < 3; ++nt)
#pragma unroll
            for (int e = 0; e < 4; ++e) lgt[(4 * kg + e) * 49 + 16 * nt + tk] = acc[nt][e];
        LDS_WAIT();
        int l1 = 0, l2 = 0, q1 = 0, q2 = 0; float gate1 = 0.f, gate2 = 0.f;
        LAS int* lcnt = (LAS int*)(lds + 53248 + 8 * 3200);
        if (tid < 64) lcnt[tid] = 0;
        __syncthreads();
        if (lane < 16) {
            const LAS float* L = lgt + lane * 49; float lg[4], le[32];
#pragma unroll
            for (int e = 0; e < 4; ++e) lg[e] = L[e] * rstd + bg[e];
#pragma unroll
            for (int e = 0; e < 32; ++e) le[e] = L[4 + e] * rstd + be[e];
            int grp = 0; float gm = lg[0];
#pragma unroll
            for (int e = 1; e < 4; ++e) if (lg[e] > gm) { gm = lg[e]; grp = e; }
            float gz = 0.f;
#pragma unroll
            for (int e = 0; e < 4; ++e) gz += __expf(lg[e] - gm);
            const float grp_p = 1.f / gz;
            float sel[8];
#pragma unroll
            for (int e = 0; e < 8; ++e) sel[e] = grp == 0 ? le[e] : (grp == 1 ? le[8 + e] : (grp == 2 ? le[16 + e] : le[24 + e]));
            int i1 = 0; float m1 = sel[0];
#pragma unroll
            for (int e = 1; e < 8; ++e) if (sel[e] > m1) { m1 = sel[e]; i1 = e; }
            int i2 = 0; float m2 = -3.0e38f;
#pragma unroll
            for (int e = 0; e < 8; ++e) if (e != i1 && sel[e] > m2) { m2 = sel[e]; i2 = e; }
            const float e2 = __expf(m2 - m1); gate1 = grp_p / (1.f + e2); gate2 = grp_p * e2 / (1.f + e2);
            l1 = grp * 8 + i1; l2 = 32 + grp * 8 + i2;
            q1 = __hip_atomic_fetch_add(lcnt + l1, 1, __ATOMIC_RELAXED, __HIP_MEMORY_SCOPE_WORKGROUP); q2 = __hip_atomic_fetch_add(lcnt + l2, 1, __ATOMIC_RELAXED, __HIP_MEMORY_SCOPE_WORKGROUP);
        }
        __syncthreads();
        if (tid < 64) { const int c = lcnt[tid]; lcnt[64 + tid] = (c > 0 && !dry) ? (int)atomicAdd(cnt + 64 * tid, (unsigned)c) : 0; }
        __syncthreads();
        if (lane < 16) { const int m = m0 + lane;
            if (!dry) { lists[(size_t)l1 * T + lcnt[64 + l1] + q1] = m; lists[(size_t)l2 * T + lcnt[64 + l2] + q2] = m; }
            tokg[(size_t)m * 2] = gate1; tokg[(size_t)m * 2 + 1] = gate2; tokg[(size_t)2 * T + m] = rstd; }
        __syncthreads();
    }
}

__global__ void __launch_bounds__(512, 2) hybrid_fwd(Args args) {
    extern __shared__ __attribute__((aligned(16))) unsigned char lds_raw[];
    LAS unsigned char* lds = (LAS unsigned char*)lds_raw;
    const int tid = threadIdx.x, wg = blockIdx.x, G = gridDim.x;
    unsigned char* ws = args.ws;
    volatile LAS unsigned* MISC = (volatile LAS unsigned*)(lds + LDS_MISC);
    if (tid < 16) MISC[tid] = 0u;
    __syncthreads();
    XcdBarrier bar; bar.bar = (unsigned*)(ws + WS_CTL) + CW_BAR; bar.x = 0; bar.st = nullptr;
    if (MK_N_LAUNCHES == 1) bar = xcd_barrier_post((unsigned*)(ws + WS_CTL) + CW_BAR, MISC);
    const int lo = args.ph_lo, hi = args.ph_hi;
#ifndef PHASE_MASK
#define PHASE_MASK 0xFFF
#endif
#define IN(k) (((PHASE_MASK >> (k)) & 1) && lo <= (k) && (k) < hi)
#define SEAM(k) do { if (IN(k) && IN((k) + 1)) xcd_barrier(bar); } while (0)
#define NAIVE(k) ((NAIVE_GEMM_MASK >> (k)) & 1)

#ifdef PROBE_TIME_PHASE
    unsigned long long tp0 = 0ull, tp1 = 0ull;
#define TSTAMP(k) do { if ((k) == PROBE_TIME_PHASE) tp0 = __builtin_amdgcn_s_memrealtime(); if ((k) == PROBE_TIME_PHASE + 1) tp1 = __builtin_amdgcn_s_memrealtime(); } while (0)
#else
#define TSTAMP(k) do { } while (0)
#endif
#ifdef GEMM_ACC_PHASE
#define GEMM_ACC_PTR(k) ((k) == GEMM_ACC_PHASE ? (unsigned long long*)(ws + WS_CTL + 900 * 1024) : (unsigned long long*)nullptr)
#else
#define GEMM_ACC_PTR(k) ((unsigned long long*)nullptr)
#endif
#ifndef REPEAT_MASK
#define REPEAT_MASK 0
#endif
#define REPS(k) _Pragma("unroll 1") for (int rep = 0; rep < 1 + ((REPEAT_MASK >> (k)) & 1); ++rep)
#define REPBAR() do { if (rep) xcd_barrier(bar); } while (0)
    TSTAMP(0);
    if (IN(0)) REPS(0) { REPBAR(); p0_prologue(args, lds, wg, G); }
    SEAM(0);
    TSTAMP(1);
    if (IN(1)) REPS(1) {
        REPBAR();
        pg8::StaticOrder S; S.init(ws + WS_H, ws + WS_WIN, T, NIN, D, G, wg);
        FIn f{(bf16_t*)(ws + WS_QKV), (bf16_t*)(ws + WS_PR), (bf16_t*)args.out};
#ifndef P1_ALIGN
#define P1_ALIGN true
#endif
        if (NAIVE(1)) pg8::gemm_naive<false>(D, S, f); else { pg8::EpiRow8<FIn> E{f}; pg8::gemm_phase<P1_ALIGN>(lds, D, S, E, GEMM_ACC_PTR(1)); }
        p0b_extra_cols(args, wg, G);
    }
    SEAM(1);
#ifndef P2_SKIP
#define P2_SKIP 0
#endif
    TSTAMP(2);
    if (IN(2)) REPS(2) { REPBAR(); p2_lora(args, lds, wg, G, rep ? P2_SKIP : 0); }
    TSTAMP(3);
    SEAM(3);
    TSTAMP(4);
    if (IN(4)) REPS(4) {
        REPBAR();
        const int nscan = G / 2;
#ifdef PROBE_SKIP_SCAN_REP
        if (wg < nscan && !rep)
#else
        if (wg < nscan)
#endif
            {
#ifndef SCAN_REPS
#define SCAN_REPS 1
#endif
#ifndef ATTN_REPS
#define ATTN_REPS 1
#endif
#ifndef SCAN_SKIP
#define SCAN_SKIP 0
#endif
              _Pragma("unroll 1") for (int rr = 0; rr < SCAN_REPS; ++rr)
                for (int u = wg; u < BATCH * 8; u += nscan) scan_unit(args, lds, u >> 3, u & 7, rr ? (SCAN_SKIP | 1) : 0);
#if defined(SPLIT_STAMP) && SPLIT_STAMP == 41
              if (wg == 0 && tid == 0) *(volatile unsigned long long*)(ws + WS_CTL + 900 * 1024) = __builtin_amdgcn_s_memrealtime();
#endif
            }
#ifdef PROBE_SKIP_ATTN_REP
        if (!rep)
#endif
        {
            unsigned* qhead = (unsigned*)(ws + WS_CTL) + CW_QH + 64 * rep; volatile LAS int* slot = (volatile LAS int*)(lds + LDS_MISC + 32);
            __syncthreads();
            if (tid == 0) { slot[0] = (int)atomicAdd(qhead, 1u); slot[1] = (int)atomicAdd(qhead, 1u); }
            __syncthreads();
            int cur = slot[0], nxt = slot[1];
            constexpr int NAU = 3072 * ATTN_REPS;
            if (cur < NAU) {
                u32x4 kq[4], vq[4], qc[2], qn[2]; AttnDesc dc = attn_decode(cur % 3072); attn_load(args, dc, kq, vq, qc);
                attn_bias_tables(args, lds);
#ifdef ATTN_ACC
                unsigned long long aacc = 0ull, aq0 = 0ull;
#define AACC_B(id) do { if (ATTN_ACC == (id)) aq0 = __builtin_amdgcn_s_memrealtime(); } while (0)
#define AACC_E(id) do { if (ATTN_ACC == (id)) aacc += __builtin_amdgcn_s_memrealtime() - aq0; } while (0)
#else
#define AACC_B(id) do { } while (0)
#define AACC_E(id) do { } while (0)
#endif
                bool first = true;
                for (;;) {
                    AACC_B(1);
                    lds_barrier();
                    if (!first) nxt = slot[0];
                    first = false;
                    attn_stage(args, dc, kq, vq, lds);
                    lds_barrier();
                    AACC_E(1); AACC_B(2);
                    AttnDesc dn = attn_decode(nxt < NAU ? nxt % 3072 : 0);
                    if (nxt < NAU) attn_load(args, dn, kq, vq, qn);
                    unsigned fut = 0u; if (tid == 0) fut = atomicAdd(qhead, 1u);
                    attn_compute(args, dc, lds, qc);
                    if (tid == 0) slot[0] = (int)fut;
                    AACC_E(2);
                    if (nxt >= NAU) break;
                    dc = dn; cur = nxt; qc[0] = qn[0]; qc[1] = qn[1];
                }
#ifdef ATTN_ACC
                if (wg == G - 1 && tid == 0) *(volatile unsigned long long*)(ws + WS_CTL + 900 * 1024) = aacc;
#endif
            }
#if defined(SPLIT_STAMP) && SPLIT_STAMP == 42
            if (wg == G - 1 && tid == 0) *(volatile unsigned long long*)(ws + WS_CTL + 900 * 1024) = __builtin_amdgcn_s_memrealtime();
#endif
            __syncthreads();
        }
    }
    SEAM(4);
    TSTAMP(5);
    if (IN(5)) REPS(5) { REPBAR(); p5_combine(args, wg, G); }
    SEAM(5);
    TSTAMP(6);
    if (IN(6)) REPS(6) {
        REPBAR();
#ifndef P6A_REPS
#define P6A_REPS 1
#endif
#ifndef P6B_REPS
#define P6B_REPS 1
#endif
        { pg8::StaticOrder S; S.init(ws + WS_ATT, ws + WS_WATT, T, D, 256, G, wg, P6A_REPS);
          FMix1 f{(bf16_t*)(ws + WS_H), (const bf16_t*)args.out};
          if (NAIVE(6)) pg8::gemm_naive<false>(256, S, f); else { pg8::EpiRow8<FMix1> E{f}; pg8::gemm_phase(lds, 256, S, E, GEMM_ACC_PTR(61)); } }
        VM_WAIT(); __syncthreads();
        { pg8::StaticOrder S; S.init(ws + WS_ORW, ws + WS_WRWKV, T, D, CR, G, wg, P6B_REPS);
          FMix2 f{(bf16_t*)(ws + WS_H), (const bf16_t*)args.out};
          if (NAIVE(6)) pg8::gemm_naive<false>(CR, S, f); else { pg8::EpiRow8<FMix2> E{f}; pg8::gemm_phase(lds, CR, S, E, GEMM_ACC_PTR(62)); } }
    }
    SEAM(6);
    TSTAMP(7);
    if (IN(7)) REPS(7) {
        REPBAR();
        pg8::StaticOrder S; S.init(ws + WS_H, ws + WS_WOUT, T, D, D, G, wg);
        FOut f{args.in[I_X], args.out};
#ifndef P7_ALIGN
#define P7_ALIGN true
#endif
        if (NAIVE(7)) pg8::gemm_naive<false>(D, S, f); else { pg8::EpiRow8<FOut> E{f}; pg8::gemm_phase<P7_ALIGN>(lds, D, S, E, GEMM_ACC_PTR(7)); }
    }
    SEAM(7);
    TSTAMP(8);
    if (IN(8)) REPS(8) { REPBAR(); p8_router(args, lds, wg, G, rep); }
    SEAM(8);
    LAS int* tab = (LAS int*)(lds + LDS_TAB);
    const unsigned* cnt = (const unsigned*)(ws + WS_CTL) + CW_CNT; const int* lists = (const int*)(ws + WS_LIST);
    TSTAMP(9);
    if (IN(9)) REPS(9) {
        REPBAR();
        moe_tables(tab, cnt, lists, 0, 64, wg, G);
        MoeOrder S{tab, D, (const char*)(ws + WS_H), (const char*)(ws + WS_WGU), (size_t)1024 * 1024 * 2, 1};
        FGU f{(bf16_t*)(ws + WS_HID), tab, (const float*)(ws + WS_TOKG) + (size_t)2 * T};
#ifdef P9_DRY
        { MoeOrder S2 = S; S2.dry = 1; pg8::EpiPair8<FGU> E{f}; pg8::gemm_phase(lds, D, S2, E, nullptr); VM_WAIT(); __syncthreads(); }
#endif
        if (NAIVE(9)) pg8::gemm_naive<true>(D, S, f); else { pg8::EpiPair8<FGU> E{f}; pg8::gemm_phase(lds, D, S, E, GEMM_ACC_PTR(9)); }
        const int ntl = tab[64], ngr = (G >> 5) * 8; const bool crit = ntl > 0 && (ntl % ngr) != 0 && tab[160 + 4 * ((ntl - 1) / ngr) + 3] != 0;
        if (!rep && !crit) {
            constexpr int I_GU = 32 * 32 * 16, I_DN = 32 * 32 * 8;
            unsigned* q2 = (unsigned*)(ws + WS_CTL) + CW_QH + 128; volatile LAS int* slot = (volatile LAS int*)(lds + LDS_MISC + 40);
            LAS float* scr = (LAS float*)(lds + (tid >> 6) * 16896);
            for (;;) {
                __syncthreads();
                if (tid == 0) slot[0] = (int)atomicAdd(q2, 16u);
                __syncthreads();
                const int base = slot[0]; if (base >= I_DN) break;
                const int it = I_GU + base + 2 * (tid >> 6); conv_expert_items(args, scr, it, it + 1, true, tid & 63);
            }
        }
    }
    SEAM(9);
    TSTAMP(10);
    if (IN(10)) REPS(10) {
        REPBAR();
        if (MK_N_LAUNCHES != 1) moe_tables(tab, cnt, lists, 0, 64, wg, G);
        MoeOrder S{tab, DE, (const char*)(ws + WS_HID), (const char*)(ws + WS_WD), (size_t)1024 * 512 * 2, 0};
        FDown0 f{(bf16_t*)(ws + WS_Y0), (const float*)(ws + WS_TOKG), tab};
        if (NAIVE(10)) pg8::gemm_naive<false>(DE, S, f); else { pg8::EpiRow8<FDown0> E{f}; pg8::gemm_phase(lds, DE, S, E, GEMM_ACC_PTR(10)); }
    }
    SEAM(10);
    TSTAMP(11);
    if (IN(11)) REPS(11) {
        REPBAR();
        float* out = args.out; const bf16_t* Y0 = (const bf16_t*)(ws + WS_Y0); const bf16_t* Y1 = Y0 + (size_t)T * D;
#ifndef P11_BATCH
#define P11_BATCH 2
#endif
        const size_t nit = (size_t)T * D / 8, stp = (size_t)G * 512;
        for (size_t itb = (size_t)wg * 512 + tid; itb < nit; itb += P11_BATCH * stp) {
          f32x4 xv[P11_BATCH][2]; u32x4 yv[P11_BATCH][2]; f32x2 gv[P11_BATCH];
#pragma unroll
          for (int q = 0; q < P11_BATCH; ++q) { const size_t it = itb + q * stp < nit ? itb + q * stp : itb, off = it * 8;
              xv[q][0] = ld16f<11>(out + off); xv[q][1] = ld16f<11>(out + off + 4); yv[q][0] = ld16<11>(Y0 + off); yv[q][1] = ld16<11>(Y1 + off);
              gv[q] = *(const f32x2*)((const float*)(ws + WS_TOKG) + 2 * (off >> 10)); }
#pragma unroll
          for (int q = 0; q < P11_BATCH; ++q) { const size_t it = itb + q * stp; if (it >= nit) break; const size_t off = it * 8;
            const f32x4 x0 = xv[q][0], x1 = xv[q][1]; float y0[8], y1[8]; unpack8(yv[q][0], y0); unpack8(yv[q][1], y1);
            { const float g0 = gv[q][0], g1 = gv[q][1];
#pragma unroll
              for (int e = 0; e < 8; ++e) { y0[e] *= g0; y1[e] *= g1; } }
            if (!rep) { st16f<11>(out + off, (f32x4){x0[0] + y0[0] + y1[0], x0[1] + y0[1] + y1[1], x0[2] + y0[2] + y1[2], x0[3] + y0[3] + y1[3]});
                        st16f<11>(out + off + 4, (f32x4){x1[0] + y0[4] + y1[4], x1[1] + y0[5] + y1[5], x1[2] + y0[6] + y1[6], x1[3] + y0[7] + y1[7]}); } } }
    }
    TSTAMP(12);
#ifdef PROBE_TIME_PHASE
#ifdef SPLIT_STAMP
    if (wg == 0 && tid == 0) tp1 = *(volatile unsigned long long*)(ws + WS_CTL + 900 * 1024);
#endif
#if defined(SCAN_ACC) || defined(GEMM_ACC_PHASE) || defined(ATTN_ACC)
    if (wg == 0 && tid == 0) tp1 = tp0 + *(volatile unsigned long long*)(ws + WS_CTL + 900 * 1024);
#endif
    if (wg == 0 && tid == 0) { const unsigned long long te = __builtin_amdgcn_s_memrealtime(), dt = (tp1 - tp0) * 4ull; while (__builtin_amdgcn_s_memrealtime() - te < dt) __builtin_amdgcn_s_sleep(8); }
#endif
#undef IN
#undef SEAM
#undef NAIVE
}

extern "C" void kernel_launch(void* const* d_in, const int* in_sizes, int n_in, void* d_out, int out_size, void* d_ws, size_t ws_size, hipStream_t stream) {
    static int grid = 0;
    if (grid == 0) {
        if (n_in != 28 || out_size != T * D || ws_size < WS_END) { fprintf(stderr, "kernel_launch: unexpected problem (n_in %d, out %d, ws %zu)\n", n_in, out_size, ws_size); grid = -1; return; }
        int dev = 0, cus = 0;
        if (hipGetDevice(&dev) != hipSuccess || hipDeviceGetAttribute(&cus, hipDeviceAttributeMultiprocessorCount, dev) != hipSuccess) { grid = -1; return; }
        if (hipFuncSetAttribute((const void*)hybrid_fwd, hipFuncAttributeMaxDynamicSharedMemorySize, LDS_BYTES) != hipSuccess) { fprintf(stderr, "kernel_launch: hipFuncSetAttribute failed\n"); grid = -1; return; }
        int per_cu = 0;
        if (hipOccupancyMaxActiveBlocksPerMultiprocessor(&per_cu, (const void*)hybrid_fwd, 512, LDS_BYTES) != hipSuccess || per_cu < 1) fprintf(stderr, "kernel_launch: occupancy query reports %d\n", per_cu);
        (void)hipGetLastError();
        grid = cus;
    }
    if (grid < 0) return;
    (void)hipMemsetAsync((char*)d_ws + WS_CTL, 0, CTL_ZERO_BYTES, stream);
    Args a{};
    for (int i = 0; i < 28; ++i) a.in[i] = (const float*)d_in[i];
    a.out = (float*)d_out; a.ws = (unsigned char*)d_ws;
    if (MK_N_LAUNCHES == 1) { a.ph_lo = 0; a.ph_hi = NPH; hipLaunchKernelGGL(hybrid_fwd, dim3(grid), dim3(512), LDS_BYTES, stream, a); }
    else { for (int p = 0; p < NPH; ++p) { a.ph_lo = p; a.ph_hi = p + 1; hipLaunchKernelGGL(hybrid_fwd, dim3(grid), dim3(512), LDS_BYTES, stream, a); } }
}
```
